# Optimizing an MI355X kernel written in HIP

```python
import jax, jax.numpy as jnp
from jax import lax
import numpy as np

D_MODEL = 1024
BATCH = 8
SEQ = 2048
DEPTH = 4
DEC_BATCH = 128
DEC_SEQ = 8
PAST_LEN = 16384
PAGE_SIZE = 128

MIX_WIDTH = D_MODEL // 2
HEAD_SIZE = 64
N_HEADS = MIX_WIDTH // HEAD_SIZE
D_DECAY_LORA = 64
D_AAA_LORA = 64
D_MV_LORA = 32
D_GATE_LORA = 128
POOL_WIDTH = D_MODEL // 2
POOL_WINDOWS = (2, 4, 8, 16)
N_POOL_GROUPS = len(POOL_WINDOWS)
POOL_GROUP = POOL_WIDTH // N_POOL_GROUPS
POOL_BUF = max(POOL_WINDOWS) - 1
D_FF = 4 * D_MODEL
N_BRANCHES = 2
RWKV_COLS = 3 * MIX_WIDTH + D_DECAY_LORA + D_AAA_LORA + D_GATE_LORA
IN_COLS = RWKV_COLS + POOL_WIDTH + N_BRANCHES * D_MODEL
RWKV_SPLITS = (MIX_WIDTH, 2 * MIX_WIDTH, 3 * MIX_WIDTH,
               3 * MIX_WIDTH + D_DECAY_LORA, 3 * MIX_WIDTH + D_DECAY_LORA + D_AAA_LORA)
NORM_EPS = 1e-6
GN_EPS = 64e-5

kernel_name = "rwkv7_pool_gated_hybrid_step"

V_NAMES = ("v0", "v1", "v2")


def rms_norm(x, g):
    xf = x.astype(jnp.float32)
    y = xf * lax.rsqrt(jnp.mean(xf * xf, axis=-1, keepdims=True) + NORM_EPS)
    return (y * g.astype(jnp.float32)).astype(x.dtype)


def ada_mod(c, w, b):
    m = jax.nn.silu(c) @ w + b
    shift, scale, gate = jnp.split(m, 3, axis=-1)
    return shift[:, None], scale[:, None], gate[:, None]


def wkv7_scan(state0, r, decay, k, v, kk, a):
    def step(S, inp):
        r_t, w_t, k_t, v_t, kk_t, a_t = inp
        sa = jnp.einsum("bhvk,bhk->bhv", S, -kk_t)
        S = (S * w_t[:, :, None, :]
             + sa[..., None] * (kk_t * a_t)[:, :, None, :]
             + v_t[..., None] * k_t[:, :, None, :])
        y = jnp.einsum("bhvk,bhk->bhv", S, r_t)
        return S, y
    xs = tuple(jnp.moveaxis(t, 1, 0) for t in (r, decay, k, v, kk, a))
    S, ys = lax.scan(step, state0, xs)
    return jnp.moveaxis(ys, 0, 1), S


def rwkv7_branch(pr, shift_prev, wkv_prev, v_first, lp):
    B, T, _ = pr.shape
    f32 = jnp.float32
    pr_prev = jnp.concatenate([shift_prev[:, None, :].astype(pr.dtype), pr[:, :-1]], axis=1)
    xl = pr + (pr_prev - pr) * lp["mu_shift"]
    r, k, v, xw, xa, xg = jnp.split(xl, RWKV_SPLITS, axis=-1)
    w_logit = (lp["w0"] + jnp.tanh(xw) @ lp["w2"]).astype(f32)
    decay = jnp.exp(-jnp.exp(-jax.nn.softplus(-w_logit) - 0.5))
    a = jax.nn.sigmoid(lp["a0"] + xa @ lp["a2"])
    g = jax.nn.sigmoid(xg) @ lp["g2"]
    if v_first is None:
        v_first = v
    else:
        v = v + (v_first - v) * jax.nn.sigmoid(lp["v0"] + (v @ lp["v1"]) @ lp["v2"])
    heads = lambda t: t.reshape(B, T, N_HEADS, HEAD_SIZE).astype(f32)
    kk = heads(k * lp["k_k"])
    kk = kk * lax.rsqrt(jnp.sum(kk * kk, axis=-1, keepdims=True) + 1e-12)
    k = k * (1 + (a - 1) * lp["k_a"])
    rh, kh, vh, ah = heads(r), heads(k), heads(v), heads(a)
    y, wkv_new = wkv7_scan(wkv_prev.astype(f32), rh, heads(decay), kh, vh, kk, ah)
    mean = jnp.mean(y, axis=-1, keepdims=True)
    var = jnp.mean(jnp.square(y - mean), axis=-1, keepdims=True)
    y = ((y - mean) * lax.rsqrt(var + GN_EPS)).reshape(B, T, MIX_WIDTH)
    y = y * lp["ln_w"].astype(f32) + lp["ln_b"].astype(f32)
    bonus = jnp.sum(rh * kh * lp["r_k"].astype(f32), axis=-1, keepdims=True) * vh
    y = (y + bonus.reshape(B, T, MIX_WIDTH)).astype(pr.dtype) * g
    return y, pr[:, -1], wkv_new, v_first


def pool_branch(pp, pool_prev, pos0, lp):
    B, T, _ = pp.shape
    buf = jnp.concatenate([pool_prev.astype(pp.dtype), pp], axis=1)
    cs = jnp.pad(jnp.cumsum(buf.astype(jnp.float32), axis=1), ((0, 0), (1, 0), (0, 0)))
    pos = pos0 + jnp.arange(T, dtype=jnp.int32)
    hi = cs[:, POOL_BUF + 1:]
    means = []
    for gi, win in enumerate(POOL_WINDOWS):
        ch = slice(gi * POOL_GROUP, (gi + 1) * POOL_GROUP)
        lo = cs[:, POOL_BUF + 1 - win: POOL_BUF + 1 - win + T, ch]
        cnt = jnp.minimum(pos + 1, win).astype(jnp.float32)[None, :, None]
        means.append((hi[..., ch] - lo) / cnt)
    pooled = jnp.concatenate(means, axis=-1).astype(pp.dtype) - pp
    z = jnp.einsum("btgc,gcd->btgd", pooled.reshape(B, T, N_POOL_GROUPS, POOL_GROUP), lp["pool_w"])
    return z.reshape(B, T, POOL_WIDTH) * lp["pool_scale"], buf[:, -POOL_BUF:]


def trunk(x, c, shift0, pool0, wkv0, pos0, W):
    shifts, pools, wkvs = [], [], []
    v_first = None
    for l in range(DEPTH):
        lp = {name: arr[l] for name, arr in W.items() if name not in V_NAMES}
        if l > 0:
            lp.update({name: W[name][l - 1] for name in V_NAMES})
        sh, sc, gt = ada_mod(c, lp["w_ada_mix"], lp["b_ada_mix"])
        h = rms_norm(x, lp["norm_mix"]) * (1 + sc) + sh
        P = h @ lp["w_in"]
        pr, pp, pg = jnp.split(P, [RWKV_COLS, RWKV_COLS + POOL_WIDTH], axis=-1)
        o_r, s_shift, s_wkv, v_first = rwkv7_branch(pr, shift0[l], wkv0[l], v_first, lp)
        o_p, s_pool = pool_branch(pp, pool0[l], pos0, lp)
        g_r, g_p = jnp.split(jax.nn.sigmoid(pg), 2, axis=-1)
        merged = g_r * (o_r @ lp["w_br_rwkv"]) + g_p * (o_p @ lp["w_br_pool"])
        x = x + gt * (merged @ lp["w_out"])
        sh, sc, gt = ada_mod(c, lp["w_ada_mlp"], lp["b_ada_mlp"])
        h = rms_norm(x, lp["norm_mlp"]) * (1 + sc) + sh
        x = x + gt * (jnp.square(jax.nn.relu(h @ lp["w_ff1"])) @ lp["w_ff2"])
        shifts.append(s_shift)
        pools.append(s_pool)
        wkvs.append(s_wkv)
    y = rms_norm(x, W["norm_final"])
    return y, jnp.stack(shifts), jnp.stack(pools), jnp.stack(wkvs)


def setup_inputs(seed: int = 0) -> dict:
    key = jax.random.key(seed)
    ks = iter(jax.random.split(key, 48))
    nrm = lambda shape, s: jax.random.normal(next(ks), shape, jnp.float32) * s
    uni = lambda shape, lo, hi: jax.random.uniform(next(ks), shape, jnp.float32, lo, hi)
    L, D, M = DEPTH, D_MODEL, MIX_WIDTH
    return {
        "x_prompt": nrm((BATCH, SEQ, D), 1.0),
        "x_sample": nrm((DEC_BATCH, DEC_SEQ, D), 1.0),
        "state_shift": nrm((L, DEC_BATCH, RWKV_COLS), 1.0),
        "state_pool": nrm((L, DEC_BATCH, POOL_BUF, POOL_WIDTH), 1.0),
        "state_wkv": nrm((L, DEC_BATCH, N_HEADS, HEAD_SIZE, HEAD_SIZE), 0.3),
        "c_prompt": nrm((BATCH, D), 1.0),
        "c_sample": nrm((DEC_BATCH, D), 1.0),
        "w_ada_mix": nrm((L, D, 3 * D), 0.5 * D ** -0.5),
        "b_ada_mix": nrm((L, 3 * D), 0.02),
        "norm_mix": 1.0 + nrm((L, D), 0.1),
        "w_in": nrm((L, D, IN_COLS), D ** -0.5),
        "mu_shift": uni((L, RWKV_COLS), 0.0, 1.0),
        "w0": uni((L, M), -6.0, 0.0),
        "w2": nrm((L, D_DECAY_LORA, M), 0.1),
        "a0": nrm((L, M), 0.1),
        "a2": nrm((L, D_AAA_LORA, M), D_AAA_LORA ** -0.5),
        "g2": nrm((L, D_GATE_LORA, M), D_GATE_LORA ** -0.5),
        "v0": nrm((L - 1, M), 0.1),
        "v1": nrm((L - 1, M, D_MV_LORA), M ** -0.5),
        "v2": nrm((L - 1, D_MV_LORA, M), D_MV_LORA ** -0.5),
        "k_k": 0.85 + nrm((L, M), 0.05),
        "k_a": 1.0 + nrm((L, M), 0.1),
        "r_k": nrm((L, N_HEADS, HEAD_SIZE), 0.1),
        "ln_w": 1.0 + nrm((L, M), 0.1),
        "ln_b": nrm((L, M), 0.01),
        "pool_w": nrm((L, N_POOL_GROUPS, POOL_GROUP, POOL_GROUP), POOL_GROUP ** -0.5),
        "pool_scale": 1.0 + nrm((L, POOL_WIDTH), 0.1),
        "w_br_rwkv": nrm((L, M, D), M ** -0.5),
        "w_br_pool": nrm((L, POOL_WIDTH, D), POOL_WIDTH ** -0.5),
        "w_out": nrm((L, D, D), D ** -0.5),
        "w_ada_mlp": nrm((L, D, 3 * D), 0.5 * D ** -0.5),
        "b_ada_mlp": nrm((L, 3 * D), 0.02),
        "norm_mlp": 1.0 + nrm((L, D), 0.1),
        "w_ff1": nrm((L, D, D_FF), D ** -0.5),
        "w_ff2": nrm((L, D_FF, D), D_FF ** -0.5),
        "norm_final": 1.0 + nrm((D,), 0.1),
    }


def reference(x_prompt, x_sample, state_shift, state_pool, state_wkv, c_prompt, c_sample,
              w_ada_mix, b_ada_mix, norm_mix, w_in, mu_shift, w0, w2, a0, a2, g2, v0, v1, v2,
              k_k, k_a, r_k, ln_w, ln_b, pool_w, pool_scale, w_br_rwkv, w_br_pool, w_out,
              w_ada_mlp, b_ada_mlp, norm_mlp, w_ff1, w_ff2, norm_final):
    W = {
        "w_ada_mix": w_ada_mix, "b_ada_mix": b_ada_mix, "norm_mix": norm_mix, "w_in": w_in,
        "mu_shift": mu_shift, "w0": w0, "w2": w2, "a0": a0, "a2": a2, "g2": g2,
        "v0": v0, "v1": v1, "v2": v2, "k_k": k_k, "k_a": k_a, "r_k": r_k,
        "ln_w": ln_w, "ln_b": ln_b, "pool_w": pool_w, "pool_scale": pool_scale,
        "w_br_rwkv": w_br_rwkv, "w_br_pool": w_br_pool, "w_out": w_out,
        "w_ada_mlp": w_ada_mlp, "b_ada_mlp": b_ada_mlp, "norm_mlp": norm_mlp,
        "w_ff1": w_ff1, "w_ff2": w_ff2, "norm_final": norm_final,
    }
    Bp = x_prompt.shape[0]
    shift0 = jnp.zeros((DEPTH, Bp, RWKV_COLS), x_prompt.dtype)
    pool0 = jnp.zeros((DEPTH, Bp, POOL_BUF, POOL_WIDTH), x_prompt.dtype)
    wkv0 = jnp.zeros((DEPTH, Bp, N_HEADS, HEAD_SIZE, HEAD_SIZE), jnp.float32)
    y_prompt, shift_p, pool_p, wkv_p = trunk(x_prompt, c_prompt, shift0, pool0, wkv0, 0, W)
    y_sample, shift_s, pool_s, wkv_s = trunk(x_sample, c_sample, state_shift, state_pool,
                                             state_wkv, PAST_LEN, W)
    return (y_prompt, y_sample, shift_p, pool_p, wkv_p, shift_s, pool_s, wkv_s)
```

```cpp
#include <hip/hip_runtime.h>
#include <cstdio>
#include <cstdint>

#ifndef MK_ONE_LAUNCH
#define MK_ONE_LAUNCH 0
#endif

#define GAS __attribute__((address_space(1)))
#define LAS __attribute__((address_space(3)))
typedef unsigned short bf16;
typedef unsigned v4u __attribute__((ext_vector_type(4)));
typedef unsigned v2u __attribute__((ext_vector_type(2)));
typedef float f32x4 __attribute__((ext_vector_type(4)));
typedef float f32x2 __attribute__((ext_vector_type(2)));
typedef short bf16x8 __attribute__((ext_vector_type(8)));

constexpr int D = 1024, DEPTH = 4, NSEQ_P = 8, T_P = 2048, NSEQ_S = 128, T_S = 8;
constexpr int MP = NSEQ_P * T_P, MS = NSEQ_S * T_S, M = MP + MS;
constexpr int NSEQ = NSEQ_P + NSEQ_S;
constexpr int MIX = 512, HS = 64, NH = 8, POOLW = 512, PGRP = 128, PBUF = 15, DFF = 4096;
constexpr int RWKV_COLS = 1792, IN_COLS = 4352;
constexpr int C_R = 0, C_K = 512, C_V = 1024, C_XW = 1536, C_XA = 1600, C_XG = 1664, C_PP = 1792, C_GR = 2304, C_GP = 3328;
constexpr int MODW = 8 * 3072;
constexpr int NWAVES = 8, NTHR = 512;

enum { I_XP = 0, I_XS, I_SSHIFT, I_SPOOL, I_SWKV, I_CP, I_CS, I_WADAMIX, I_BADAMIX, I_NORMMIX, I_WIN, I_MU, I_W0, I_W2, I_A0, I_A2, I_G2,
       I_V0, I_V1, I_V2, I_KK, I_KA, I_RK, I_LNW, I_LNB, I_POOLW, I_POOLS, I_WBRR, I_WBRP, I_WOUT, I_WADAMLP, I_BADAMLP, I_NORMMLP, I_WFF1, I_WFF2, I_NORMF, N_IN };
constexpr size_t O_Y = 0, O_SHP = (size_t)M * D, O_POP = O_SHP + 4 * 8 * 1792, O_WKP = O_POP + 4 * 8 * 15 * 512, O_SHS = O_WKP + 4 * 8 * 8 * 4096,
                 O_POS = O_SHS + 4 * 128 * 1792, O_WKS = O_POS + (size_t)4 * 128 * 15 * 512, O_END = O_WKS + (size_t)4 * 128 * 8 * 4096;

constexpr size_t MiB = 1u << 20;
constexpr size_t WS_CTL = 0, CTL_ZERO_BYTES = 1 * MiB;
constexpr size_t WS_MOD = 1 * MiB;
constexpr size_t WS_SC = 14 * MiB;
constexpr size_t WS_WIN = 16 * MiB;
constexpr size_t WS_WBR = 25 * MiB;
constexpr size_t WS_WOUT = 27 * MiB;
constexpr size_t WS_WFF1 = 29 * MiB;
constexpr size_t WS_WFF2 = 37 * MiB;
constexpr size_t WS_WSM = 45 * MiB;
constexpr size_t SM_W2 = 0, SM_A2 = 65536, SM_G2 = 131072, SM_V1 = 262144, SM_V2 = 294912, SM_PW = 327680;
constexpr size_t WS_H = 48 * MiB;
constexpr size_t WS_P = 82 * MiB;
constexpr size_t WS_R = 227 * MiB, WS_K2 = 244 * MiB, WS_V = 261 * MiB, WS_KK = 278 * MiB, WS_B = 295 * MiB;
constexpr size_t WS_W = 312 * MiB;
constexpr size_t WS_ORP = 346 * MiB;
constexpr size_t WS_G = 380 * MiB;
constexpr size_t WS_VF = 397 * MiB;
constexpr size_t WS_Y = 414 * MiB;
constexpr size_t WS_END = 448 * MiB;

constexpr int CW_BAR = 4096;

constexpr int RING_BYTES = 131072, LDSCTL_OFF = RING_BYTES, MISC_OFF = LDSCTL_OFF + 320, LDS_BYTES = 147456;

typedef __bf16 bf16x2_t __attribute__((ext_vector_type(2)));
__device__ __forceinline__ unsigned cvt_pk_bf16(float lo, float hi) { f32x2 v = {lo, hi}; bf16x2_t b = __builtin_convertvector(v, bf16x2_t); return __builtin_bit_cast(unsigned, b); }
__device__ __forceinline__ float bf_lo(unsigned u) { return __builtin_bit_cast(float, u << 16); }
__device__ __forceinline__ float bf_hi(unsigned u) { return __builtin_bit_cast(float, u & 0xffff0000u); }
__device__ __forceinline__ float sigmoidf_(float x) { return 1.0f / (1.0f + __expf(-x)); }
__device__ __forceinline__ float tanhf_(float x) { return 1.0f - 2.0f / (1.0f + __expf(2.0f * x)); }
__device__ __forceinline__ float wave_sum(float v) {
#pragma unroll
    for (int o = 1; o < 64; o <<= 1) v += __shfl_xor(v, o);
    return v;
}
__device__ __forceinline__ int launder_tid() { int t = threadIdx.x; asm volatile("" : "+v"(t)); return t; }
#define LDS_WAIT() asm volatile("s_waitcnt lgkmcnt(0)" ::: "memory")
#define VM_WAIT() asm volatile("s_waitcnt vmcnt(0)" ::: "memory")

namespace pg8 {
#define PG8_LAS __attribute__((address_space(3)))
typedef unsigned short bf16_t;
constexpr int BM = 256, BK = 64, HALF = 128, HTB = HALF * BK * 2, STAGE_BYTES = 8 * HTB, NXCD = 8, WGM = 8;

__host__ __device__ __forceinline__ int lds_byte(int r, int c) { const int st = (r >> 4) * 2 + (c >> 5), rr = r & 15, cc = c & 31, ob = rr * 64 + cc * 2; return st * 1024 + (ob ^ (((ob >> 9) & 1) << 5)); }
__host__ __device__ __forceinline__ void stage_rc(int b, int& R, int& C) { const int st = b / 1024, sb = b % 1024, swz = sb ^ (((sb >> 9) & 1) << 5); R = (st >> 1) * 16 + swz / 64; C = (st & 1) * 32 + (swz % 64) / 2; }
__host__ __device__ __forceinline__ int perm32(int rho) { const int n = rho >> 4, i = rho & 15; return 8 * (i >> 2) + 4 * n + (i & 3); }

struct Unit { int pm, pn; };
struct Gemm { const bf16_t* A; const bf16_t* Bt; int M, N, K; };

struct StaticOrder {
    int nM, nN, nwg, G, c;
    __host__ __device__ void init(int M_, int N_, int G_, int c_) { nM = M_ / BM; nN = N_ / BM; nwg = nM * nN; G = G_; c = c_; }
    __host__ __device__ bool next(int i, Unit& u) const {
        const long L = (long)i * G + c; if (L >= nwg) return false;
        int wgid = (int)L; { const int q = nwg / NXCD, r = nwg % NXCD, xcd = wgid % NXCD, off = wgid / NXCD; wgid = (xcd < r ? xcd * (q + 1) : r * (q + 1) + (xcd - r) * q) + off; }
        const int nig = WGM * nN, gid = wgid / nig, fm = gid * WGM, gsz = (nM - fm) < WGM ? (nM - fm) : WGM;
        u.pm = fm + ((wgid % nig) % gsz); u.pn = (wgid % nig) / gsz; return true;
    }
};

template <class Epi, class Sched, bool ALIGN_EPI = false, bool SP2 = false>
__device__ __forceinline__ void gemm_phase(PG8_LAS unsigned char* lds, const Gemm g, const Sched& S, const Epi& E) {
    const int tid = launder_tid(), wid = __builtin_amdgcn_readfirstlane(tid >> 6), lane = tid & 63, wr = wid >> 2, wc = wid & 3, fr = lane & 15, fq = lane >> 4;
    const int K = g.K, nt = K / BK;
    unsigned voffA[2], voffB[2];
#pragma unroll
    for (int i = 0; i < 2; ++i) { int R, C; stage_rc(tid * 16 + i * 8192, R, C); const int Rb = (R & ~31) + perm32(R & 31);
        voffA[i] = (unsigned)(R * K + C) * 2u; voffB[i] = (unsigned)(Rb * K + C) * 2u; }
    const size_t kstep = (size_t)(BK * 2);
    const size_t hstep = (size_t)HALF * K * 2;
    const size_t tstep = 2 * hstep;
    const unsigned ldsw = (unsigned)wid * 1024u;
    const int aoff = lds_byte(wr * 64 + fr, fq * 8), boff = lds_byte(wc * 32 + fr, fq * 8);
#define PG8_SA(b, h) (((b) * 2 + (h)) * HTB)
#define PG8_SB(b, h) ((4 + (b) * 2 + (h)) * HTB)
#define PG8_STAGE(bufoff, gbase, voff) do { _Pragma("unroll") for (int _i = 0; _i < 2; ++_i) \
        __builtin_amdgcn_global_load_lds((const unsigned*)((const char*)(gbase) + (voff)[_i]), (PG8_LAS unsigned*)(lds + (bufoff) + ldsw + _i * 8192), 16, 0, 0); } while (0)
#define PG8_LDA(dst, b, h) do { _Pragma("unroll") for (int m = 0; m < 4; ++m) _Pragma("unroll") for (int k = 0; k < 2; ++k) dst[m][k] = *(const PG8_LAS bf16x8*)(lds + PG8_SA(b, h) + aoff + m * 2048 + k * 1024); } while (0)
#define PG8_LDB(dst, b, h) do { _Pragma("unroll") for (int n = 0; n < 2; ++n) _Pragma("unroll") for (int k = 0; k < 2; ++k) dst[n][k] = *(const PG8_LAS bf16x8*)(lds + PG8_SB(b, h) + boff + n * 2048 + k * 1024); } while (0)
#define PG8_MMA(ai, bj, At, Bt) do { __builtin_amdgcn_s_setprio(1); _Pragma("unroll") for (int m = 0; m < 4; ++m) _Pragma("unroll") for (int n = 0; n < 2; ++n) _Pragma("unroll") for (int k = 0; k < 2; ++k) \
        acc[ai][bj][m][n] = __builtin_amdgcn_mfma_f32_16x16x32_bf16(Bt[n][k], At[m][k], acc[ai][bj][m][n], 0, 0, 0); __builtin_amdgcn_s_setprio(0); } while (0)
#define PG8_WAIT_V(n) asm volatile("s_waitcnt vmcnt(" #n ")" ::: "memory")
#define PG8_WAIT_L(n) asm volatile("s_waitcnt lgkmcnt(" #n ")" ::: "memory")
#define PG8_BAR __builtin_amdgcn_s_barrier()
#define PG8_SCHED __builtin_amdgcn_sched_barrier(0)
    Unit cur, nxt; int ui = 0;
    if (!S.next(0, cur)) return;
    f32x4 acc[2][2][4][2];
#pragma unroll
    for (int a = 0; a < 2; ++a)
#pragma unroll
        for (int b = 0; b < 2; ++b)
#pragma unroll
            for (int m = 0; m < 4; ++m)
#pragma unroll
                for (int n = 0; n < 2; ++n) acc[a][b][m][n] = (f32x4){0.f, 0.f, 0.f, 0.f};
    bf16x8 At[4][2], B0[2][2], B1[2][2];
    const char* cA = (const char*)g.A + (size_t)cur.pm * tstep; const char* cB = (const char*)g.Bt + (size_t)cur.pn * tstep;
    if constexpr (SP2) {
        PG8_STAGE(PG8_SB(0, 0), cB, voffB); PG8_STAGE(PG8_SB(0, 1), cB + hstep, voffB); PG8_STAGE(PG8_SA(0, 0), cA, voffA); PG8_STAGE(PG8_SA(0, 1), cA + hstep, voffA);
        if (wr == 1) PG8_BAR;
        PG8_WAIT_V(2); PG8_BAR;
        PG8_STAGE(PG8_SB(1, 0), cB + kstep, voffB); PG8_STAGE(PG8_SA(1, 0), cA + kstep, voffA); PG8_STAGE(PG8_SB(1, 1), cB + hstep + kstep, voffB);
        PG8_WAIT_V(6); PG8_BAR;
    } else {
        PG8_STAGE(PG8_SB(0, 0), cB, voffB); PG8_STAGE(PG8_SA(0, 0), cA, voffA); PG8_STAGE(PG8_SB(0, 1), cB + hstep, voffB); PG8_STAGE(PG8_SA(0, 1), cA + hstep, voffA);
        if (wr == 1) PG8_BAR;
        PG8_WAIT_V(4); PG8_BAR;
        PG8_STAGE(PG8_SB(1, 0), cB + kstep, voffB); PG8_STAGE(PG8_SA(1, 0), cA + kstep, voffA); PG8_STAGE(PG8_SB(1, 1), cB + hstep + kstep, voffB);
        PG8_WAIT_V(6); PG8_BAR;
    }
    for (;;) {
        const bool has_next = S.next(ui + 1, nxt);
        const char* nA = has_next ? (const char*)g.A + (size_t)nxt.pm * tstep : cA; const char* nB = has_next ? (const char*)g.Bt + (size_t)nxt.pn * tstep : cB;
        for (int t = 0; t < nt; t += 2) {
            const bool last = (t == nt - 2);
            const char* a1 = cA + (size_t)(t + 1) * kstep;
            const char* a2 = last ? nA : cA + (size_t)(t + 2) * kstep; const char* b2 = last ? nB : cB + (size_t)(t + 2) * kstep;
            const char* a3 = a2 + kstep; const char* b3 = b2 + kstep;
            if constexpr (Epi::HOOK) { if (t == E.hook_t) E.hook(acc, cur, wr, wc, fr, fq); }
            if constexpr (SP2) {
            PG8_LDB(B0, 0, 0); PG8_LDB(B1, 0, 1); PG8_SCHED; PG8_LDA(At, 0, 0); PG8_STAGE(PG8_SA(1, 1), a1 + hstep, voffA);
            PG8_WAIT_V(8); PG8_WAIT_L(0); PG8_BAR; PG8_MMA(0, 0, At, B0); PG8_MMA(0, 1, At, B1); PG8_BAR; PG8_SCHED;
            PG8_LDA(At, 0, 1); PG8_STAGE(PG8_SB(0, 0), b2, voffB); PG8_STAGE(PG8_SB(0, 1), b2 + hstep, voffB); PG8_STAGE(PG8_SA(0, 0), a2, voffA);
            PG8_WAIT_V(8); PG8_WAIT_L(0); PG8_BAR; PG8_MMA(1, 0, At, B0); PG8_MMA(1, 1, At, B1); PG8_BAR; PG8_SCHED;
            PG8_LDB(B0, 1, 0); PG8_LDB(B1, 1, 1); PG8_SCHED; PG8_LDA(At, 1, 0); PG8_STAGE(PG8_SA(0, 1), a2 + hstep, voffA);
            PG8_WAIT_V(8); PG8_WAIT_L(0); PG8_BAR; PG8_MMA(0, 0, At, B0); PG8_MMA(0, 1, At, B1); PG8_BAR; PG8_SCHED;
            PG8_LDA(At, 1, 1); PG8_STAGE(PG8_SB(1, 0), b3, voffB); PG8_STAGE(PG8_SB(1, 1), b3 + hstep, voffB); PG8_STAGE(PG8_SA(1, 0), a3, voffA);
            PG8_WAIT_V(8); PG8_WAIT_L(0); PG8_BAR; PG8_MMA(1, 0, At, B0); PG8_MMA(1, 1, At, B1); PG8_BAR; PG8_SCHED;
            } else {
            PG8_LDB(B0, 0, 0); PG8_SCHED; PG8_LDA(At, 0, 0); PG8_STAGE(PG8_SA(1, 1), a1 + hstep, voffA);
            PG8_WAIT_L(8); PG8_BAR; PG8_WAIT_L(0); PG8_MMA(0, 0, At, B0); PG8_BAR; PG8_SCHED;
            PG8_LDB(B1, 0, 1); PG8_STAGE(PG8_SB(0, 0), b2, voffB);
            PG8_BAR; PG8_WAIT_L(0); PG8_MMA(0, 1, At, B1); PG8_BAR;
            PG8_LDA(At, 0, 1); PG8_STAGE(PG8_SA(0, 0), a2, voffA);
            PG8_BAR; PG8_WAIT_L(0); PG8_MMA(1, 0, At, B0); PG8_BAR; PG8_SCHED;
            PG8_STAGE(PG8_SB(0, 1), b2 + hstep, voffB);
            PG8_WAIT_V(6); PG8_BAR; PG8_MMA(1, 1, At, B1); PG8_BAR;
            PG8_LDB(B0, 1, 0); PG8_SCHED; PG8_LDA(At, 1, 0); PG8_STAGE(PG8_SA(0, 1), a2 + hstep, voffA);
            PG8_WAIT_L(8); PG8_BAR; PG8_WAIT_L(0); PG8_MMA(0, 0, At, B0); PG8_BAR; PG8_SCHED;
            PG8_LDB(B1, 1, 1); PG8_STAGE(PG8_SB(1, 0), b3, voffB);
            PG8_BAR; PG8_WAIT_L(0); PG8_MMA(0, 1, At, B1); PG8_BAR;
            PG8_LDA(At, 1, 1); PG8_STAGE(PG8_SA(1, 0), a3, voffA);
            PG8_BAR; PG8_WAIT_L(0); PG8_MMA(1, 0, At, B0); PG8_BAR; PG8_SCHED;
            PG8_STAGE(PG8_SB(1, 1), b3 + hstep, voffB);
            PG8_WAIT_V(6); PG8_BAR; PG8_MMA(1, 1, At, B1); PG8_BAR;
            }
        }
        if constexpr (ALIGN_EPI) { if (wr == 0) PG8_BAR; }
        E(acc, cur, wr, wc, fr, fq);
        if (!has_next) break;
#pragma unroll
        for (int a = 0; a < 2; ++a)
#pragma unroll
            for (int b = 0; b < 2; ++b)
#pragma unroll
                for (int m = 0; m < 4; ++m)
#pragma unroll
                    for (int n = 0; n < 2; ++n) acc[a][b][m][n] = (f32x4){0.f, 0.f, 0.f, 0.f};
        cur = nxt; cA = nA; cB = nB; ++ui;
        if constexpr (ALIGN_EPI) { if (wr == 1) PG8_BAR; }
    }
    PG8_WAIT_V(0);
    if constexpr (!ALIGN_EPI) { if (wr == 0) PG8_BAR; }
    PG8_BAR;
#undef PG8_SA
#undef PG8_SB
#undef PG8_STAGE
#undef PG8_LDA
#undef PG8_LDB
#undef PG8_MMA
#undef PG8_WAIT_V
#undef PG8_WAIT_L
#undef PG8_BAR
#undef PG8_SCHED
}
}

__device__ __forceinline__ int row_seq(int m) { return m < MP ? (m >> 11) : NSEQ_P + ((m - MP) >> 3); }
__device__ __forceinline__ int row_t(int m) { return m < MP ? (m & (T_P - 1)) : ((m - MP) & (T_S - 1)); }

struct EpiBase { static constexpr bool HOOK = false; int hook_t; };

struct EpiStoreBf16 {
    static constexpr bool HOOK = false; int hook_t;
    bf16* O; int ldc; int act;
    __device__ __forceinline__ void hook(f32x4 (&)[2][2][4][2], const pg8::Unit&, int, int, int, int) const {}
    __device__ __forceinline__ void operator()(const f32x4 (&acc)[2][2][4][2], const pg8::Unit& u, int wr, int wc, int fr, int fq) const {
        asm volatile("" : "+v"(fr), "+v"(fq));
        const int row0 = u.pm * 256 + wr * 64 + fr, col0 = u.pn * 256 + wc * 32 + 8 * fq;
#pragma unroll
        for (int ai = 0; ai < 2; ++ai)
#pragma unroll
            for (int m = 0; m < 4; ++m) { bf16* rowp = O + (size_t)(row0 + ai * 128 + m * 16) * ldc + col0;
#pragma unroll
                for (int bj = 0; bj < 2; ++bj) { f32x4 v0 = acc[ai][bj][m][0], v1 = acc[ai][bj][m][1];
                    if (act == 1) {
#pragma unroll
                        for (int j = 0; j < 4; ++j) { float a = fmaxf(v0[j], 0.f), b = fmaxf(v1[j], 0.f); v0[j] = a * a; v1[j] = b * b; } }
                    v4u w; w.x = cvt_pk_bf16(v0[0], v0[1]); w.y = cvt_pk_bf16(v0[2], v0[3]); w.z = cvt_pk_bf16(v1[0], v1[1]); w.w = cvt_pk_bf16(v1[2], v1[3]);
                    *(v4u*)(rowp + bj * 128) = w; } }
    }
};

struct EpiMod {
    static constexpr bool HOOK = false; int hook_t;
    float* O; const float* bmix; const float* bmlp;
    __device__ __forceinline__ void hook(f32x4 (&)[2][2][4][2], const pg8::Unit&, int, int, int, int) const {}
    __device__ __forceinline__ void operator()(const f32x4 (&acc)[2][2][4][2], const pg8::Unit& u, int wr, int wc, int fr, int fq) const {
        asm volatile("" : "+v"(fr), "+v"(fq));
        const int row0 = u.pm * 256 + wr * 64 + fr, col0 = u.pn * 256 + wc * 32 + 8 * fq;
        const int mat = (u.pn * 256) / 3072, l = mat >> 1, which = mat & 1;
        const float* bias = (which ? bmlp : bmix) + l * 3072 - mat * 3072;
#pragma unroll
        for (int ai = 0; ai < 2; ++ai)
#pragma unroll
            for (int m = 0; m < 4; ++m) { const int row = row0 + ai * 128 + m * 16; if (row >= NSEQ) continue;
#pragma unroll
                for (int bj = 0; bj < 2; ++bj) { const int col = col0 + bj * 128;
                    const f32x4 b0 = *(const f32x4*)(bias + col), b1 = *(const f32x4*)(bias + col + 4);
                    *(f32x4*)(O + (size_t)row * MODW + col) = acc[ai][bj][m][0] + b0; *(f32x4*)(O + (size_t)row * MODW + col + 4) = acc[ai][bj][m][1] + b1; } }
    }
};

struct EpiRes {
    static constexpr bool HOOK = false; int hook_t;
    float* X; const float* gate;
    __device__ __forceinline__ void hook(f32x4 (&)[2][2][4][2], const pg8::Unit&, int, int, int, int) const {}
    __device__ __forceinline__ void operator()(const f32x4 (&acc)[2][2][4][2], const pg8::Unit& u, int wr, int wc, int fr, int fq) const {
        asm volatile("" : "+v"(fr), "+v"(fq));
        const int row0 = u.pm * 256 + wr * 64 + fr, col0 = u.pn * 256 + wc * 32 + 8 * fq;
#pragma unroll
        for (int ai = 0; ai < 2; ++ai)
#pragma unroll
            for (int m = 0; m < 4; ++m) { const int row = row0 + ai * 128 + m * 16; const float* gr = gate + (size_t)row_seq(row) * MODW; float* xr = X + (size_t)row * D;
#pragma unroll
                for (int bj = 0; bj < 2; ++bj) { const int col = col0 + bj * 128;
                    const f32x4 g0 = *(const f32x4*)(gr + col), g1 = *(const f32x4*)(gr + col + 4);
                    f32x4 x0 = *(const f32x4*)(xr + col), x1 = *(const f32x4*)(xr + col + 4);
                    x0 += g0 * acc[ai][bj][m][0]; x1 += g1 * acc[ai][bj][m][1];
                    *(f32x4*)(xr + col) = x0; *(f32x4*)(xr + col + 4) = x1; } }
    }
};

struct EpiMerge {
    static constexpr bool HOOK = true; int hook_t;
    const bf16* P; bf16* O;
    __device__ __forceinline__ void hook(f32x4 (&acc)[2][2][4][2], const pg8::Unit& u, int wr, int wc, int fr, int fq) const {
        asm volatile("" : "+v"(fr), "+v"(fq));
        const int row0 = u.pm * 256 + wr * 64 + fr, col0 = u.pn * 256 + wc * 32 + 8 * fq;
#pragma unroll
        for (int ai = 0; ai < 2; ++ai)
#pragma unroll
            for (int m = 0; m < 4; ++m) { const bf16* pr = P + (size_t)(row0 + ai * 128 + m * 16) * IN_COLS + col0;
#pragma unroll
                for (int bj = 0; bj < 2; ++bj) { const v4u a = *(const v4u*)(pr + C_GR + bj * 128), b = *(const v4u*)(pr + C_GP + bj * 128);
                    float ga[8] = {bf_lo(a.x), bf_hi(a.x), bf_lo(a.y), bf_hi(a.y), bf_lo(a.z), bf_hi(a.z), bf_lo(a.w), bf_hi(a.w)};
                    float gb[8] = {bf_lo(b.x), bf_hi(b.x), bf_lo(b.y), bf_hi(b.y), bf_lo(b.z), bf_hi(b.z), bf_lo(b.w), bf_hi(b.w)};
#pragma unroll
                    for (int j = 0; j < 4; ++j) { acc[ai][bj][m][0][j] *= (1.0f + __expf(-gb[j])) / (1.0f + __expf(-ga[j]));
                                                  acc[ai][bj][m][1][j] *= (1.0f + __expf(-gb[4 + j])) / (1.0f + __expf(-ga[4 + j])); } } }
    }
    __device__ __forceinline__ void operator()(const f32x4 (&acc)[2][2][4][2], const pg8::Unit& u, int wr, int wc, int fr, int fq) const {
        asm volatile("" : "+v"(fr), "+v"(fq));
        const int row0 = u.pm * 256 + wr * 64 + fr, col0 = u.pn * 256 + wc * 32 + 8 * fq;
#pragma unroll
        for (int ai = 0; ai < 2; ++ai)
#pragma unroll
            for (int m = 0; m < 4; ++m) { const size_t row = (size_t)(row0 + ai * 128 + m * 16); const bf16* pr = P + row * IN_COLS + col0;
#pragma unroll
                for (int bj = 0; bj < 2; ++bj) { const v4u b = *(const v4u*)(pr + C_GP + bj * 128);
                    float gb[8] = {bf_lo(b.x), bf_hi(b.x), bf_lo(b.y), bf_hi(b.y), bf_lo(b.z), bf_hi(b.z), bf_lo(b.w), bf_hi(b.w)};
                    f32x4 v0 = acc[ai][bj][m][0], v1 = acc[ai][bj][m][1];
#pragma unroll
                    for (int j = 0; j < 4; ++j) { v0[j] *= sigmoidf_(gb[j]); v1[j] *= sigmoidf_(gb[4 + j]); }
                    v4u w; w.x = cvt_pk_bf16(v0[0], v0[1]); w.y = cvt_pk_bf16(v0[2], v0[3]); w.z = cvt_pk_bf16(v1[0], v1[1]); w.w = cvt_pk_bf16(v1[2], v1[3]);
                    *(v4u*)(O + row * D + col0 + bj * 128) = w; } }
    }
};

#define XB_TMO      128
#define XB_XCNT(j)  (256  + 64 * (j))
#define XB_XSUB(j)  (1280 + 64 * (j))
#define XB_XGEN(j)  (2304 + 64 * (j))
#define XB_TOP      3328
#define XB_TOPGEN   3392
#define XCD_BAR_WORDS 3456
#define XB_SPIN_CAP (1u << 22)

__device__ __forceinline__ unsigned xb_ld(unsigned* p)              { return __hip_atomic_load(p, __ATOMIC_RELAXED, __HIP_MEMORY_SCOPE_AGENT); }
__device__ __forceinline__ unsigned xb_add(unsigned* p, unsigned v) { return __hip_atomic_fetch_add(p, v, __ATOMIC_RELAXED, __HIP_MEMORY_SCOPE_AGENT); }
__device__ __forceinline__ unsigned xb_xcc_id() { return (unsigned)__builtin_amdgcn_s_getreg((3 << 11) | 20) & 0xFu; }
#define XB_SPIN(cond, bar) do { unsigned _sp = 0; while (cond) { __builtin_amdgcn_s_sleep(1); \
    if ((++_sp & 255u) == 0u) { if (xb_ld(&(bar)[XB_TMO])) break; if (_sp > XB_SPIN_CAP) { atomicAdd(&(bar)[XB_TMO], 1u); break; } } } } while (0)

struct XcdBarrier { unsigned* bar; unsigned x; volatile LAS unsigned* st; };

__device__ __forceinline__ XcdBarrier xcd_barrier_post(unsigned* bar, volatile LAS unsigned* st) {
    XcdBarrier b; b.bar = bar; b.x = xb_xcc_id(); b.st = st;
    if (threadIdx.x == 0) (void)xb_add(&bar[XB_XCNT(b.x)], 1u);
    return b;
}
__device__ __forceinline__ void xcd_barrier_complete(unsigned* bar, unsigned x, unsigned& nloc, unsigned& nx) {
    const unsigned G = gridDim.x * gridDim.y * gridDim.z;
    unsigned sum, cnt, mine, sp = 0u;
    for (;;) {
        sum = 0u; cnt = 0u; mine = 0u;
#pragma unroll
        for (unsigned j = 0; j < 16; ++j) { const unsigned c = xb_ld(&bar[XB_XCNT(j)]); sum += c; cnt += (c > 0u) ? 1u : 0u; mine = (j == x) ? c : mine; }
        if (sum == G) break;
        __builtin_amdgcn_s_sleep(1);
        if ((++sp & 255u) == 0u) { if (xb_ld(&bar[XB_TMO])) break; if (sp > XB_SPIN_CAP) { atomicAdd(&bar[XB_TMO], 1u); break; } }
    }
    nloc = mine > 0u ? mine : 1u; nx = cnt > 0u ? cnt : 1u;
}
__device__ __forceinline__ void xcd_barrier(const XcdBarrier& b) {
    asm volatile("s_waitcnt vmcnt(0)" ::: "memory");
    __syncthreads();
    if (threadIdx.x == 0) {
        unsigned* bar = b.bar;
        __builtin_amdgcn_s_waitcnt(0);
        unsigned nloc = b.st[0], nx = b.st[1];
        if (nloc == 0u) { xcd_barrier_complete(bar, b.x, nloc, nx); b.st[0] = nloc; b.st[1] = nx; }
        const unsigned old = xb_add(&bar[XB_XSUB(b.x)], 1u);
        const unsigned gen = old / nloc;
        if (old + 1u == (gen + 1u) * nloc) {
            __builtin_amdgcn_fence(__ATOMIC_RELEASE, "agent");
            asm volatile("s_waitcnt vmcnt(0)" ::: "memory");
            const unsigned og = xb_add(&bar[XB_TOP], 1u);
            const unsigned tg = og / nx;
            if (og + 1u == (tg + 1u) * nx) xb_add(&bar[XB_TOPGEN], 1u);
            else XB_SPIN(xb_ld(&bar[XB_TOPGEN]) == tg, bar);
            __builtin_amdgcn_fence(__ATOMIC_ACQUIRE, "agent");
            xb_add(&bar[XB_XGEN(b.x)], 1u);
            asm volatile("s_waitcnt vmcnt(0)" ::: "memory");
        } else {
            XB_SPIN(xb_ld(&bar[XB_XGEN(b.x)]) == gen, bar);
            __builtin_amdgcn_fence(__ATOMIC_ACQUIRE, "agent");
            asm volatile("s_waitcnt vmcnt(0)" ::: "memory");
        }
    }
    __syncthreads();
}

struct Args { const float* in[N_IN]; float* out; unsigned char* ws; int ph_lo, ph_hi; };

__device__ __forceinline__ void transpose_item(const float* W, int N, bf16* WT, int ldt, int item, LAS float* scr, int lane) {
    const int nblk = N / 32, kb = item / nblk, nb = item % nblk, k0 = 64 * kb, n0 = 32 * nb;
#pragma unroll 8
    for (int i = 0; i < 32; ++i) { const int kk = 2 * i + (lane >> 5); scr[kk * 33 + (lane & 31)] = W[(size_t)(k0 + kk) * N + n0 + (lane & 31)]; }
    LDS_WAIT(); asm volatile("" ::: "memory");
    const int c = lane & 7;
#pragma unroll
    for (int j = 0; j < 4; ++j) { const int n = (lane >> 3) + 8 * j; const LAS float* s = scr + (8 * c) * 33 + n;
        v4u o; o.x = cvt_pk_bf16(s[0 * 33], s[1 * 33]); o.y = cvt_pk_bf16(s[2 * 33], s[3 * 33]); o.z = cvt_pk_bf16(s[4 * 33], s[5 * 33]); o.w = cvt_pk_bf16(s[6 * 33], s[7 * 33]);
        *(v4u*)(WT + (size_t)(n0 + n) * ldt + k0 + 8 * c) = o; }
    LDS_WAIT(); asm volatile("" ::: "memory");
}

struct PrepCtx {
    const bf16* P; const float* sshift; const float* spool; const float* mu;
};
__device__ __forceinline__ void load_xl8(const PrepCtx& c, int m, int seq, int t, int col, float (&o)[8]) {
    const v4u cu = *(const v4u*)(c.P + (size_t)m * IN_COLS + col);
    float cur[8] = {bf_lo(cu.x), bf_hi(cu.x), bf_lo(cu.y), bf_hi(cu.y), bf_lo(cu.z), bf_hi(cu.z), bf_lo(cu.w), bf_hi(cu.w)};
    float pv[8];
    if (t > 0) { const v4u pu = *(const v4u*)(c.P + (size_t)(m - 1) * IN_COLS + col);
        pv[0] = bf_lo(pu.x); pv[1] = bf_hi(pu.x); pv[2] = bf_lo(pu.y); pv[3] = bf_hi(pu.y); pv[4] = bf_lo(pu.z); pv[5] = bf_hi(pu.z); pv[6] = bf_lo(pu.w); pv[7] = bf_hi(pu.w); }
    else if (seq >= NSEQ_P) { const float* s = c.sshift + (size_t)(seq - NSEQ_P) * RWKV_COLS + col; const f32x4 a = *(const f32x4*)s, b = *(const f32x4*)(s + 4);
        pv[0] = a[0]; pv[1] = a[1]; pv[2] = a[2]; pv[3] = a[3]; pv[4] = b[0]; pv[5] = b[1]; pv[6] = b[2]; pv[7] = b[3]; }
    else {
#pragma unroll
        for (int i = 0; i < 8; ++i) pv[i] = 0.f; }
    const f32x4 m0 = *(const f32x4*)(c.mu + col), m1 = *(const f32x4*)(c.mu + col + 4);
#pragma unroll
    for (int i = 0; i < 4; ++i) { o[i] = cur[i] + (pv[i] - cur[i]) * m0[i]; o[4 + i] = cur[4 + i] + (pv[4 + i] - cur[4 + i]) * m1[i]; }
}
__device__ __forceinline__ void load_xl4(const PrepCtx& c, int m, int seq, int t, int col, float (&o)[4]) {
    const v2u cu = *(const v2u*)(c.P + (size_t)m * IN_COLS + col);
    float cur[4] = {bf_lo(cu.x), bf_hi(cu.x), bf_lo(cu.y), bf_hi(cu.y)};
    float pv[4];
    if (t > 0) { const v2u pu = *(const v2u*)(c.P + (size_t)(m - 1) * IN_COLS + col); pv[0] = bf_lo(pu.x); pv[1] = bf_hi(pu.x); pv[2] = bf_lo(pu.y); pv[3] = bf_hi(pu.y); }
    else if (seq >= NSEQ_P) { const f32x4 a = *(const f32x4*)(c.sshift + (size_t)(seq - NSEQ_P) * RWKV_COLS + col); pv[0] = a[0]; pv[1] = a[1]; pv[2] = a[2]; pv[3] = a[3]; }
    else { pv[0] = pv[1] = pv[2] = pv[3] = 0.f; }
    const f32x4 m0 = *(const f32x4*)(c.mu + col);
#pragma unroll
    for (int i = 0; i < 4; ++i) o[i] = cur[i] + (pv[i] - cur[i]) * m0[i];
}
__device__ __forceinline__ bf16x8 pack8(const float (&f)[8]) {
    v4u u; u.x = cvt_pk_bf16(f[0], f[1]); u.y = cvt_pk_bf16(f[2], f[3]); u.z = cvt_pk_bf16(f[4], f[5]); u.w = cvt_pk_bf16(f[6], f[7]);
    return __builtin_bit_cast(bf16x8, u);
}
__device__ __forceinline__ v2u pack4(float a, float b, float c, float d) { v2u u; u.x = cvt_pk_bf16(a, b); u.y = cvt_pk_bf16(c, d); return u; }
#define MFMA16(a, b, c) __builtin_amdgcn_mfma_f32_16x16x32_bf16((a), (b), (c), 0, 0, 0)

__global__ void __launch_bounds__(NTHR, 2) mk_fwd(Args args) {
    extern __shared__ __attribute__((aligned(16))) unsigned char lds_raw[];
    LAS unsigned char* lds = (LAS unsigned char*)lds_raw;
    const int G = gridDim.x, NGW = G * NWAVES;
#define PH_IDS() const int tid = launder_tid(), lane = tid & 63, wave = __builtin_amdgcn_readfirstlane(tid >> 6), gw = blockIdx.x * NWAVES + wave; LAS float* scr = (LAS float*)(lds + wave * 16384); (void)lane; (void)gw; (void)scr
    unsigned char* ws = args.ws;
    float* out = args.out;
    unsigned* ctl = (unsigned*)(ws + WS_CTL);
    volatile LAS unsigned* MISC = (volatile LAS unsigned*)(lds + MISC_OFF);
    for (int u = threadIdx.x; u < (LDS_BYTES - LDSCTL_OFF) / 4; u += NTHR) ((LAS unsigned*)(lds + LDSCTL_OFF))[u] = 0u;
    __syncthreads();
    const int lo = args.ph_lo, hi = args.ph_hi;
    XcdBarrier bar; bar.bar = ctl + CW_BAR; bar.x = 0; bar.st = nullptr;
    if (hi - lo > 1) bar = xcd_barrier_post(ctl + CW_BAR, MISC + 8);
#define IN(k) (lo <= (k) && (k) < hi)
#define SEAM(k) do { if (IN(k) && IN((k) + 1)) xcd_barrier(bar); } while (0)

    float* X = out + O_Y;
    float* MOD = (float*)(ws + WS_MOD);
    bf16* SC = (bf16*)(ws + WS_SC);
    bf16* H = (bf16*)(ws + WS_H);
    bf16* P = (bf16*)(ws + WS_P);
    bf16* Rb = (bf16*)(ws + WS_R); bf16* K2b = (bf16*)(ws + WS_K2); bf16* Vb = (bf16*)(ws + WS_V); bf16* KKb = (bf16*)(ws + WS_KK); bf16* Bb = (bf16*)(ws + WS_B);
    float* Wd = (float*)(ws + WS_W);
    bf16* ORP = (bf16*)(ws + WS_ORP); bf16* Gb = (bf16*)(ws + WS_G); bf16* VF = (bf16*)(ws + WS_VF);
    float* Y = (float*)(ws + WS_Y);
    bf16* WIN_T = (bf16*)(ws + WS_WIN); bf16* WBR_T = (bf16*)(ws + WS_WBR); bf16* WOUT_T = (bf16*)(ws + WS_WOUT); bf16* WFF1_T = (bf16*)(ws + WS_WFF1); bf16* WFF2_T = (bf16*)(ws + WS_WFF2);
    bf16* W2T = (bf16*)(ws + WS_WSM + SM_W2); bf16* A2T = (bf16*)(ws + WS_WSM + SM_A2); bf16* G2T = (bf16*)(ws + WS_WSM + SM_G2);
    bf16* V1T = (bf16*)(ws + WS_WSM + SM_V1); bf16* V2T = (bf16*)(ws + WS_WSM + SM_V2); bf16* PWT = (bf16*)(ws + WS_WSM + SM_PW);
    bf16* ADA_T = P;

    int ph = 0;
    if (IN(ph)) { PH_IDS();
        constexpr int I_ADA = (D / 64) * (3072 / 32);
        for (int it = gw; it < 8 * I_ADA; it += NGW) { const int mat = it / I_ADA, r = it % I_ADA, l = mat >> 1, which = mat & 1;
            const float* W = (which ? args.in[I_WADAMLP] : args.in[I_WADAMIX]) + (size_t)l * D * 3072;
            transpose_item(W, 3072, ADA_T + (size_t)mat * 3072 * D, D, r, scr, lane); }
        for (int r = gw; r < 256; r += NGW) {
            const float* c = r < NSEQ_P ? args.in[I_CP] + (size_t)r * D : args.in[I_CS] + (size_t)(r - NSEQ_P) * D;
#pragma unroll
            for (int j = 0; j < 4; ++j) { f32x4 v = (f32x4){0.f, 0.f, 0.f, 0.f}; if (r < NSEQ) v = *(const f32x4*)(c + 4 * lane + 256 * j);
#pragma unroll
                for (int i = 0; i < 4; ++i) v[i] = v[i] * sigmoidf_(v[i]);
                *(v2u*)(SC + (size_t)r * D + 4 * lane + 256 * j) = pack4(v[0], v[1], v[2], v[3]); } }
        for (int m = gw; m < M; m += NGW) {
            const float* src = m < MP ? args.in[I_XP] + (size_t)m * D : args.in[I_XS] + (size_t)(m - MP) * D;
#pragma unroll
            for (int j = 0; j < 4; ++j) *(f32x4*)(X + (size_t)m * D + 4 * lane + 256 * j) = *(const f32x4*)(src + 4 * lane + 256 * j); }
    }
    SEAM(ph); ++ph;
    if (IN(ph)) {
        pg8::Gemm g{SC, ADA_T, 256, MODW, D}; pg8::StaticOrder S; S.init(256, MODW, G, (int)blockIdx.x);
        EpiMod E{0, MOD, args.in[I_BADAMIX], args.in[I_BADAMLP]};
        pg8::gemm_phase<EpiMod, pg8::StaticOrder, true, true>(lds, g, S, E);
    }
    SEAM(ph); ++ph;

    for (int l = 0; l < DEPTH; ++l) {
        const float* modmix = MOD + (size_t)(2 * l) * 3072;
        const float* modmlp = MOD + (size_t)(2 * l + 1) * 3072;
        if (IN(ph)) { PH_IDS();
            constexpr int N_IN_ = (D / 64) * (IN_COLS / 32), N_BR = (MIX / 64) * (D / 32), N_OUT = (D / 64) * (D / 32), N_F1 = (D / 64) * (DFF / 32), N_F2 = (DFF / 64) * (D / 32);
            constexpr int N_W2 = 1 * 16, N_G2 = 2 * 16, N_V1 = 8 * 1, N_PW = 4 * (2 * 4);
            constexpr int TOT = N_IN_ + 2 * N_BR + N_OUT + N_F1 + N_F2 + 2 * N_W2 + N_G2 + N_V1 + N_PW;
            for (int it = gw; it < TOT; it += NGW) { int r = it;
                if (r < N_IN_) { transpose_item(args.in[I_WIN] + (size_t)l * D * IN_COLS, IN_COLS, WIN_T, D, r, scr, lane); continue; } r -= N_IN_;
                if (r < N_BR) { transpose_item(args.in[I_WBRR] + (size_t)l * MIX * D, D, WBR_T, D, r, scr, lane); continue; } r -= N_BR;
                if (r < N_BR) { transpose_item(args.in[I_WBRP] + (size_t)l * POOLW * D, D, WBR_T + MIX, D, r, scr, lane); continue; } r -= N_BR;
                if (r < N_OUT) { transpose_item(args.in[I_WOUT] + (size_t)l * D * D, D, WOUT_T, D, r, scr, lane); continue; } r -= N_OUT;
                if (r < N_F1) { transpose_item(args.in[I_WFF1] + (size_t)l * D * DFF, DFF, WFF1_T, D, r, scr, lane); continue; } r -= N_F1;
                if (r < N_F2) { transpose_item(args.in[I_WFF2] + (size_t)l * DFF * D, D, WFF2_T, DFF, r, scr, lane); continue; } r -= N_F2;
                if (r < N_W2) { transpose_item(args.in[I_W2] + (size_t)l * 64 * MIX, MIX, W2T, 64, r, scr, lane); continue; } r -= N_W2;
                if (r < N_W2) { transpose_item(args.in[I_A2] + (size_t)l * 64 * MIX, MIX, A2T, 64, r, scr, lane); continue; } r -= N_W2;
                if (r < N_G2) { transpose_item(args.in[I_G2] + (size_t)l * 128 * MIX, MIX, G2T, 128, r, scr, lane); continue; } r -= N_G2;
                if (r < N_V1) { if (l > 0) transpose_item(args.in[I_V1] + (size_t)(l - 1) * MIX * 32, 32, V1T, MIX, r, scr, lane); continue; } r -= N_V1;
                { const int gi = r / 8; transpose_item(args.in[I_POOLW] + ((size_t)l * 4 + gi) * PGRP * PGRP, PGRP, PWT + (size_t)gi * PGRP * PGRP, PGRP, r % 8, scr, lane); }
            }
            if (l > 0) {
                const float* v2 = args.in[I_V2] + (size_t)(l - 1) * 32 * MIX;
                for (int e = blockIdx.x * NTHR + tid; e < 32 * MIX; e += G * NTHR) { const int n = e >> 5, k = e & 31; V2T[e] = (bf16)(cvt_pk_bf16(v2[(size_t)k * MIX + n], 0.f) & 0xffffu); }
            }
            const float* nw = args.in[I_NORMMIX] + (size_t)l * D;
            for (int m = gw; m < M; m += NGW) {
                const float* xr = X + (size_t)m * D; const float* mo = modmix + (size_t)row_seq(m) * MODW;
                f32x4 v[4]; float s = 0.f;
#pragma unroll
                for (int j = 0; j < 4; ++j) { v[j] = *(const f32x4*)(xr + 4 * lane + 256 * j); s += (v[j][0] * v[j][0] + v[j][1] * v[j][1]) + (v[j][2] * v[j][2] + v[j][3] * v[j][3]); }
                const float rstd = 1.0f / sqrtf(wave_sum(s) * (1.0f / D) + 1e-6f);
#pragma unroll
                for (int j = 0; j < 4; ++j) { const int c = 4 * lane + 256 * j; const f32x4 g = *(const f32x4*)(nw + c), sh = *(const f32x4*)(mo + c), sc = *(const f32x4*)(mo + 1024 + c);
                    f32x4 o;
#pragma unroll
                    for (int i = 0; i < 4; ++i) o[i] = v[j][i] * rstd * g[i] * (1.0f + sc[i]) + sh[i];
                    *(v2u*)(H + (size_t)m * D + c) = pack4(o[0], o[1], o[2], o[3]); }
            }
        }
        SEAM(ph); ++ph;
        if (IN(ph)) {
            pg8::Gemm g{H, WIN_T, M, IN_COLS, D}; pg8::StaticOrder S; S.init(M, IN_COLS, G, (int)blockIdx.x);
            EpiStoreBf16 E{0, P, IN_COLS, 0};
            pg8::gemm_phase<EpiStoreBf16, pg8::StaticOrder, true, true>(lds, g, S, E);
        }
        SEAM(ph); ++ph;
        if (IN(ph)) { PH_IDS();
            PrepCtx pc; pc.P = P; pc.sshift = args.in[I_SSHIFT] + (size_t)l * NSEQ_S * RWKV_COLS; pc.spool = args.in[I_SPOOL] + (size_t)l * NSEQ_S * PBUF * POOLW; pc.mu = args.in[I_MU] + (size_t)l * RWKV_COLS;
            const float* w0 = args.in[I_W0] + (size_t)l * MIX; const float* a0 = args.in[I_A0] + (size_t)l * MIX;
            const float* kkw = args.in[I_KK] + (size_t)l * MIX; const float* kaw = args.in[I_KA] + (size_t)l * MIX;
            const float* v0 = l > 0 ? args.in[I_V0] + (size_t)(l - 1) * MIX : nullptr;
            const float* pscale = args.in[I_POOLS] + (size_t)l * POOLW;
            constexpr int NTILE = M / 16, NTASK = 6 * NTILE + NSEQ;
            for (int task = gw; task < NTASK; task += NGW) {
                int ln_ = lane; asm volatile("" : "+v"(ln_));
                const int tok = ln_ & 15, q = ln_ >> 4;
                if (task >= 6 * NTILE) {
                    const int seq = task - 6 * NTILE;
                    if (seq < NSEQ_P) {
                        const int mlast = seq * T_P + T_P - 1;
                        float* so = out + O_SHP + ((size_t)l * NSEQ_P + seq) * RWKV_COLS;
                        for (int c = lane; c < RWKV_COLS; c += 64) so[c] = bf_lo((unsigned)P[(size_t)mlast * IN_COLS + c]);
                        float* po = out + O_POP + ((size_t)l * NSEQ_P + seq) * PBUF * POOLW;
                        for (int e = lane; e < PBUF * POOLW; e += 64) { const int i = e >> 9, c = e & 511; po[e] = bf_lo((unsigned)P[(size_t)(mlast - 14 + i) * IN_COLS + C_PP + c]); }
                    } else {
                        const int b = seq - NSEQ_P, mfirst = MP + b * T_S;
                        float* so = out + O_SHS + ((size_t)l * NSEQ_S + b) * RWKV_COLS;
                        for (int c = lane; c < RWKV_COLS; c += 64) so[c] = bf_lo((unsigned)P[(size_t)(mfirst + T_S - 1) * IN_COLS + c]);
                        float* po = out + O_POS + ((size_t)l * NSEQ_S + b) * PBUF * POOLW; const float* sp = pc.spool + (size_t)b * PBUF * POOLW;
                        for (int e = lane; e < PBUF * POOLW; e += 64) { const int i = e >> 9, c = e & 511;
                            po[e] = i < 7 ? sp[(size_t)(8 + i) * POOLW + c] : bf_lo((unsigned)P[(size_t)(mfirst + i - 7) * IN_COLS + C_PP + c]); }
                    }
                    continue;
                }
                const int type = task / NTILE, tile = task % NTILE, m = tile * 16 + tok, seq = row_seq(m), t = row_t(m);
                if (type == 0) {
#pragma unroll 2
                    for (int cb = q; cb < 64; cb += 4) { float x[8]; load_xl8(pc, m, seq, t, C_R + 8 * cb, x);
                        *(bf16x8*)(Rb + (size_t)m * MIX + 8 * cb) = pack8(x); }
                    if (l == 0)
#pragma unroll 2
                    for (int cb = q; cb < 64; cb += 4) { float x[8]; load_xl8(pc, m, seq, t, C_V + 8 * cb, x); const bf16x8 pk = pack8(x);
                        *(bf16x8*)(Vb + (size_t)m * MIX + 8 * cb) = pk; *(bf16x8*)(VF + (size_t)m * MIX + 8 * cb) = pk; }
                } else if (type == 1) {
                    bf16x8 af[2];
#pragma unroll
                    for (int ks = 0; ks < 2; ++ks) { float x[8]; load_xl8(pc, m, seq, t, C_XW + 32 * ks + 8 * q, x);
#pragma unroll
                        for (int i = 0; i < 8; ++i) x[i] = tanhf_(x[i]);
                        af[ks] = pack8(x); }
#pragma unroll 2
                    for (int nt = 0; nt < 32; ++nt) { f32x4 acc = (f32x4){0.f, 0.f, 0.f, 0.f};
#pragma unroll
                        for (int ks = 0; ks < 2; ++ks) { const bf16x8 wf = *(const bf16x8*)(W2T + (size_t)(16 * nt + tok) * 64 + 32 * ks + 8 * q); acc = MFMA16(wf, af[ks], acc); }
                        const int c = 16 * nt + 4 * q; const f32x4 w0v = *(const f32x4*)(w0 + c); f32x4 o;
#pragma unroll
                        for (int r = 0; r < 4; ++r) o[r] = __expf(-0.6065306597126334f * sigmoidf_(w0v[r] + acc[r]));
                        *(f32x4*)(Wd + (size_t)m * MIX + c) = o; }
                } else if (type == 2) {
                    bf16x8 af[2];
#pragma unroll
                    for (int ks = 0; ks < 2; ++ks) { float x[8]; load_xl8(pc, m, seq, t, C_XA + 32 * ks + 8 * q, x); af[ks] = pack8(x); }
#pragma unroll 1
                    for (int hh = 0; hh < NH; ++hh) {
                        float kv[4][4], av[4][4], kkv[4][4]; float ss = 0.f;
#pragma unroll
                        for (int n4 = 0; n4 < 4; ++n4) { const int nt = 4 * hh + n4; f32x4 acc = (f32x4){0.f, 0.f, 0.f, 0.f};
#pragma unroll
                            for (int ks = 0; ks < 2; ++ks) { const bf16x8 wf = *(const bf16x8*)(A2T + (size_t)(16 * nt + tok) * 64 + 32 * ks + 8 * q); acc = MFMA16(wf, af[ks], acc); }
                            const int c = 16 * nt + 4 * q; const f32x4 a0v = *(const f32x4*)(a0 + c), kkwv = *(const f32x4*)(kkw + c);
                            load_xl4(pc, m, seq, t, C_K + c, kv[n4]);
#pragma unroll
                            for (int r = 0; r < 4; ++r) { av[n4][r] = sigmoidf_(a0v[r] + acc[r]); kkv[n4][r] = kv[n4][r] * kkwv[r]; ss += kkv[n4][r] * kkv[n4][r]; } }
                        ss += __shfl_xor(ss, 16); ss += __shfl_xor(ss, 32);
                        const float rn = 1.0f / sqrtf(ss + 1e-12f);
#pragma unroll
                        for (int n4 = 0; n4 < 4; ++n4) { const int c = 16 * (4 * hh + n4) + 4 * q; const f32x4 kav = *(const f32x4*)(kaw + c);
                            float k2[4], kn[4], bb[4];
#pragma unroll
                            for (int r = 0; r < 4; ++r) { kn[r] = kkv[n4][r] * rn; k2[r] = kv[n4][r] * (1.0f + (av[n4][r] - 1.0f) * kav[r]); bb[r] = kn[r] * av[n4][r]; }
                            *(v2u*)(K2b + (size_t)m * MIX + c) = pack4(k2[0], k2[1], k2[2], k2[3]);
                            *(v2u*)(KKb + (size_t)m * MIX + c) = pack4(kn[0], kn[1], kn[2], kn[3]);
                            *(v2u*)(Bb + (size_t)m * MIX + c) = pack4(bb[0], bb[1], bb[2], bb[3]); }
                    }
                } else if (type == 3) {
                    bf16x8 af[4];
#pragma unroll
                    for (int ks = 0; ks < 4; ++ks) { float x[8]; load_xl8(pc, m, seq, t, C_XG + 32 * ks + 8 * q, x);
#pragma unroll
                        for (int i = 0; i < 8; ++i) x[i] = sigmoidf_(x[i]);
                        af[ks] = pack8(x); }
#pragma unroll 2
                    for (int nt = 0; nt < 32; ++nt) { f32x4 acc = (f32x4){0.f, 0.f, 0.f, 0.f};
#pragma unroll
                        for (int ks = 0; ks < 4; ++ks) { const bf16x8 wf = *(const bf16x8*)(G2T + (size_t)(16 * nt + tok) * 128 + 32 * ks + 8 * q); acc = MFMA16(wf, af[ks], acc); }
                        *(v2u*)(Gb + (size_t)m * MIX + 16 * nt + 4 * q) = pack4(acc[0], acc[1], acc[2], acc[3]); }
                } else if (type == 4) {
                    if (l > 0) {
                        f32x4 a1[2] = {(f32x4){0.f, 0.f, 0.f, 0.f}, (f32x4){0.f, 0.f, 0.f, 0.f}};
#pragma unroll 2
                        for (int ks = 0; ks < 16; ++ks) { float x[8]; load_xl8(pc, m, seq, t, C_V + 32 * ks + 8 * q, x); const bf16x8 af = pack8(x);
#pragma unroll
                            for (int nt = 0; nt < 2; ++nt) { const bf16x8 wf = *(const bf16x8*)(V1T + (size_t)(16 * nt + tok) * MIX + 32 * ks + 8 * q); a1[nt] = MFMA16(wf, af, a1[nt]); } }
                        float tt[8] = {a1[0][0], a1[0][1], a1[0][2], a1[0][3], a1[1][0], a1[1][1], a1[1][2], a1[1][3]};
                        const bf16x8 tf = pack8(tt);
#pragma unroll 2
                        for (int nt = 0; nt < 32; ++nt) {
                            const v2u wa = *(const v2u*)(V2T + (size_t)(16 * nt + tok) * 32 + 4 * q), wb = *(const v2u*)(V2T + (size_t)(16 * nt + tok) * 32 + 16 + 4 * q);
                            v4u wu; wu.x = wa.x; wu.y = wa.y; wu.z = wb.x; wu.w = wb.y;
                            const f32x4 acc = MFMA16(__builtin_bit_cast(bf16x8, wu), tf, ((f32x4){0.f, 0.f, 0.f, 0.f}));
                            const int c = 16 * nt + 4 * q; float vv[4]; load_xl4(pc, m, seq, t, C_V + c, vv);
                            const f32x4 v0v = *(const f32x4*)(v0 + c); const v2u vfu = *(const v2u*)(VF + (size_t)m * MIX + c);
                            const float vf[4] = {bf_lo(vfu.x), bf_hi(vfu.x), bf_lo(vfu.y), bf_hi(vfu.y)}; float o[4];
#pragma unroll
                            for (int r = 0; r < 4; ++r) o[r] = vv[r] + (vf[r] - vv[r]) * sigmoidf_(v0v[r] + acc[r]);
                            *(v2u*)(Vb + (size_t)m * MIX + c) = pack4(o[0], o[1], o[2], o[3]); }
                    }
                } else {
#pragma unroll 1
                    for (int gi = 0; gi < 4; ++gi) { const int win = 2 << gi; bf16x8 af[4];
#pragma unroll
                        for (int ks = 0; ks < 4; ++ks) { const int c = PGRP * gi + 32 * ks + 8 * q; float sum[8], cur[8];
                            __builtin_amdgcn_sched_barrier(0);
#pragma unroll
                            for (int i = 0; i < 8; ++i) { sum[i] = 0.f; cur[i] = 0.f; }
#pragma unroll 2
                            for (int i = 0; i < win; ++i) { const int tt = t - i; float x[8];
                                if (tt >= 0) { const v4u u = *(const v4u*)(P + (size_t)(m - i) * IN_COLS + C_PP + c);
                                    x[0] = bf_lo(u.x); x[1] = bf_hi(u.x); x[2] = bf_lo(u.y); x[3] = bf_hi(u.y); x[4] = bf_lo(u.z); x[5] = bf_hi(u.z); x[6] = bf_lo(u.w); x[7] = bf_hi(u.w); }
                                else if (seq >= NSEQ_P) { const float* s = pc.spool + ((size_t)(seq - NSEQ_P) * PBUF + (PBUF + tt)) * POOLW + c; const f32x4 a = *(const f32x4*)s, b = *(const f32x4*)(s + 4);
                                    x[0] = a[0]; x[1] = a[1]; x[2] = a[2]; x[3] = a[3]; x[4] = b[0]; x[5] = b[1]; x[6] = b[2]; x[7] = b[3]; }
                                else {
#pragma unroll
                                    for (int j = 0; j < 8; ++j) x[j] = 0.f; }
#pragma unroll
                                for (int j = 0; j < 8; ++j) { sum[j] += x[j]; if (i == 0) cur[j] = x[j]; } }
                            const float inv = 1.0f / (float)((seq < NSEQ_P && t + 1 < win) ? t + 1 : win);
#pragma unroll
                            for (int j = 0; j < 8; ++j) sum[j] = sum[j] * inv - cur[j];
                            af[ks] = pack8(sum); }
#pragma unroll 2
                        for (int nt = 0; nt < 8; ++nt) { f32x4 acc = (f32x4){0.f, 0.f, 0.f, 0.f};
#pragma unroll
                            for (int ks = 0; ks < 4; ++ks) { const bf16x8 wf = *(const bf16x8*)(PWT + ((size_t)gi * PGRP + 16 * nt + tok) * PGRP + 32 * ks + 8 * q); acc = MFMA16(wf, af[ks], acc); }
                            const int d = PGRP * gi + 16 * nt + 4 * q; const f32x4 sc = *(const f32x4*)(pscale + d);
                            *(v2u*)(ORP + (size_t)m * D + MIX + d) = pack4(acc[0] * sc[0], acc[1] * sc[1], acc[2] * sc[2], acc[3] * sc[3]); } }
                }
            }
        }
        SEAM(ph); ++ph;
        if (IN(ph)) { PH_IDS();
            LAS float* lw = (LAS float*)lds;
            LAS float* lkk = lw + 2048; LAS float* lb = lkk + 2048; LAS float* lk = lb + 2048; LAS float* lr = lk + 2048; LAS float* lv = lr + 2048; LAS float* ly = lv + 1024;
            constexpr int NITEM = NSEQ * NH * 2;
            const int rl = lane >> 4, kq = lane & 15, vrow = wave * 4 + rl;
            for (int item = blockIdx.x; item < NITEM; item += G) {
                const int seq = item >> 4, hh = (item >> 1) & 7, half = item & 1;
                const int T = seq < NSEQ_P ? T_P : T_S, mbase = seq < NSEQ_P ? seq * T_P : MP + (seq - NSEQ_P) * T_S;
                const int vg = 32 * half + vrow;
                f32x4 S = (f32x4){0.f, 0.f, 0.f, 0.f};
                if (seq >= NSEQ_P) S = *(const f32x4*)(args.in[I_SWKV] + ((((size_t)l * NSEQ_S + (seq - NSEQ_P)) * NH + hh) * HS + vg) * HS + 4 * kq);
                const int CH = T < 32 ? T : 32, nch = T / CH;
                const int st = tid >> 4, sk = (tid & 15) * 4;
                const bool sact = st < CH;
                f32x4 pw = (f32x4){0.f, 0.f, 0.f, 0.f}; v2u pkk = (v2u){0u, 0u}, pb = pkk, pk = pkk, pr = pkk; unsigned pv = 0u;
#define SCAN_LOAD(c0) do { if (sact) { const size_t mm = (size_t)(mbase + (c0) + st) * MIX + 64 * hh; pw = *(const f32x4*)(Wd + mm + sk); pkk = *(const v2u*)(KKb + mm + sk); pb = *(const v2u*)(Bb + mm + sk); \
                    pk = *(const v2u*)(K2b + mm + sk); pr = *(const v2u*)(Rb + mm + sk); pv = *(const unsigned*)(Vb + mm + 32 * half + (tid & 15) * 2); } } while (0)
#define SCAN_STORE() do { if (sact) { *(LAS f32x4*)(lw + st * 64 + sk) = pw; *(LAS f32x4*)(lkk + st * 64 + sk) = (f32x4){bf_lo(pkk.x), bf_hi(pkk.x), bf_lo(pkk.y), bf_hi(pkk.y)}; \
                    *(LAS f32x4*)(lb + st * 64 + sk) = (f32x4){bf_lo(pb.x), bf_hi(pb.x), bf_lo(pb.y), bf_hi(pb.y)}; *(LAS f32x4*)(lk + st * 64 + sk) = (f32x4){bf_lo(pk.x), bf_hi(pk.x), bf_lo(pk.y), bf_hi(pk.y)}; \
                    *(LAS f32x4*)(lr + st * 64 + sk) = (f32x4){bf_lo(pr.x), bf_hi(pr.x), bf_lo(pr.y), bf_hi(pr.y)}; *(LAS f32x2*)(lv + st * 32 + (tid & 15) * 2) = (f32x2){bf_lo(pv), bf_hi(pv)}; } } while (0)
                SCAN_LOAD(0);
                for (int ch = 0; ch < nch; ++ch) {
                    __syncthreads();
                    SCAN_STORE();
                    __syncthreads();
                    if (ch + 1 < nch) SCAN_LOAD((ch + 1) * CH);
                    for (int s = 0; s < CH; ++s) {
                        const f32x4 w4 = *(const LAS f32x4*)(lw + s * 64 + 4 * kq), kk4 = *(const LAS f32x4*)(lkk + s * 64 + 4 * kq), b4 = *(const LAS f32x4*)(lb + s * 64 + 4 * kq),
                                    k4 = *(const LAS f32x4*)(lk + s * 64 + 4 * kq), r4 = *(const LAS f32x4*)(lr + s * 64 + 4 * kq);
                        const float vv = lv[s * 32 + vrow];
                        float sa = (S[0] * kk4[0] + S[1] * kk4[1]) + (S[2] * kk4[2] + S[3] * kk4[3]);
                        sa += __shfl_xor(sa, 1); sa += __shfl_xor(sa, 2); sa += __shfl_xor(sa, 4); sa += __shfl_xor(sa, 8);
                        sa = -sa;
#pragma unroll
                        for (int j = 0; j < 4; ++j) S[j] = S[j] * w4[j] + sa * b4[j] + vv * k4[j];
                        float y = (S[0] * r4[0] + S[1] * r4[1]) + (S[2] * r4[2] + S[3] * r4[3]);
                        y += __shfl_xor(y, 1); y += __shfl_xor(y, 2); y += __shfl_xor(y, 4); y += __shfl_xor(y, 8);
                        if (kq == 0) ly[s * 32 + vrow] = y;
                    }
                    __syncthreads();
                    if (sact) { const f32x2 yy = *(const LAS f32x2*)(ly + st * 32 + (tid & 15) * 2);
                        *(f32x2*)(Y + (size_t)(mbase + ch * CH + st) * MIX + 64 * hh + 32 * half + (tid & 15) * 2) = yy; }
                }
                float* so = seq < NSEQ_P ? out + O_WKP + ((((size_t)l * NSEQ_P + seq) * NH + hh) * HS + vg) * HS + 4 * kq
                                         : out + O_WKS + ((((size_t)l * NSEQ_S + (seq - NSEQ_P)) * NH + hh) * HS + vg) * HS + 4 * kq;
                *(f32x4*)so = S;
                __syncthreads();
            }
#undef SCAN_LOAD
#undef SCAN_STORE
        }
        SEAM(ph); ++ph;
        if (IN(ph)) { PH_IDS();
            const float* lnw = args.in[I_LNW] + (size_t)l * MIX; const float* lnb = args.in[I_LNB] + (size_t)l * MIX; const float* rk = args.in[I_RK] + (size_t)l * MIX;
            const int c = 8 * lane;
            for (int m = gw; m < M; m += NGW) {
                const f32x4 y0 = *(const f32x4*)(Y + (size_t)m * MIX + c), y1 = *(const f32x4*)(Y + (size_t)m * MIX + c + 4);
                float y[8] = {y0[0], y0[1], y0[2], y0[3], y1[0], y1[1], y1[2], y1[3]};
                float s = 0.f;
#pragma unroll
                for (int i = 0; i < 8; ++i) s += y[i];
                s += __shfl_xor(s, 1); s += __shfl_xor(s, 2); s += __shfl_xor(s, 4);
                const float mean = s * (1.0f / 64.0f); float q2 = 0.f;
#pragma unroll
                for (int i = 0; i < 8; ++i) { y[i] -= mean; q2 += y[i] * y[i]; }
                q2 += __shfl_xor(q2, 1); q2 += __shfl_xor(q2, 2); q2 += __shfl_xor(q2, 4);
                const float rstd = 1.0f / sqrtf(q2 * (1.0f / 64.0f) + 64e-5f);
                const v4u ru = *(const v4u*)(Rb + (size_t)m * MIX + c), ku = *(const v4u*)(K2b + (size_t)m * MIX + c), vu = *(const v4u*)(Vb + (size_t)m * MIX + c), gu = *(const v4u*)(Gb + (size_t)m * MIX + c);
                const float rr[8] = {bf_lo(ru.x), bf_hi(ru.x), bf_lo(ru.y), bf_hi(ru.y), bf_lo(ru.z), bf_hi(ru.z), bf_lo(ru.w), bf_hi(ru.w)};
                const float kk[8] = {bf_lo(ku.x), bf_hi(ku.x), bf_lo(ku.y), bf_hi(ku.y), bf_lo(ku.z), bf_hi(ku.z), bf_lo(ku.w), bf_hi(ku.w)};
                const float vv[8] = {bf_lo(vu.x), bf_hi(vu.x), bf_lo(vu.y), bf_hi(vu.y), bf_lo(vu.z), bf_hi(vu.z), bf_lo(vu.w), bf_hi(vu.w)};
                const float gg[8] = {bf_lo(gu.x), bf_hi(gu.x), bf_lo(gu.y), bf_hi(gu.y), bf_lo(gu.z), bf_hi(gu.z), bf_lo(gu.w), bf_hi(gu.w)};
                const f32x4 rk0 = *(const f32x4*)(rk + c), rk1 = *(const f32x4*)(rk + c + 4), w0 = *(const f32x4*)(lnw + c), w1 = *(const f32x4*)(lnw + c + 4), b0 = *(const f32x4*)(lnb + c), b1 = *(const f32x4*)(lnb + c + 4);
                float bs = 0.f;
#pragma unroll
                for (int i = 0; i < 4; ++i) bs += rr[i] * kk[i] * rk0[i] + rr[4 + i] * kk[4 + i] * rk1[i];
                bs += __shfl_xor(bs, 1); bs += __shfl_xor(bs, 2); bs += __shfl_xor(bs, 4);
                float o[8];
#pragma unroll
                for (int i = 0; i < 4; ++i) { o[i] = (y[i] * rstd * w0[i] + b0[i] + bs * vv[i]) * gg[i]; o[4 + i] = (y[4 + i] * rstd * w1[i] + b1[i] + bs * vv[4 + i]) * gg[4 + i]; }
                *(bf16x8*)(ORP + (size_t)m * D + c) = pack8(o);
            }
        }
        SEAM(ph); ++ph;
        if (IN(ph)) {
            pg8::Gemm g{ORP, WBR_T, M, D, D}; pg8::StaticOrder S; S.init(M, D, G, (int)blockIdx.x);
            EpiMerge E{8, P, H};
            pg8::gemm_phase<EpiMerge, pg8::StaticOrder, true, true>(lds, g, S, E);
        }
        SEAM(ph); ++ph;
        if (IN(ph)) {
            pg8::Gemm g{H, WOUT_T, M, D, D}; pg8::StaticOrder S; S.init(M, D, G, (int)blockIdx.x);
            EpiRes E{0, X, modmix + 2048};
            pg8::gemm_phase<EpiRes, pg8::StaticOrder, true, true>(lds, g, S, E);
        }
        SEAM(ph); ++ph;
        if (IN(ph)) { PH_IDS();
            const float* nw = args.in[I_NORMMLP] + (size_t)l * D;
            for (int m = gw; m < M; m += NGW) {
                const float* xr = X + (size_t)m * D; const float* mo = modmlp + (size_t)row_seq(m) * MODW;
                f32x4 v[4]; float s = 0.f;
#pragma unroll
                for (int j = 0; j < 4; ++j) { v[j] = *(const f32x4*)(xr + 4 * lane + 256 * j); s += (v[j][0] * v[j][0] + v[j][1] * v[j][1]) + (v[j][2] * v[j][2] + v[j][3] * v[j][3]); }
                const float rstd = 1.0f / sqrtf(wave_sum(s) * (1.0f / D) + 1e-6f);
#pragma unroll
                for (int j = 0; j < 4; ++j) { const int c = 4 * lane + 256 * j; const f32x4 g = *(const f32x4*)(nw + c), sh = *(const f32x4*)(mo + c), sc = *(const f32x4*)(mo + 1024 + c);
                    f32x4 o;
#pragma unroll
                    for (int i = 0; i < 4; ++i) o[i] = v[j][i] * rstd * g[i] * (1.0f + sc[i]) + sh[i];
                    *(v2u*)(H + (size_t)m * D + c) = pack4(o[0], o[1], o[2], o[3]); }
            }
        }
        SEAM(ph); ++ph;
        if (IN(ph)) {
            pg8::Gemm g{H, WFF1_T, M, DFF, D}; pg8::StaticOrder S; S.init(M, DFF, G, (int)blockIdx.x);
            EpiStoreBf16 E{0, P, DFF, 1};
            pg8::gemm_phase<EpiStoreBf16, pg8::StaticOrder, true, true>(lds, g, S, E);
        }
        SEAM(ph); ++ph;
        if (IN(ph)) {
            pg8::Gemm g{P, WFF2_T, M, D, DFF}; pg8::StaticOrder S; S.init(M, D, G, (int)blockIdx.x);
            EpiRes E{0, X, modmlp + 2048};
            pg8::gemm_phase<EpiRes, pg8::StaticOrder, true, true>(lds, g, S, E);
        }
        SEAM(ph); ++ph;
    }
    if (IN(ph)) { PH_IDS();
        const float* nw = args.in[I_NORMF];
        for (int m = gw; m < M; m += NGW) {
            float* xr = X + (size_t)m * D;
            f32x4 v[4]; float s = 0.f;
#pragma unroll
            for (int j = 0; j < 4; ++j) { v[j] = *(const f32x4*)(xr + 4 * lane + 256 * j); s += (v[j][0] * v[j][0] + v[j][1] * v[j][1]) + (v[j][2] * v[j][2] + v[j][3] * v[j][3]); }
            const float rstd = 1.0f / sqrtf(wave_sum(s) * (1.0f / D) + 1e-6f);
#pragma unroll
            for (int j = 0; j < 4; ++j) { const int c = 4 * lane + 256 * j; const f32x4 g = *(const f32x4*)(nw + c); *(f32x4*)(xr + c) = v[j] * rstd * g; }
        }
    }
#undef IN
#undef SEAM
}

constexpr int N_PHASES = 2 + DEPTH * 10 + 1;

extern "C" void kernel_launch(void* const* d_in, const int* in_sizes, int n_in, void* d_out, int out_size, void* d_ws, size_t ws_size, hipStream_t stream) {
    static int grid = 0;
    if (grid == 0) {
        if (n_in != N_IN || (size_t)out_size != O_END || ws_size < WS_END) { fprintf(stderr, "kernel_launch: shape mismatch n_in %d out %d ws %zu\n", n_in, out_size, ws_size); grid = -1; return; }
        int dev = 0, cus = 0, per_cu = 0;
        if (hipGetDevice(&dev) != hipSuccess || hipDeviceGetAttribute(&cus, hipDeviceAttributeMultiprocessorCount, dev) != hipSuccess) { grid = -1; return; }
        if (hipFuncSetAttribute((const void*)mk_fwd, hipFuncAttributeMaxDynamicSharedMemorySize, LDS_BYTES) != hipSuccess) { fprintf(stderr, "kernel_launch: hipFuncSetAttribute failed\n"); grid = -1; return; }
        if (hipOccupancyMaxActiveBlocksPerMultiprocessor(&per_cu, (const void*)mk_fwd, NTHR, LDS_BYTES) != hipSuccess || per_cu < 1) { fprintf(stderr, "kernel_launch: occupancy query says %d\n", per_cu); per_cu = 1; }
        (void)hipGetLastError();
        grid = cus;
    }
    if (grid < 0) return;
    (void)hipMemsetAsync((char*)d_ws + WS_CTL, 0, CTL_ZERO_BYTES, stream);
    Args a{};
    for (int i = 0; i < N_IN; ++i) a.in[i] = (const float*)d_in[i];
    a.out = (float*)d_out; a.ws = (unsigned char*)d_ws;
#if MK_ONE_LAUNCH
    a.ph_lo = 0; a.ph_hi = N_PHASES;
    hipLaunchKernelGGL(mk_fwd, dim3(grid), dim3(NTHR), LDS_BYTES, stream, a);
#else
    for (int p = 0; p < N_PHASES; ++p) { a.ph_lo = p; a.ph_hi = p + 1; hipLaunchKernelGGL(mk_fwd, dim3(grid), dim3(NTHR), LDS_BYTES, stream, a); }
#endif
}
```

```cpp
#include <hip/hip_runtime.h>
#include <cstdio>
#include <cstdint>

#ifndef MK_ONE_LAUNCH
#define MK_ONE_LAUNCH 1
#endif

#define GAS __attribute__((address_space(1)))
#define LAS __attribute__((address_space(3)))
typedef unsigned short bf16;
typedef unsigned v4u __attribute__((ext_vector_type(4)));
typedef unsigned v2u __attribute__((ext_vector_type(2)));
typedef float f32x4 __attribute__((ext_vector_type(4)));
typedef float f32x2 __attribute__((ext_vector_type(2)));
typedef short bf16x8 __attribute__((ext_vector_type(8)));

constexpr int D = 1024, DEPTH = 4, NSEQ_P = 8, T_P = 2048, NSEQ_S = 128, T_S = 8;
constexpr int MP = NSEQ_P * T_P, MS = NSEQ_S * T_S, M = MP + MS;
constexpr int NSEQ = NSEQ_P + NSEQ_S;
constexpr int MIX = 512, HS = 64, NH = 8, POOLW = 512, PGRP = 128, PBUF = 15, DFF = 4096;
constexpr int RWKV_COLS = 1792, IN_COLS = 4352;
constexpr int C_R = 0, C_K = 512, C_V = 1024, C_XW = 1536, C_XA = 1600, C_XG = 1664, C_PP = 1792, C_GR = 2304, C_GP = 3328;
constexpr int MODW = 8 * 3072;
constexpr int NWAVES = 8, NTHR = 512;

enum { I_XP = 0, I_XS, I_SSHIFT, I_SPOOL, I_SWKV, I_CP, I_CS, I_WADAMIX, I_BADAMIX, I_NORMMIX, I_WIN, I_MU, I_W0, I_W2, I_A0, I_A2, I_G2,
       I_V0, I_V1, I_V2, I_KK, I_KA, I_RK, I_LNW, I_LNB, I_POOLW, I_POOLS, I_WBRR, I_WBRP, I_WOUT, I_WADAMLP, I_BADAMLP, I_NORMMLP, I_WFF1, I_WFF2, I_NORMF, N_IN };
constexpr size_t O_Y = 0, O_SHP = (size_t)M * D, O_POP = O_SHP + 4 * 8 * 1792, O_WKP = O_POP + 4 * 8 * 15 * 512, O_SHS = O_WKP + 4 * 8 * 8 * 4096,
                 O_POS = O_SHS + 4 * 128 * 1792, O_WKS = O_POS + (size_t)4 * 128 * 15 * 512, O_END = O_WKS + (size_t)4 * 128 * 8 * 4096;

constexpr size_t MiB = 1u << 20;
constexpr size_t WS_CTL = 0, CTL_ZERO_BYTES = 1 * MiB;
constexpr size_t WS_MOD = 1 * MiB;
constexpr size_t WS_SC = 14 * MiB;
constexpr size_t WS_WIN = 16 * MiB;
constexpr size_t WS_WBR = 25 * MiB;
constexpr size_t WS_WOUT = 27 * MiB;
constexpr size_t WS_WFF1 = 29 * MiB;
constexpr size_t WS_WFF2 = 37 * MiB;
constexpr size_t WS_WSM = 45 * MiB;
constexpr size_t SM_W2 = 0, SM_A2 = 65536, SM_G2 = 131072, SM_V1 = 262144, SM_V2 = 294912, SM_PW = 327680;
constexpr size_t WS_H = 48 * MiB;
constexpr size_t WS_P = 82 * MiB;
constexpr size_t WS_R = 227 * MiB, WS_K2 = 244 * MiB, WS_V = 261 * MiB, WS_KK = 278 * MiB, WS_B = 295 * MiB;
constexpr size_t WS_W = 312 * MiB;
constexpr size_t WS_ORP = 346 * MiB;
constexpr size_t WS_G = 380 * MiB;
constexpr size_t WS_VF = 397 * MiB;
constexpr size_t WS_Y = 414 * MiB;
constexpr size_t WS_END = 448 * MiB;

constexpr int CW_BAR = 4096;

constexpr int RING_BYTES = 131072, LDSCTL_OFF = RING_BYTES, MISC_OFF = LDSCTL_OFF + 320, LDS_BYTES = 147456;

typedef __bf16 bf16x2_t __attribute__((ext_vector_type(2)));
__device__ __forceinline__ unsigned cvt_pk_bf16(float lo, float hi) { f32x2 v = {lo, hi}; bf16x2_t b = __builtin_convertvector(v, bf16x2_t); return __builtin_bit_cast(unsigned, b); }
__device__ __forceinline__ float bf_lo(unsigned u) { return __builtin_bit_cast(float, u << 16); }
__device__ __forceinline__ float bf_hi(unsigned u) { return __builtin_bit_cast(float, u & 0xffff0000u); }
__device__ __forceinline__ float sigmoidf_(float x) { return 1.0f / (1.0f + __expf(-x)); }
__device__ __forceinline__ float tanhf_(float x) { return 1.0f - 2.0f / (1.0f + __expf(2.0f * x)); }
__device__ __forceinline__ float wave_sum(float v) {
#pragma unroll
    for (int o = 1; o < 64; o <<= 1) v += __shfl_xor(v, o);
    return v;
}
__device__ __forceinline__ int launder_tid() { int t = threadIdx.x; asm volatile("" : "+v"(t)); return t; }
#define LDS_WAIT() asm volatile("s_waitcnt lgkmcnt(0)" ::: "memory")
#define VM_WAIT() asm volatile("s_waitcnt vmcnt(0)" ::: "memory")

namespace pg8 {
#define PG8_LAS __attribute__((address_space(3)))
typedef unsigned short bf16_t;
constexpr int BM = 256, BK = 64, HALF = 128, HTB = HALF * BK * 2, STAGE_BYTES = 8 * HTB, NXCD = 8, WGM = 8;

__host__ __device__ __forceinline__ int lds_byte(int r, int c) { const int st = (r >> 4) * 2 + (c >> 5), rr = r & 15, cc = c & 31, ob = rr * 64 + cc * 2; return st * 1024 + (ob ^ (((ob >> 9) & 1) << 5)); }
__host__ __device__ __forceinline__ void stage_rc(int b, int& R, int& C) { const int st = b / 1024, sb = b % 1024, swz = sb ^ (((sb >> 9) & 1) << 5); R = (st >> 1) * 16 + swz / 64; C = (st & 1) * 32 + (swz % 64) / 2; }
__host__ __device__ __forceinline__ int perm32(int rho) { const int n = rho >> 4, i = rho & 15; return 8 * (i >> 2) + 4 * n + (i & 3); }

struct Unit { int pm, pn; };
struct Gemm { const bf16_t* A; const bf16_t* Bt; int M, N, K; };

struct StaticOrder {
    int nM, nN, nwg, G, c;
    __host__ __device__ void init(int M_, int N_, int G_, int c_) { nM = M_ / BM; nN = N_ / BM; nwg = nM * nN; G = G_; c = c_; }
    __host__ __device__ bool next(int i, Unit& u) const {
        const long L = (long)i * G + c; if (L >= nwg) return false;
        int wgid = (int)L; { const int q = nwg / NXCD, r = nwg % NXCD, xcd = wgid % NXCD, off = wgid / NXCD; wgid = (xcd < r ? xcd * (q + 1) : r * (q + 1) + (xcd - r) * q) + off; }
        const int nig = WGM * nN, gid = wgid / nig, fm = gid * WGM, gsz = (nM - fm) < WGM ? (nM - fm) : WGM;
        u.pm = fm + ((wgid % nig) % gsz); u.pn = (wgid % nig) / gsz; return true;
    }
};

template <class Epi, class Sched, bool ALIGN_EPI = false, bool SP2 = false>
__device__ __forceinline__ void gemm_phase(PG8_LAS unsigned char* lds, const Gemm g, const Sched& S, const Epi& E) {
    const int tid = launder_tid(), wid = __builtin_amdgcn_readfirstlane(tid >> 6), lane = tid & 63, wr = wid >> 2, wc = wid & 3, fr = lane & 15, fq = lane >> 4;
    const int K = g.K, nt = K / BK;
    unsigned voffA[2], voffB[2];
#pragma unroll
    for (int i = 0; i < 2; ++i) { int R, C; stage_rc(tid * 16 + i * 8192, R, C); const int Rb = (R & ~31) + perm32(R & 31);
        voffA[i] = (unsigned)(R * K + C) * 2u; voffB[i] = (unsigned)(Rb * K + C) * 2u; }
    const size_t kstep = (size_t)(BK * 2);
    const size_t hstep = (size_t)HALF * K * 2;
    const size_t tstep = 2 * hstep;
    const unsigned ldsw = (unsigned)wid * 1024u;
    const int aoff = lds_byte(wr * 64 + fr, fq * 8), boff = lds_byte(wc * 32 + fr, fq * 8);
#define PG8_SA(b, h) (((b) * 2 + (h)) * HTB)
#define PG8_SB(b, h) ((4 + (b) * 2 + (h)) * HTB)
#define PG8_STAGE(bufoff, gbase, voff) do { _Pragma("unroll") for (int _i = 0; _i < 2; ++_i) \
        __builtin_amdgcn_global_load_lds((const unsigned*)((const char*)(gbase) + (voff)[_i]), (PG8_LAS unsigned*)(lds + (bufoff) + ldsw + _i * 8192), 16, 0, 0); } while (0)
#define PG8_LDA(dst, b, h) do { _Pragma("unroll") for (int m = 0; m < 4; ++m) _Pragma("unroll") for (int k = 0; k < 2; ++k) dst[m][k] = *(const PG8_LAS bf16x8*)(lds + PG8_SA(b, h) + aoff + m * 2048 + k * 1024); } while (0)
#define PG8_LDB(dst, b, h) do { _Pragma("unroll") for (int n = 0; n < 2; ++n) _Pragma("unroll") for (int k = 0; k < 2; ++k) dst[n][k] = *(const PG8_LAS bf16x8*)(lds + PG8_SB(b, h) + boff + n * 2048 + k * 1024); } while (0)
#define PG8_MMA(ai, bj, At, Bt) do { __builtin_amdgcn_s_setprio(1); _Pragma("unroll") for (int m = 0; m < 4; ++m) _Pragma("unroll") for (int n = 0; n < 2; ++n) _Pragma("unroll") for (int k = 0; k < 2; ++k) \
        acc[ai][bj][m][n] = __builtin_amdgcn_mfma_f32_16x16x32_bf16(Bt[n][k], At[m][k], acc[ai][bj][m][n], 0, 0, 0); __builtin_amdgcn_s_setprio(0); } while (0)
#define PG8_WAIT_V(n) asm volatile("s_waitcnt vmcnt(" #n ")" ::: "memory")
#define PG8_WAIT_L(n) asm volatile("s_waitcnt lgkmcnt(" #n ")" ::: "memory")
#define PG8_BAR __builtin_amdgcn_s_barrier()
#define PG8_SCHED __builtin_amdgcn_sched_barrier(0)
    Unit cur, nxt; int ui = 0;
    if (!S.next(0, cur)) return;
    f32x4 acc[2][2][4][2];
#pragma unroll
    for (int a = 0; a < 2; ++a)
#pragma unroll
        for (int b = 0; b < 2; ++b)
#pragma unroll
            for (int m = 0; m < 4; ++m)
#pragma unroll
                for (int n = 0; n < 2; ++n) acc[a][b][m][n] = (f32x4){0.f, 0.f, 0.f, 0.f};
    bf16x8 At[4][2], B0[2][2], B1[2][2];
    const char* cA = (const char*)g.A + (size_t)cur.pm * tstep; const char* cB = (const char*)g.Bt + (size_t)cur.pn * tstep;
    if constexpr (SP2) {
        PG8_STAGE(PG8_SB(0, 0), cB, voffB); PG8_STAGE(PG8_SB(0, 1), cB + hstep, voffB); PG8_STAGE(PG8_SA(0, 0), cA, voffA); PG8_STAGE(PG8_SA(0, 1), cA + hstep, voffA);
        if (wr == 1) PG8_BAR;
        PG8_WAIT_V(2); PG8_BAR;
        PG8_STAGE(PG8_SB(1, 0), cB + kstep, voffB); PG8_STAGE(PG8_SA(1, 0), cA + kstep, voffA); PG8_STAGE(PG8_SB(1, 1), cB + hstep + kstep, voffB);
        PG8_WAIT_V(6); PG8_BAR;
    } else {
        PG8_STAGE(PG8_SB(0, 0), cB, voffB); PG8_STAGE(PG8_SA(0, 0), cA, voffA); PG8_STAGE(PG8_SB(0, 1), cB + hstep, voffB); PG8_STAGE(PG8_SA(0, 1), cA + hstep, voffA);
        if (wr == 1) PG8_BAR;
        PG8_WAIT_V(4); PG8_BAR;
        PG8_STAGE(PG8_SB(1, 0), cB + kstep, voffB); PG8_STAGE(PG8_SA(1, 0), cA + kstep, voffA); PG8_STAGE(PG8_SB(1, 1), cB + hstep + kstep, voffB);
        PG8_WAIT_V(6); PG8_BAR;
    }
    for (;;) {
        const bool has_next = S.next(ui + 1, nxt);
        const char* nA = has_next ? (const char*)g.A + (size_t)nxt.pm * tstep : cA; const char* nB = has_next ? (const char*)g.Bt + (size_t)nxt.pn * tstep : cB;
        for (int t = 0; t < nt; t += 2) {
            const bool last = (t == nt - 2);
            const char* a1 = cA + (size_t)(t + 1) * kstep;
            const char* a2 = last ? nA : cA + (size_t)(t + 2) * kstep; const char* b2 = last ? nB : cB + (size_t)(t + 2) * kstep;
            const char* a3 = a2 + kstep; const char* b3 = b2 + kstep;
            if constexpr (Epi::HOOK) { if (t == E.hook_t) E.hook(acc, cur, wr, wc, fr, fq); }
            if constexpr (SP2) {
            PG8_LDB(B0, 0, 0); PG8_LDB(B1, 0, 1); PG8_SCHED; PG8_LDA(At, 0, 0); PG8_STAGE(PG8_SA(1, 1), a1 + hstep, voffA);
            PG8_WAIT_V(8); PG8_WAIT_L(0); PG8_BAR; PG8_MMA(0, 0, At, B0); PG8_MMA(0, 1, At, B1); PG8_BAR; PG8_SCHED;
            PG8_LDA(At, 0, 1); PG8_STAGE(PG8_SB(0, 0), b2, voffB); PG8_STAGE(PG8_SB(0, 1), b2 + hstep, voffB); PG8_STAGE(PG8_SA(0, 0), a2, voffA);
            PG8_WAIT_V(8); PG8_WAIT_L(0); PG8_BAR; PG8_MMA(1, 0, At, B0); PG8_MMA(1, 1, At, B1); PG8_BAR; PG8_SCHED;
            PG8_LDB(B0, 1, 0); PG8_LDB(B1, 1, 1); PG8_SCHED; PG8_LDA(At, 1, 0); PG8_STAGE(PG8_SA(0, 1), a2 + hstep, voffA);
            PG8_WAIT_V(8); PG8_WAIT_L(0); PG8_BAR; PG8_MMA(0, 0, At, B0); PG8_MMA(0, 1, At, B1); PG8_BAR; PG8_SCHED;
            PG8_LDA(At, 1, 1); PG8_STAGE(PG8_SB(1, 0), b3, voffB); PG8_STAGE(PG8_SB(1, 1), b3 + hstep, voffB); PG8_STAGE(PG8_SA(1, 0), a3, voffA);
            PG8_WAIT_V(8); PG8_WAIT_L(0); PG8_BAR; PG8_MMA(1, 0, At, B0); PG8_MMA(1, 1, At, B1); PG8_BAR; PG8_SCHED;
            } else {
            PG8_LDB(B0, 0, 0); PG8_SCHED; PG8_LDA(At, 0, 0); PG8_STAGE(PG8_SA(1, 1), a1 + hstep, voffA);
            PG8_WAIT_L(8); PG8_BAR; PG8_WAIT_L(0); PG8_MMA(0, 0, At, B0); PG8_BAR; PG8_SCHED;
            PG8_LDB(B1, 0, 1); PG8_STAGE(PG8_SB(0, 0), b2, voffB);
            PG8_BAR; PG8_WAIT_L(0); PG8_MMA(0, 1, At, B1); PG8_BAR;
            PG8_LDA(At, 0, 1); PG8_STAGE(PG8_SA(0, 0), a2, voffA);
            PG8_BAR; PG8_WAIT_L(0); PG8_MMA(1, 0, At, B0); PG8_BAR; PG8_SCHED;
            PG8_STAGE(PG8_SB(0, 1), b2 + hstep, voffB);
            PG8_WAIT_V(6); PG8_BAR; PG8_MMA(1, 1, At, B1); PG8_BAR;
            PG8_LDB(B0, 1, 0); PG8_SCHED; PG8_LDA(At, 1, 0); PG8_STAGE(PG8_SA(0, 1), a2 + hstep, voffA);
            PG8_WAIT_L(8); PG8_BAR; PG8_WAIT_L(0); PG8_MMA(0, 0, At, B0); PG8_BAR; PG8_SCHED;
            PG8_LDB(B1, 1, 1); PG8_STAGE(PG8_SB(1, 0), b3, voffB);
            PG8_BAR; PG8_WAIT_L(0); PG8_MMA(0, 1, At, B1); PG8_BAR;
            PG8_LDA(At, 1, 1); PG8_STAGE(PG8_SA(1, 0), a3, voffA);
            PG8_BAR; PG8_WAIT_L(0); PG8_MMA(1, 0, At, B0); PG8_BAR; PG8_SCHED;
            PG8_STAGE(PG8_SB(1, 1), b3 + hstep, voffB);
            PG8_WAIT_V(6); PG8_BAR; PG8_MMA(1, 1, At, B1); PG8_BAR;
            }
        }
        if constexpr (ALIGN_EPI) { if (wr == 0) PG8_BAR; }
        E(acc, cur, wr, wc, fr, fq);
        if (!has_next) break;
#pragma unroll
        for (int a = 0; a < 2; ++a)
#pragma unroll
            for (int b = 0; b < 2; ++b)
#pragma unroll
                for (int m = 0; m < 4; ++m)
#pragma unroll
                    for (int n = 0; n < 2; ++n) acc[a][b][m][n] = (f32x4){0.f, 0.f, 0.f, 0.f};
        cur = nxt; cA = nA; cB = nB; ++ui;
        if constexpr (ALIGN_EPI) { if (wr == 1) PG8_BAR; }
    }
    PG8_WAIT_V(0);
    if constexpr (!ALIGN_EPI) { if (wr == 0) PG8_BAR; }
    PG8_BAR;
#undef PG8_SA
#undef PG8_SB
#undef PG8_STAGE
#undef PG8_LDA
#undef PG8_LDB
#undef PG8_MMA
#undef PG8_WAIT_V
#undef PG8_WAIT_L
#undef PG8_BAR
#undef PG8_SCHED
}
}

__device__ __forceinline__ int row_seq(int m) { return m < MP ? (m >> 11) : NSEQ_P + ((m - MP) >> 3); }
__device__ __forceinline__ int row_t(int m) { return m < MP ? (m & (T_P - 1)) : ((m - MP) & (T_S - 1)); }

struct EpiBase { static constexpr bool HOOK = false; int hook_t; };

struct EpiStoreBf16 {
    static constexpr bool HOOK = false; int hook_t;
    bf16* O; int ldc; int act;
    __device__ __forceinline__ void hook(f32x4 (&)[2][2][4][2], const pg8::Unit&, int, int, int, int) const {}
    __device__ __forceinline__ void operator()(const f32x4 (&acc)[2][2][4][2], const pg8::Unit& u, int wr, int wc, int fr, int fq) const {
        asm volatile("" : "+v"(fr), "+v"(fq));
        const int row0 = u.pm * 256 + wr * 64 + fr, col0 = u.pn * 256 + wc * 32 + 8 * fq;
#pragma unroll
        for (int ai = 0; ai < 2; ++ai)
#pragma unroll
            for (int m = 0; m < 4; ++m) { bf16* rowp = O + (size_t)(row0 + ai * 128 + m * 16) * ldc + col0;
#pragma unroll
                for (int bj = 0; bj < 2; ++bj) { f32x4 v0 = acc[ai][bj][m][0], v1 = acc[ai][bj][m][1];
                    if (act == 1) {
#pragma unroll
                        for (int j = 0; j < 4; ++j) { float a = fmaxf(v0[j], 0.f), b = fmaxf(v1[j], 0.f); v0[j] = a * a; v1[j] = b * b; } }
                    v4u w; w.x = cvt_pk_bf16(v0[0], v0[1]); w.y = cvt_pk_bf16(v0[2], v0[3]); w.z = cvt_pk_bf16(v1[0], v1[1]); w.w = cvt_pk_bf16(v1[2], v1[3]);
                    *(v4u*)(rowp + bj * 128) = w; } }
    }
};

struct EpiMod {
    static constexpr bool HOOK = false; int hook_t;
    float* O; const float* bmix; const float* bmlp;
    __device__ __forceinline__ void hook(f32x4 (&)[2][2][4][2], const pg8::Unit&, int, int, int, int) const {}
    __device__ __forceinline__ void operator()(const f32x4 (&acc)[2][2][4][2], const pg8::Unit& u, int wr, int wc, int fr, int fq) const {
        asm volatile("" : "+v"(fr), "+v"(fq));
        const int row0 = u.pm * 256 + wr * 64 + fr, col0 = u.pn * 256 + wc * 32 + 8 * fq;
        const int mat = (u.pn * 256) / 3072, l = mat >> 1, which = mat & 1;
        const float* bias = (which ? bmlp : bmix) + l * 3072 - mat * 3072;
#pragma unroll
        for (int ai = 0; ai < 2; ++ai)
#pragma unroll
            for (int m = 0; m < 4; ++m) { const int row = row0 + ai * 128 + m * 16; if (row >= NSEQ) continue;
#pragma unroll
                for (int bj = 0; bj < 2; ++bj) { const int col = col0 + bj * 128;
                    const f32x4 b0 = *(const f32x4*)(bias + col), b1 = *(const f32x4*)(bias + col + 4);
                    *(f32x4*)(O + (size_t)row * MODW + col) = acc[ai][bj][m][0] + b0; *(f32x4*)(O + (size_t)row * MODW + col + 4) = acc[ai][bj][m][1] + b1; } }
    }
};

struct EpiRes {
    static constexpr bool HOOK = false; int hook_t;
    float* X; const float* gate;
    __device__ __forceinline__ void hook(f32x4 (&)[2][2][4][2], const pg8::Unit&, int, int, int, int) const {}
    __device__ __forceinline__ void operator()(const f32x4 (&acc)[2][2][4][2], const pg8::Unit& u, int wr, int wc, int fr, int fq) const {
        asm volatile("" : "+v"(fr), "+v"(fq));
        const int row0 = u.pm * 256 + wr * 64 + fr, col0 = u.pn * 256 + wc * 32 + 8 * fq;
#pragma unroll
        for (int ai = 0; ai < 2; ++ai)
#pragma unroll
            for (int m = 0; m < 4; ++m) { const int row = row0 + ai * 128 + m * 16; const float* gr = gate + (size_t)row_seq(row) * MODW; float* xr = X + (size_t)row * D;
#pragma unroll
                for (int bj = 0; bj < 2; ++bj) { const int col = col0 + bj * 128;
                    const f32x4 g0 = *(const f32x4*)(gr + col), g1 = *(const f32x4*)(gr + col + 4);
                    f32x4 x0 = *(const f32x4*)(xr + col), x1 = *(const f32x4*)(xr + col + 4);
                    x0 += g0 * acc[ai][bj][m][0]; x1 += g1 * acc[ai][bj][m][1];
                    *(f32x4*)(xr + col) = x0; *(f32x4*)(xr + col + 4) = x1; } }
    }
};

struct EpiMerge {
    static constexpr bool HOOK = true; int hook_t;
    const bf16* P; bf16* O;
    __device__ __forceinline__ void hook(f32x4 (&acc)[2][2][4][2], const pg8::Unit& u, int wr, int wc, int fr, int fq) const {
        asm volatile("" : "+v"(fr), "+v"(fq));
        const int row0 = u.pm * 256 + wr * 64 + fr, col0 = u.pn * 256 + wc * 32 + 8 * fq;
#pragma unroll
        for (int ai = 0; ai < 2; ++ai)
#pragma unroll
            for (int m = 0; m < 4; ++m) { const bf16* pr = P + (size_t)(row0 + ai * 128 + m * 16) * IN_COLS + col0;
#pragma unroll
                for (int bj = 0; bj < 2; ++bj) { const v4u a = *(const v4u*)(pr + C_GR + bj * 128), b = *(const v4u*)(pr + C_GP + bj * 128);
                    float ga[8] = {bf_lo(a.x), bf_hi(a.x), bf_lo(a.y), bf_hi(a.y), bf_lo(a.z), bf_hi(a.z), bf_lo(a.w), bf_hi(a.w)};
                    float gb[8] = {bf_lo(b.x), bf_hi(b.x), bf_lo(b.y), bf_hi(b.y), bf_lo(b.z), bf_hi(b.z), bf_lo(b.w), bf_hi(b.w)};
#pragma unroll
                    for (int j = 0; j < 4; ++j) { acc[ai][bj][m][0][j] *= (1.0f + __expf(-gb[j])) / (1.0f + __expf(-ga[j]));
                                                  acc[ai][bj][m][1][j] *= (1.0f + __expf(-gb[4 + j])) / (1.0f + __expf(-ga[4 + j])); } } }
    }
    __device__ __forceinline__ void operator()(const f32x4 (&acc)[2][2][4][2], const pg8::Unit& u, int wr, int wc, int fr, int fq) const {
        asm volatile("" : "+v"(fr), "+v"(fq));
        const int row0 = u.pm * 256 + wr * 64 + fr, col0 = u.pn * 256 + wc * 32 + 8 * fq;
#pragma unroll
        for (int ai = 0; ai < 2; ++ai)
#pragma unroll
            for (int m = 0; m < 4; ++m) { const size_t row = (size_t)(row0 + ai * 128 + m * 16); const bf16* pr = P + row * IN_COLS + col0;
#pragma unroll
                for (int bj = 0; bj < 2; ++bj) { const v4u b = *(const v4u*)(pr + C_GP + bj * 128);
                    float gb[8] = {bf_lo(b.x), bf_hi(b.x), bf_lo(b.y), bf_hi(b.y), bf_lo(b.z), bf_hi(b.z), bf_lo(b.w), bf_hi(b.w)};
                    f32x4 v0 = acc[ai][bj][m][0], v1 = acc[ai][bj][m][1];
#pragma unroll
                    for (int j = 0; j < 4; ++j) { v0[j] *= sigmoidf_(gb[j]); v1[j] *= sigmoidf_(gb[4 + j]); }
                    v4u w; w.x = cvt_pk_bf16(v0[0], v0[1]); w.y = cvt_pk_bf16(v0[2], v0[3]); w.z = cvt_pk_bf16(v1[0], v1[1]); w.w = cvt_pk_bf16(v1[2], v1[3]);
                    *(v4u*)(O + row * D + col0 + bj * 128) = w; } }
    }
};

#define XB_TMO      128
#define XB_XCNT(j)  (256  + 64 * (j))
#define XB_XSUB(j)  (1280 + 64 * (j))
#define XB_XGEN(j)  (2304 + 64 * (j))
#define XB_TOP      3328
#define XB_TOPGEN   3392
#define XCD_BAR_WORDS 3456
#define XB_SPIN_CAP (1u << 22)

__device__ __forceinline__ unsigned xb_ld(unsigned* p)              { return __hip_atomic_load(p, __ATOMIC_RELAXED, __HIP_MEMORY_SCOPE_AGENT); }
__device__ __forceinline__ unsigned xb_add(unsigned* p, unsigned v) { return __hip_atomic_fetch_add(p, v, __ATOMIC_RELAXED, __HIP_MEMORY_SCOPE_AGENT); }
__device__ __forceinline__ unsigned xb_xcc_id() { return (unsigned)__builtin_amdgcn_s_getreg((3 << 11) | 20) & 0xFu; }
#define XB_SPIN(cond, bar) do { unsigned _sp = 0; while (cond) { __builtin_amdgcn_s_sleep(1); \
    if ((++_sp & 255u) == 0u) { if (xb_ld(&(bar)[XB_TMO])) break; if (_sp > XB_SPIN_CAP) { atomicAdd(&(bar)[XB_TMO], 1u); break; } } } } while (0)

struct XcdBarrier { unsigned* bar; unsigned x; volatile LAS unsigned* st; };

__device__ __forceinline__ XcdBarrier xcd_barrier_post(unsigned* bar, volatile LAS unsigned* st) {
    XcdBarrier b; b.bar = bar; b.x = xb_xcc_id(); b.st = st;
    if (threadIdx.x == 0) (void)xb_add(&bar[XB_XCNT(b.x)], 1u);
    return b;
}
__device__ __forceinline__ void xcd_barrier_complete(unsigned* bar, unsigned x, unsigned& nloc, unsigned& nx) {
    const unsigned G = gridDim.x * gridDim.y * gridDim.z;
    unsigned sum, cnt, mine, sp = 0u;
    for (;;) {
        sum = 0u; cnt = 0u; mine = 0u;
#pragma unroll
        for (unsigned j = 0; j < 16; ++j) { const unsigned c = xb_ld(&bar[XB_XCNT(j)]); sum += c; cnt += (c > 0u) ? 1u : 0u; mine = (j == x) ? c : mine; }
        if (sum == G) break;
        __builtin_amdgcn_s_sleep(1);
        if ((++sp & 255u) == 0u) { if (xb_ld(&bar[XB_TMO])) break; if (sp > XB_SPIN_CAP) { atomicAdd(&bar[XB_TMO], 1u); break; } }
    }
    nloc = mine > 0u ? mine : 1u; nx = cnt > 0u ? cnt : 1u;
}
__device__ __forceinline__ void xcd_barrier(const XcdBarrier& b) {
    asm volatile("s_waitcnt vmcnt(0)" ::: "memory");
    __syncthreads();
    if (threadIdx.x == 0) {
        unsigned* bar = b.bar;
        __builtin_amdgcn_s_waitcnt(0);
        unsigned nloc = b.st[0], nx = b.st[1];
        if (nloc == 0u) { xcd_barrier_complete(bar, b.x, nloc, nx); b.st[0] = nloc; b.st[1] = nx; }
        const unsigned old = xb_add(&bar[XB_XSUB(b.x)], 1u);
        const unsigned gen = old / nloc;
        if (old + 1u == (gen + 1u) * nloc) {
            __builtin_amdgcn_fence(__ATOMIC_RELEASE, "agent");
            asm volatile("s_waitcnt vmcnt(0)" ::: "memory");
            const unsigned og = xb_add(&bar[XB_TOP], 1u);
            const unsigned tg = og / nx;
            if (og + 1u == (tg + 1u) * nx) xb_add(&bar[XB_TOPGEN], 1u);
            else XB_SPIN(xb_ld(&bar[XB_TOPGEN]) == tg, bar);
            __builtin_amdgcn_fence(__ATOMIC_ACQUIRE, "agent");
            xb_add(&bar[XB_XGEN(b.x)], 1u);
            asm volatile("s_waitcnt vmcnt(0)" ::: "memory");
        } else {
            XB_SPIN(xb_ld(&bar[XB_XGEN(b.x)]) == gen, bar);
            __builtin_amdgcn_fence(__ATOMIC_ACQUIRE, "agent");
            asm volatile("s_waitcnt vmcnt(0)" ::: "memory");
        }
    }
    __syncthreads();
}

struct Args { const float* in[N_IN]; float* out; unsigned char* ws; int ph_lo, ph_hi; };

__device__ __forceinline__ void transpose_item(const float* W, int N, bf16* WT, int ldt, int item, LAS float* scr, int lane) {
    const int nblk = N / 32, kb = item / nblk, nb = item % nblk, k0 = 64 * kb, n0 = 32 * nb;
#pragma unroll 8
    for (int i = 0; i < 32; ++i) { const int kk = 2 * i + (lane >> 5); scr[kk * 33 + (lane & 31)] = W[(size_t)(k0 + kk) * N + n0 + (lane & 31)]; }
    LDS_WAIT(); asm volatile("" ::: "memory");
    const int c = lane & 7;
#pragma unroll
    for (int j = 0; j < 4; ++j) { const int n = (lane >> 3) + 8 * j; const LAS float* s = scr + (8 * c) * 33 + n;
        v4u o; o.x = cvt_pk_bf16(s[0 * 33], s[1 * 33]); o.y = cvt_pk_bf16(s[2 * 33], s[3 * 33]); o.z = cvt_pk_bf16(s[4 * 33], s[5 * 33]); o.w = cvt_pk_bf16(s[6 * 33], s[7 * 33]);
        *(v4u*)(WT + (size_t)(n0 + n) * ldt + k0 + 8 * c) = o; }
    LDS_WAIT(); asm volatile("" ::: "memory");
}

struct PrepCtx {
    const bf16* P; const float* sshift; const float* spool; const float* mu;
};
__device__ __forceinline__ void load_xl8(const PrepCtx& c, int m, int seq, int t, int col, float (&o)[8]) {
    const v4u cu = *(const v4u*)(c.P + (size_t)m * IN_COLS + col);
    float cur[8] = {bf_lo(cu.x), bf_hi(cu.x), bf_lo(cu.y), bf_hi(cu.y), bf_lo(cu.z), bf_hi(cu.z), bf_lo(cu.w), bf_hi(cu.w)};
    float pv[8];
    if (t > 0) { const v4u pu = *(const v4u*)(c.P + (size_t)(m - 1) * IN_COLS + col);
        pv[0] = bf_lo(pu.x); pv[1] = bf_hi(pu.x); pv[2] = bf_lo(pu.y); pv[3] = bf_hi(pu.y); pv[4] = bf_lo(pu.z); pv[5] = bf_hi(pu.z); pv[6] = bf_lo(pu.w); pv[7] = bf_hi(pu.w); }
    else if (seq >= NSEQ_P) { const float* s = c.sshift + (size_t)(seq - NSEQ_P) * RWKV_COLS + col; const f32x4 a = *(const f32x4*)s, b = *(const f32x4*)(s + 4);
        pv[0] = a[0]; pv[1] = a[1]; pv[2] = a[2]; pv[3] = a[3]; pv[4] = b[0]; pv[5] = b[1]; pv[6] = b[2]; pv[7] = b[3]; }
    else {
#pragma unroll
        for (int i = 0; i < 8; ++i) pv[i] = 0.f; }
    const f32x4 m0 = *(const f32x4*)(c.mu + col), m1 = *(const f32x4*)(c.mu + col + 4);
#pragma unroll
    for (int i = 0; i < 4; ++i) { o[i] = cur[i] + (pv[i] - cur[i]) * m0[i]; o[4 + i] = cur[4 + i] + (pv[4 + i] - cur[4 + i]) * m1[i]; }
}
__device__ __forceinline__ void load_xl4(const PrepCtx& c, int m, int seq, int t, int col, float (&o)[4]) {
    const v2u cu = *(const v2u*)(c.P + (size_t)m * IN_COLS + col);
    float cur[4] = {bf_lo(cu.x), bf_hi(cu.x), bf_lo(cu.y), bf_hi(cu.y)};
    float pv[4];
    if (t > 0) { const v2u pu = *(const v2u*)(c.P + (size_t)(m - 1) * IN_COLS + col); pv[0] = bf_lo(pu.x); pv[1] = bf_hi(pu.x); pv[2] = bf_lo(pu.y); pv[3] = bf_hi(pu.y); }
    else if (seq >= NSEQ_P) { const f32x4 a = *(const f32x4*)(c.sshift + (size_t)(seq - NSEQ_P) * RWKV_COLS + col); pv[0] = a[0]; pv[1] = a[1]; pv[2] = a[2]; pv[3] = a[3]; }
    else { pv[0] = pv[1] = pv[2] = pv[3] = 0.f; }
    const f32x4 m0 = *(const f32x4*)(c.mu + col);
#pragma unroll
    for (int i = 0; i < 4; ++i) o[i] = cur[i] + (pv[i] - cur[i]) * m0[i];
}
__device__ __forceinline__ bf16x8 pack8(const float (&f)[8]) {
    v4u u; u.x = cvt_pk_bf16(f[0], f[1]); u.y = cvt_pk_bf16(f[2], f[3]); u.z = cvt_pk_bf16(f[4], f[5]); u.w = cvt_pk_bf16(f[6], f[7]);
    return __builtin_bit_cast(bf16x8, u);
}
__device__ __forceinline__ v2u pack4(float a, float b, float c, float d) { v2u u; u.x = cvt_pk_bf16(a, b); u.y = cvt_pk_bf16(c, d); return u; }
#define MFMA16(a, b, c) __builtin_amdgcn_mfma_f32_16x16x32_bf16((a), (b), (c), 0, 0, 0)

__global__ void __launch_bounds__(NTHR, 2) mk_fwd(Args args) {
    extern __shared__ __attribute__((aligned(16))) unsigned char lds_raw[];
    LAS unsigned char* lds = (LAS unsigned char*)lds_raw;
    const int G = gridDim.x, NGW = G * NWAVES;
#define PH_IDS() const int tid = launder_tid(), lane = tid & 63, wave = __builtin_amdgcn_readfirstlane(tid >> 6), gw = blockIdx.x * NWAVES + wave; LAS float* scr = (LAS float*)(lds + wave * 16384); (void)lane; (void)gw; (void)scr
    unsigned char* ws = args.ws;
    float* out = args.out;
    unsigned* ctl = (unsigned*)(ws + WS_CTL);
    volatile LAS unsigned* MISC = (volatile LAS unsigned*)(lds + MISC_OFF);
    for (int u = threadIdx.x; u < (LDS_BYTES - LDSCTL_OFF) / 4; u += NTHR) ((LAS unsigned*)(lds + LDSCTL_OFF))[u] = 0u;
    __syncthreads();
    const int lo = args.ph_lo, hi = args.ph_hi;
    XcdBarrier bar; bar.bar = ctl + CW_BAR; bar.x = 0; bar.st = nullptr;
    if (hi - lo > 1) bar = xcd_barrier_post(ctl + CW_BAR, MISC + 8);
#define IN(k) (lo <= (k) && (k) < hi)
#define SEAM(k) do { if (IN(k) && IN((k) + 1)) xcd_barrier(bar); } while (0)

    float* X = out + O_Y;
    float* MOD = (float*)(ws + WS_MOD);
    bf16* SC = (bf16*)(ws + WS_SC);
    bf16* H = (bf16*)(ws + WS_H);
    bf16* P = (bf16*)(ws + WS_P);
    bf16* Rb = (bf16*)(ws + WS_R); bf16* K2b = (bf16*)(ws + WS_K2); bf16* Vb = (bf16*)(ws + WS_V); bf16* KKb = (bf16*)(ws + WS_KK); bf16* Bb = (bf16*)(ws + WS_B);
    float* Wd = (float*)(ws + WS_W);
    bf16* ORP = (bf16*)(ws + WS_ORP); bf16* Gb = (bf16*)(ws + WS_G); bf16* VF = (bf16*)(ws + WS_VF);
    float* Y = (float*)(ws + WS_Y);
    bf16* WIN_T = (bf16*)(ws + WS_WIN); bf16* WBR_T = (bf16*)(ws + WS_WBR); bf16* WOUT_T = (bf16*)(ws + WS_WOUT); bf16* WFF1_T = (bf16*)(ws + WS_WFF1); bf16* WFF2_T = (bf16*)(ws + WS_WFF2);
    bf16* W2T = (bf16*)(ws + WS_WSM + SM_W2); bf16* A2T = (bf16*)(ws + WS_WSM + SM_A2); bf16* G2T = (bf16*)(ws + WS_WSM + SM_G2);
    bf16* V1T = (bf16*)(ws + WS_WSM + SM_V1); bf16* V2T = (bf16*)(ws + WS_WSM + SM_V2); bf16* PWT = (bf16*)(ws + WS_WSM + SM_PW);
    bf16* ADA_T = P;

    int ph = 0;
    if (IN(ph)) { PH_IDS();
        constexpr int I_ADA = (D / 64) * (3072 / 32);
        for (int it = gw; it < 8 * I_ADA; it += NGW) { const int mat = it / I_ADA, r = it % I_ADA, l = mat >> 1, which = mat & 1;
            const float* W = (which ? args.in[I_WADAMLP] : args.in[I_WADAMIX]) + (size_t)l * D * 3072;
            transpose_item(W, 3072, ADA_T + (size_t)mat * 3072 * D, D, r, scr, lane); }
        for (int r = gw; r < 256; r += NGW) {
            const float* c = r < NSEQ_P ? args.in[I_CP] + (size_t)r * D : args.in[I_CS] + (size_t)(r - NSEQ_P) * D;
#pragma unroll
            for (int j = 0; j < 4; ++j) { f32x4 v = (f32x4){0.f, 0.f, 0.f, 0.f}; if (r < NSEQ) v = *(const f32x4*)(c + 4 * lane + 256 * j);
#pragma unroll
                for (int i = 0; i < 4; ++i) v[i] = v[i] * sigmoidf_(v[i]);
                *(v2u*)(SC + (size_t)r * D + 4 * lane + 256 * j) = pack4(v[0], v[1], v[2], v[3]); } }
        for (int m = gw; m < M; m += NGW) {
            const float* src = m < MP ? args.in[I_XP] + (size_t)m * D : args.in[I_XS] + (size_t)(m - MP) * D;
#pragma unroll
            for (int j = 0; j < 4; ++j) *(f32x4*)(X + (size_t)m * D + 4 * lane + 256 * j) = *(const f32x4*)(src + 4 * lane + 256 * j); }
    }
    SEAM(ph); ++ph;
    if (IN(ph)) {
        pg8::Gemm g{SC, ADA_T, 256, MODW, D}; pg8::StaticOrder S; S.init(256, MODW, G, (int)blockIdx.x);
        EpiMod E{0, MOD, args.in[I_BADAMIX], args.in[I_BADAMLP]};
        pg8::gemm_phase<EpiMod, pg8::StaticOrder, true, true>(lds, g, S, E);
    }
    SEAM(ph); ++ph;

    for (int l = 0; l < DEPTH; ++l) {
        const float* modmix = MOD + (size_t)(2 * l) * 3072;
        const float* modmlp = MOD + (size_t)(2 * l + 1) * 3072;
        if (IN(ph)) { PH_IDS();
            constexpr int N_IN_ = (D / 64) * (IN_COLS / 32), N_BR = (MIX / 64) * (D / 32), N_OUT = (D / 64) * (D / 32), N_F1 = (D / 64) * (DFF / 32), N_F2 = (DFF / 64) * (D / 32);
            constexpr int N_W2 = 1 * 16, N_G2 = 2 * 16, N_V1 = 8 * 1, N_PW = 4 * (2 * 4);
            constexpr int TOT = N_IN_ + 2 * N_BR + N_OUT + N_F1 + N_F2 + 2 * N_W2 + N_G2 + N_V1 + N_PW;
            for (int it = gw; it < TOT; it += NGW) { int r = it;
                if (r < N_IN_) { transpose_item(args.in[I_WIN] + (size_t)l * D * IN_COLS, IN_COLS, WIN_T, D, r, scr, lane); continue; } r -= N_IN_;
                if (r < N_BR) { transpose_item(args.in[I_WBRR] + (size_t)l * MIX * D, D, WBR_T, D, r, scr, lane); continue; } r -= N_BR;
                if (r < N_BR) { transpose_item(args.in[I_WBRP] + (size_t)l * POOLW * D, D, WBR_T + MIX, D, r, scr, lane); continue; } r -= N_BR;
                if (r < N_OUT) { transpose_item(args.in[I_WOUT] + (size_t)l * D * D, D, WOUT_T, D, r, scr, lane); continue; } r -= N_OUT;
                if (r < N_F1) { transpose_item(args.in[I_WFF1] + (size_t)l * D * DFF, DFF, WFF1_T, D, r, scr, lane); continue; } r -= N_F1;
                if (r < N_F2) { transpose_item(args.in[I_WFF2] + (size_t)l * DFF * D, D, WFF2_T, DFF, r, scr, lane); continue; } r -= N_F2;
                if (r < N_W2) { transpose_item(args.in[I_W2] + (size_t)l * 64 * MIX, MIX, W2T, 64, r, scr, lane); continue; } r -= N_W2;
                if (r < N_W2) { transpose_item(args.in[I_A2] + (size_t)l * 64 * MIX, MIX, A2T, 64, r, scr, lane); continue; } r -= N_W2;
                if (r < N_G2) { transpose_item(args.in[I_G2] + (size_t)l * 128 * MIX, MIX, G2T, 128, r, scr, lane); continue; } r -= N_G2;
                if (r < N_V1) { if (l > 0) transpose_item(args.in[I_V1] + (size_t)(l - 1) * MIX * 32, 32, V1T, MIX, r, scr, lane); continue; } r -= N_V1;
                { const int gi = r / 8; transpose_item(args.in[I_POOLW] + ((size_t)l * 4 + gi) * PGRP * PGRP, PGRP, PWT + (size_t)gi * PGRP * PGRP, PGRP, r % 8, scr, lane); }
            }
            if (l > 0) {
                const float* v2 = args.in[I_V2] + (size_t)(l - 1) * 32 * MIX;
                for (int e = blockIdx.x * NTHR + tid; e < 32 * MIX; e += G * NTHR) { const int n = e >> 5, k = e & 31; V2T[e] = (bf16)(cvt_pk_bf16(v2[(size_t)k * MIX + n], 0.f) & 0xffffu); }
            }
            const float* nw = args.in[I_NORMMIX] + (size_t)l * D;
            for (int m = gw; m < M; m += NGW) {
                const float* xr = X + (size_t)m * D; const float* mo = modmix + (size_t)row_seq(m) * MODW;
                f32x4 v[4]; float s = 0.f;
#pragma unroll
                for (int j = 0; j < 4; ++j) { v[j] = *(const f32x4*)(xr + 4 * lane + 256 * j); s += (v[j][0] * v[j][0] + v[j][1] * v[j][1]) + (v[j][2] * v[j][2] + v[j][3] * v[j][3]); }
                const float rstd = 1.0f / sqrtf(wave_sum(s) * (1.0f / D) + 1e-6f);
#pragma unroll
                for (int j = 0; j < 4; ++j) { const int c = 4 * lane + 256 * j; const f32x4 g = *(const f32x4*)(nw + c), sh = *(const f32x4*)(mo + c), sc = *(const f32x4*)(mo + 1024 + c);
                    f32x4 o;
#pragma unroll
                    for (int i = 0; i < 4; ++i) o[i] = v[j][i] * rstd * g[i] * (1.0f + sc[i]) + sh[i];
                    *(v2u*)(H + (size_t)m * D + c) = pack4(o[0], o[1], o[2], o[3]); }
            }
        }
        SEAM(ph); ++ph;
        if (IN(ph)) {
            pg8::Gemm g{H, WIN_T, M, IN_COLS, D}; pg8::StaticOrder S; S.init(M, IN_COLS, G, (int)blockIdx.x);
            EpiStoreBf16 E{0, P, IN_COLS, 0};
            pg8::gemm_phase<EpiStoreBf16, pg8::StaticOrder, true, true>(lds, g, S, E);
        }
        SEAM(ph); ++ph;
        if (IN(ph)) { PH_IDS();
            PrepCtx pc; pc.P = P; pc.sshift = args.in[I_SSHIFT] + (size_t)l * NSEQ_S * RWKV_COLS; pc.spool = args.in[I_SPOOL] + (size_t)l * NSEQ_S * PBUF * POOLW; pc.mu = args.in[I_MU] + (size_t)l * RWKV_COLS;
            const float* w0 = args.in[I_W0] + (size_t)l * MIX; const float* a0 = args.in[I_A0] + (size_t)l * MIX;
            const float* kkw = args.in[I_KK] + (size_t)l * MIX; const float* kaw = args.in[I_KA] + (size_t)l * MIX;
            const float* v0 = l > 0 ? args.in[I_V0] + (size_t)(l - 1) * MIX : nullptr;
            const float* pscale = args.in[I_POOLS] + (size_t)l * POOLW;
            constexpr int NTILE = M / 16, NTASK = 6 * NTILE + NSEQ;
            for (int task = gw; task < NTASK; task += NGW) {
                int ln_ = lane; asm volatile("" : "+v"(ln_));
                const int tok = ln_ & 15, q = ln_ >> 4;
                if (task >= 6 * NTILE) {
                    const int seq = task - 6 * NTILE;
                    if (seq < NSEQ_P) {
                        const int mlast = seq * T_P + T_P - 1;
                        float* so = out + O_SHP + ((size_t)l * NSEQ_P + seq) * RWKV_COLS;
                        for (int c = lane; c < RWKV_COLS; c += 64) so[c] = bf_lo((unsigned)P[(size_t)mlast * IN_COLS + c]);
                        float* po = out + O_POP + ((size_t)l * NSEQ_P + seq) * PBUF * POOLW;
                        for (int e = lane; e < PBUF * POOLW; e += 64) { const int i = e >> 9, c = e & 511; po[e] = bf_lo((unsigned)P[(size_t)(mlast - 14 + i) * IN_COLS + C_PP + c]); }
                    } else {
                        const int b = seq - NSEQ_P, mfirst = MP + b * T_S;
                        float* so = out + O_SHS + ((size_t)l * NSEQ_S + b) * RWKV_COLS;
                        for (int c = lane; c < RWKV_COLS; c += 64) so[c] = bf_lo((unsigned)P[(size_t)(mfirst + T_S - 1) * IN_COLS + c]);
                        float* po = out + O_POS + ((size_t)l * NSEQ_S + b) * PBUF * POOLW; const float* sp = pc.spool + (size_t)b * PBUF * POOLW;
                        for (int e = lane; e < PBUF * POOLW; e += 64) { const int i = e >> 9, c = e & 511;
                            po[e] = i < 7 ? sp[(size_t)(8 + i) * POOLW + c] : bf_lo((unsigned)P[(size_t)(mfirst + i - 7) * IN_COLS + C_PP + c]); }
                    }
                    continue;
                }
                const int type = task / NTILE, tile = task % NTILE, m = tile * 16 + tok, seq = row_seq(m), t = row_t(m);
                if (type == 0) {
#pragma unroll 2
                    for (int cb = q; cb < 64; cb += 4) { float x[8]; load_xl8(pc, m, seq, t, C_R + 8 * cb, x);
                        *(bf16x8*)(Rb + (size_t)m * MIX + 8 * cb) = pack8(x); }
                    if (l == 0)
#pragma unroll 2
                    for (int cb = q; cb < 64; cb += 4) { float x[8]; load_xl8(pc, m, seq, t, C_V + 8 * cb, x); const bf16x8 pk = pack8(x);
                        *(bf16x8*)(Vb + (size_t)m * MIX + 8 * cb) = pk; *(bf16x8*)(VF + (size_t)m * MIX + 8 * cb) = pk; }
                } else if (type == 1) {
                    bf16x8 af[2];
#pragma unroll
                    for (int ks = 0; ks < 2; ++ks) { float x[8]; load_xl8(pc, m, seq, t, C_XW + 32 * ks + 8 * q, x);
#pragma unroll
                        for (int i = 0; i < 8; ++i) x[i] = tanhf_(x[i]);
                        af[ks] = pack8(x); }
#pragma unroll 2
                    for (int nt = 0; nt < 32; ++nt) { f32x4 acc = (f32x4){0.f, 0.f, 0.f, 0.f};
#pragma unroll
                        for (int ks = 0; ks < 2; ++ks) { const bf16x8 wf = *(const bf16x8*)(W2T + (size_t)(16 * nt + tok) * 64 + 32 * ks + 8 * q); acc = MFMA16(wf, af[ks], acc); }
                        const int c = 16 * nt + 4 * q; const f32x4 w0v = *(const f32x4*)(w0 + c); f32x4 o;
#pragma unroll
                        for (int r = 0; r < 4; ++r) o[r] = __expf(-0.6065306597126334f * sigmoidf_(w0v[r] + acc[r]));
                        *(f32x4*)(Wd + (size_t)m * MIX + c) = o; }
                } else if (type == 2) {
                    bf16x8 af[2];
#pragma unroll
                    for (int ks = 0; ks < 2; ++ks) { float x[8]; load_xl8(pc, m, seq, t, C_XA + 32 * ks + 8 * q, x); af[ks] = pack8(x); }
#pragma unroll 1
                    for (int hh = 0; hh < NH; ++hh) {
                        float kv[4][4], av[4][4], kkv[4][4]; float ss = 0.f;
#pragma unroll
                        for (int n4 = 0; n4 < 4; ++n4) { const int nt = 4 * hh + n4; f32x4 acc = (f32x4){0.f, 0.f, 0.f, 0.f};
#pragma unroll
                            for (int ks = 0; ks < 2; ++ks) { const bf16x8 wf = *(const bf16x8*)(A2T + (size_t)(16 * nt + tok) * 64 + 32 * ks + 8 * q); acc = MFMA16(wf, af[ks], acc); }
                            const int c = 16 * nt + 4 * q; const f32x4 a0v = *(const f32x4*)(a0 + c), kkwv = *(const f32x4*)(kkw + c);
                            load_xl4(pc, m, seq, t, C_K + c, kv[n4]);
#pragma unroll
                            for (int r = 0; r < 4; ++r) { av[n4][r] = sigmoidf_(a0v[r] + acc[r]); kkv[n4][r] = kv[n4][r] * kkwv[r]; ss += kkv[n4][r] * kkv[n4][r]; } }
                        ss += __shfl_xor(ss, 16); ss += __shfl_xor(ss, 32);
                        const float rn = 1.0f / sqrtf(ss + 1e-12f);
#pragma unroll
                        for (int n4 = 0; n4 < 4; ++n4) { const int c = 16 * (4 * hh + n4) + 4 * q; const f32x4 kav = *(const f32x4*)(kaw + c);
                            float k2[4], kn[4], bb[4];
#pragma unroll
                            for (int r = 0; r < 4; ++r) { kn[r] = kkv[n4][r] * rn; k2[r] = kv[n4][r] * (1.0f + (av[n4][r] - 1.0f) * kav[r]); bb[r] = kn[r] * av[n4][r]; }
                            *(v2u*)(K2b + (size_t)m * MIX + c) = pack4(k2[0], k2[1], k2[2], k2[3]);
                            *(v2u*)(KKb + (size_t)m * MIX + c) = pack4(kn[0], kn[1], kn[2], kn[3]);
                            *(v2u*)(Bb + (size_t)m * MIX + c) = pack4(bb[0], bb[1], bb[2], bb[3]); }
                    }
                } else if (type == 3) {
                    bf16x8 af[4];
#pragma unroll
                    for (int ks = 0; ks < 4; ++ks) { float x[8]; load_xl8(pc, m, seq, t, C_XG + 32 * ks + 8 * q, x);
#pragma unroll
                        for (int i = 0; i < 8; ++i) x[i] = sigmoidf_(x[i]);
                        af[ks] = pack8(x); }
#pragma unroll 2
                    for (int nt = 0; nt < 32; ++nt) { f32x4 acc = (f32x4){0.f, 0.f, 0.f, 0.f};
#pragma unroll
                        for (int ks = 0; ks < 4; ++ks) { const bf16x8 wf = *(const bf16x8*)(G2T + (size_t)(16 * nt + tok) * 128 + 32 * ks + 8 * q); acc = MFMA16(wf, af[ks], acc); }
                        *(v2u*)(Gb + (size_t)m * MIX + 16 * nt + 4 * q) = pack4(acc[0], acc[1], acc[2], acc[3]); }
                } else if (type == 4) {
                    if (l > 0) {
                        f32x4 a1[2] = {(f32x4){0.f, 0.f, 0.f, 0.f}, (f32x4){0.f, 0.f, 0.f, 0.f}};
#pragma unroll 2
                        for (int ks = 0; ks < 16; ++ks) { float x[8]; load_xl8(pc, m, seq, t, C_V + 32 * ks + 8 * q, x); const bf16x8 af = pack8(x);
#pragma unroll
                            for (int nt = 0; nt < 2; ++nt) { const bf16x8 wf = *(const bf16x8*)(V1T + (size_t)(16 * nt + tok) * MIX + 32 * ks + 8 * q); a1[nt] = MFMA16(wf, af, a1[nt]); } }
                        float tt[8] = {a1[0][0], a1[0][1], a1[0][2], a1[0][3], a1[1][0], a1[1][1], a1[1][2], a1[1][3]};
                        const bf16x8 tf = pack8(tt);
#pragma unroll 2
                        for (int nt = 0; nt < 32; ++nt) {
                            const v2u wa = *(const v2u*)(V2T + (size_t)(16 * nt + tok) * 32 + 4 * q), wb = *(const v2u*)(V2T + (size_t)(16 * nt + tok) * 32 + 16 + 4 * q);
                            v4u wu; wu.x = wa.x; wu.y = wa.y; wu.z = wb.x; wu.w = wb.y;
                            const f32x4 acc = MFMA16(__builtin_bit_cast(bf16x8, wu), tf, ((f32x4){0.f, 0.f, 0.f, 0.f}));
                            const int c = 16 * nt + 4 * q; float vv[4]; load_xl4(pc, m, seq, t, C_V + c, vv);
                            const f32x4 v0v = *(const f32x4*)(v0 + c); const v2u vfu = *(const v2u*)(VF + (size_t)m * MIX + c);
                            const float vf[4] = {bf_lo(vfu.x), bf_hi(vfu.x), bf_lo(vfu.y), bf_hi(vfu.y)}; float o[4];
#pragma unroll
                            for (int r = 0; r < 4; ++r) o[r] = vv[r] + (vf[r] - vv[r]) * sigmoidf_(v0v[r] + acc[r]);
                            *(v2u*)(Vb + (size_t)m * MIX + c) = pack4(o[0], o[1], o[2], o[3]); }
                    }
                } else {
#pragma unroll 1
                    for (int gi = 0; gi < 4; ++gi) { const int win = 2 << gi; bf16x8 af[4];
#pragma unroll
                        for (int ks = 0; ks < 4; ++ks) { const int c = PGRP * gi + 32 * ks + 8 * q; float sum[8], cur[8];
                            __builtin_amdgcn_sched_barrier(0);
#pragma unroll
                            for (int i = 0; i < 8; ++i) { sum[i] = 0.f; cur[i] = 0.f; }
#pragma unroll 2
                            for (int i = 0; i < win; ++i) { const int tt = t - i; float x[8];
                                if (tt >= 0) { const v4u u = *(const v4u*)(P + (size_t)(m - i) * IN_COLS + C_PP + c);
                                    x[0] = bf_lo(u.x); x[1] = bf_hi(u.x); x[2] = bf_lo(u.y); x[3] = bf_hi(u.y); x[4] = bf_lo(u.z); x[5] = bf_hi(u.z); x[6] = bf_lo(u.w); x[7] = bf_hi(u.w); }
                                else if (seq >= NSEQ_P) { const float* s = pc.spool + ((size_t)(seq - NSEQ_P) * PBUF + (PBUF + tt)) * POOLW + c; const f32x4 a = *(const f32x4*)s, b = *(const f32x4*)(s + 4);
                                    x[0] = a[0]; x[1] = a[1]; x[2] = a[2]; x[3] = a[3]; x[4] = b[0]; x[5] = b[1]; x[6] = b[2]; x[7] = b[3]; }
                                else {
#pragma unroll
                                    for (int j = 0; j < 8; ++j) x[j] = 0.f; }
#pragma unroll
                                for (int j = 0; j < 8; ++j) { sum[j] += x[j]; if (i == 0) cur[j] = x[j]; } }
                            const float inv = 1.0f / (float)((seq < NSEQ_P && t + 1 < win) ? t + 1 : win);
#pragma unroll
                            for (int j = 0; j < 8; ++j) sum[j] = sum[j] * inv - cur[j];
                            af[ks] = pack8(sum); }
#pragma unroll 2
                        for (int nt = 0; nt < 8; ++nt) { f32x4 acc = (f32x4){0.f, 0.f, 0.f, 0.f};
#pragma unroll
                            for (int ks = 0; ks < 4; ++ks) { const bf16x8 wf = *(const bf16x8*)(PWT + ((size_t)gi * PGRP + 16 * nt + tok) * PGRP + 32 * ks + 8 * q); acc = MFMA16(wf, af[ks], acc); }
                            const int d = PGRP * gi + 16 * nt + 4 * q; const f32x4 sc = *(const f32x4*)(pscale + d);
                            *(v2u*)(ORP + (size_t)m * D + MIX + d) = pack4(acc[0] * sc[0], acc[1] * sc[1], acc[2] * sc[2], acc[3] * sc[3]); } }
                }
            }
        }
        SEAM(ph); ++ph;
        if (IN(ph)) { PH_IDS();
            LAS float* lw = (LAS float*)lds;
            LAS float* lkk = lw + 2048; LAS float* lb = lkk + 2048; LAS float* lk = lb + 2048; LAS float* lr = lk + 2048; LAS float* lv = lr + 2048; LAS float* ly = lv + 1024;
            constexpr int NITEM = NSEQ * NH * 2;
            const int rl = lane >> 4, kq = lane & 15, vrow = wave * 4 + rl;
            for (int item = blockIdx.x; item < NITEM; item += G) {
                const int seq = item >> 4, hh = (item >> 1) & 7, half = item & 1;
                const int T = seq < NSEQ_P ? T_P : T_S, mbase = seq < NSEQ_P ? seq * T_P : MP + (seq - NSEQ_P) * T_S;
                const int vg = 32 * half + vrow;
                f32x4 S = (f32x4){0.f, 0.f, 0.f, 0.f};
                if (seq >= NSEQ_P) S = *(const f32x4*)(args.in[I_SWKV] + ((((size_t)l * NSEQ_S + (seq - NSEQ_P)) * NH + hh) * HS + vg) * HS + 4 * kq);
                const int CH = T < 32 ? T : 32, nch = T / CH;
                const int st = tid >> 4, sk = (tid & 15) * 4;
                const bool sact = st < CH;
                f32x4 pw = (f32x4){0.f, 0.f, 0.f, 0.f}; v2u pkk = (v2u){0u, 0u}, pb = pkk, pk = pkk, pr = pkk; unsigned pv = 0u;
#define SCAN_LOAD(c0) do { if (sact) { const size_t mm = (size_t)(mbase + (c0) + st) * MIX + 64 * hh; pw = *(const f32x4*)(Wd + mm + sk); pkk = *(const v2u*)(KKb + mm + sk); pb = *(const v2u*)(Bb + mm + sk); \
                    pk = *(const v2u*)(K2b + mm + sk); pr = *(const v2u*)(Rb + mm + sk); pv = *(const unsigned*)(Vb + mm + 32 * half + (tid & 15) * 2); } } while (0)
#define SCAN_STORE() do { if (sact) { *(LAS f32x4*)(lw + st * 64 + sk) = pw; *(LAS f32x4*)(lkk + st * 64 + sk) = (f32x4){bf_lo(pkk.x), bf_hi(pkk.x), bf_lo(pkk.y), bf_hi(pkk.y)}; \
                    *(LAS f32x4*)(lb + st * 64 + sk) = (f32x4){bf_lo(pb.x), bf_hi(pb.x), bf_lo(pb.y), bf_hi(pb.y)}; *(LAS f32x4*)(lk + st * 64 + sk) = (f32x4){bf_lo(pk.x), bf_hi(pk.x), bf_lo(pk.y), bf_hi(pk.y)}; \
                    *(LAS f32x4*)(lr + st * 64 + sk) = (f32x4){bf_lo(pr.x), bf_hi(pr.x), bf_lo(pr.y), bf_hi(pr.y)}; *(LAS f32x2*)(lv + st * 32 + (tid & 15) * 2) = (f32x2){bf_lo(pv), bf_hi(pv)}; } } while (0)
                SCAN_LOAD(0);
                for (int ch = 0; ch < nch; ++ch) {
                    __syncthreads();
                    SCAN_STORE();
                    __syncthreads();
                    if (ch + 1 < nch) SCAN_LOAD((ch + 1) * CH);
                    for (int s = 0; s < CH; ++s) {
                        const f32x4 w4 = *(const LAS f32x4*)(lw + s * 64 + 4 * kq), kk4 = *(const LAS f32x4*)(lkk + s * 64 + 4 * kq), b4 = *(const LAS f32x4*)(lb + s * 64 + 4 * kq),
                                    k4 = *(const LAS f32x4*)(lk + s * 64 + 4 * kq), r4 = *(const LAS f32x4*)(lr + s * 64 + 4 * kq);
                        const float vv = lv[s * 32 + vrow];
                        float sa = (S[0] * kk4[0] + S[1] * kk4[1]) + (S[2] * kk4[2] + S[3] * kk4[3]);
                        sa += __shfl_xor(sa, 1); sa += __shfl_xor(sa, 2); sa += __shfl_xor(sa, 4); sa += __shfl_xor(sa, 8);
                        sa = -sa;
#pragma unroll
                        for (int j = 0; j < 4; ++j) S[j] = S[j] * w4[j] + sa * b4[j] + vv * k4[j];
                        float y = (S[0] * r4[0] + S[1] * r4[1]) + (S[2] * r4[2] + S[3] * r4[3]);
                        y += __shfl_xor(y, 1); y += __shfl_xor(y, 2); y += __shfl_xor(y, 4); y += __shfl_xor(y, 8);
                        if (kq == 0) ly[s * 32 + vrow] = y;
                    }
                    __syncthreads();
                    if (sact) { const f32x2 yy = *(const LAS f32x2*)(ly + st * 32 + (tid & 15) * 2);
                        *(f32x2*)(Y + (size_t)(mbase + ch * CH + st) * MIX + 64 * hh + 32 * half + (tid & 15) * 2) = yy; }
                }
                float* so = seq < NSEQ_P ? out + O_WKP + ((((size_t)l * NSEQ_P + seq) * NH + hh) * HS + vg) * HS + 4 * kq
                                         : out + O_WKS + ((((size_t)l * NSEQ_S + (seq - NSEQ_P)) * NH + hh) * HS + vg) * HS + 4 * kq;
                *(f32x4*)so = S;
                __syncthreads();
            }
#undef SCAN_LOAD
#undef SCAN_STORE
        }
        SEAM(ph); ++ph;
        if (IN(ph)) { PH_IDS();
            const float* lnw = args.in[I_LNW] + (size_t)l * MIX; const float* lnb = args.in[I_LNB] + (size_t)l * MIX; const float* rk = args.in[I_RK] + (size_t)l * MIX;
            const int c = 8 * lane;
            for (int m = gw; m < M; m += NGW) {
                const f32x4 y0 = *(const f32x4*)(Y + (size_t)m * MIX + c), y1 = *(const f32x4*)(Y + (size_t)m * MIX + c + 4);
                float y[8] = {y0[0], y0[1], y0[2], y0[3], y1[0], y1[1], y1[2], y1[3]};
                float s = 0.f;
#pragma unroll
                for (int i = 0; i < 8; ++i) s += y[i];
                s += __shfl_xor(s, 1); s += __shfl_xor(s, 2); s += __shfl_xor(s, 4);
                const float mean = s * (1.0f / 64.0f); float q2 = 0.f;
#pragma unroll
                for (int i = 0; i < 8; ++i) { y[i] -= mean; q2 += y[i] * y[i]; }
                q2 += __shfl_xor(q2, 1); q2 += __shfl_xor(q2, 2); q2 += __shfl_xor(q2, 4);
                const float rstd = 1.0f / sqrtf(q2 * (1.0f / 64.0f) + 64e-5f);
                const v4u ru = *(const v4u*)(Rb + (size_t)m * MIX + c), ku = *(const v4u*)(K2b + (size_t)m * MIX + c), vu = *(const v4u*)(Vb + (size_t)m * MIX + c), gu = *(const v4u*)(Gb + (size_t)m * MIX + c);
                const float rr[8] = {bf_lo(ru.x), bf_hi(ru.x), bf_lo(ru.y), bf_hi(ru.y), bf_lo(ru.z), bf_hi(ru.z), bf_lo(ru.w), bf_hi(ru.w)};
                const float kk[8] = {bf_lo(ku.x), bf_hi(ku.x), bf_lo(ku.y), bf_hi(ku.y), bf_lo(ku.z), bf_hi(ku.z), bf_lo(ku.w), bf_hi(ku.w)};
                const float vv[8] = {bf_lo(vu.x), bf_hi(vu.x), bf_lo(vu.y), bf_hi(vu.y), bf_lo(vu.z), bf_hi(vu.z), bf_lo(vu.w), bf_hi(vu.w)};
                const float gg[8] = {bf_lo(gu.x), bf_hi(gu.x), bf_lo(gu.y), bf_hi(gu.y), bf_lo(gu.z), bf_hi(gu.z), bf_lo(gu.w), bf_hi(gu.w)};
                const f32x4 rk0 = *(const f32x4*)(rk + c), rk1 = *(const f32x4*)(rk + c + 4), w0 = *(const f32x4*)(lnw + c), w1 = *(const f32x4*)(lnw + c + 4), b0 = *(const f32x4*)(lnb + c), b1 = *(const f32x4*)(lnb + c + 4);
                float bs = 0.f;
#pragma unroll
                for (int i = 0; i < 4; ++i) bs += rr[i] * kk[i] * rk0[i] + rr[4 + i] * kk[4 + i] * rk1[i];
                bs += __shfl_xor(bs, 1); bs += __shfl_xor(bs, 2); bs += __shfl_xor(bs, 4);
                float o[8];
#pragma unroll
                for (int i = 0; i < 4; ++i) { o[i] = (y[i] * rstd * w0[i] + b0[i] + bs * vv[i]) * gg[i]; o[4 + i] = (y[4 + i] * rstd * w1[i] + b1[i] + bs * vv[4 + i]) * gg[4 + i]; }
                *(bf16x8*)(ORP + (size_t)m * D + c) = pack8(o);
            }
        }
        SEAM(ph); ++ph;
        if (IN(ph)) {
            pg8::Gemm g{ORP, WBR_T, M, D, D}; pg8::StaticOrder S; S.init(M, D, G, (int)blockIdx.x);
            EpiMerge E{8, P, H};
            pg8::gemm_phase<EpiMerge, pg8::StaticOrder, true, true>(lds, g, S, E);
        }
        SEAM(ph); ++ph;
        if (IN(ph)) {
            pg8::Gemm g{H, WOUT_T, M, D, D}; pg8::StaticOrder S; S.init(M, D, G, (int)blockIdx.x);
            EpiRes E{0, X, modmix + 2048};
            pg8::gemm_phase<EpiRes, pg8::StaticOrder, true, true>(lds, g, S, E);
        }
        SEAM(ph); ++ph;
        if (IN(ph)) { PH_IDS();
            const float* nw = args.in[I_NORMMLP] + (size_t)l * D;
            for (int m = gw; m < M; m += NGW) {
                const float* xr = X + (size_t)m * D; const float* mo = modmlp + (size_t)row_seq(m) * MODW;
                f32x4 v[4]; float s = 0.f;
#pragma unroll
                for (int j = 0; j < 4; ++j) { v[j] = *(const f32x4*)(xr + 4 * lane + 256 * j); s += (v[j][0] * v[j][0] + v[j][1] * v[j][1]) + (v[j][2] * v[j][2] + v[j][3] * v[j][3]); }
                const float rstd = 1.0f / sqrtf(wave_sum(s) * (1.0f / D) + 1e-6f);
#pragma unroll
                for (int j = 0; j < 4; ++j) { const int c = 4 * lane + 256 * j; const f32x4 g = *(const f32x4*)(nw + c), sh = *(const f32x4*)(mo + c), sc = *(const f32x4*)(mo + 1024 + c);
                    f32x4 o;
#pragma unroll
                    for (int i = 0; i < 4; ++i) o[i] = v[j][i] * rstd * g[i] * (1.0f + sc[i]) + sh[i];
                    *(v2u*)(H + (size_t)m * D + c) = pack4(o[0], o[1], o[2], o[3]); }
            }
        }
        SEAM(ph); ++ph;
        if (IN(ph)) {
            pg8::Gemm g{H, WFF1_T, M, DFF, D}; pg8::StaticOrder S; S.init(M, DFF, G, (int)blockIdx.x);
            EpiStoreBf16 E{0, P, DFF, 1};
            pg8::gemm_phase<EpiStoreBf16, pg8::StaticOrder, true, true>(lds, g, S, E);
        }
        SEAM(ph); ++ph;
        if (IN(ph)) {
            pg8::Gemm g{P, WFF2_T, M, D, DFF}; pg8::StaticOrder S; S.init(M, D, G, (int)blockIdx.x);
            EpiRes E{0, X, modmlp + 2048};
            pg8::gemm_phase<EpiRes, pg8::StaticOrder, true, true>(lds, g, S, E);
        }
        SEAM(ph); ++ph;
    }
    if (IN(ph)) { PH_IDS();
        const float* nw = args.in[I_NORMF];
        for (int m = gw; m < M; m += NGW) {
            float* xr = X + (size_t)m * D;
            f32x4 v[4]; float s = 0.f;
#pragma unroll
            for (int j = 0; j < 4; ++j) { v[j] = *(const f32x4*)(xr + 4 * lane + 256 * j); s += (v[j][0] * v[j][0] + v[j][1] * v[j][1]) + (v[j][2] * v[j][2] + v[j][3] * v[j][3]); }
            const float rstd = 1.0f / sqrtf(wave_sum(s) * (1.0f / D) + 1e-6f);
#pragma unroll
            for (int j = 0; j < 4; ++j) { const int c = 4 * lane + 256 * j; const f32x4 g = *(const f32x4*)(nw + c); *(f32x4*)(xr + c) = v[j] * rstd * g; }
        }
    }
#undef IN
#undef SEAM
}

constexpr int N_PHASES = 2 + DEPTH * 10 + 1;

extern "C" void kernel_launch(void* const* d_in, const int* in_sizes, int n_in, void* d_out, int out_size, void* d_ws, size_t ws_size, hipStream_t stream) {
    static int grid = 0;
    if (grid == 0) {
        if (n_in != N_IN || (size_t)out_size != O_END || ws_size < WS_END) { fprintf(stderr, "kernel_launch: shape mismatch n_in %d out %d ws %zu\n", n_in, out_size, ws_size); grid = -1; return; }
        int dev = 0, cus = 0, per_cu = 0;
        if (hipGetDevice(&dev) != hipSuccess || hipDeviceGetAttribute(&cus, hipDeviceAttributeMultiprocessorCount, dev) != hipSuccess) { grid = -1; return; }
        if (hipFuncSetAttribute((const void*)mk_fwd, hipFuncAttributeMaxDynamicSharedMemorySize, LDS_BYTES) != hipSuccess) { fprintf(stderr, "kernel_launch: hipFuncSetAttribute failed\n"); grid = -1; return; }
        if (hipOccupancyMaxActiveBlocksPerMultiprocessor(&per_cu, (const void*)mk_fwd, NTHR, LDS_BYTES) != hipSuccess || per_cu < 1) { fprintf(stderr, "kernel_launch: occupancy query says %d\n", per_cu); per_cu = 1; }
        (void)hipGetLastError();
        grid = cus * (per_cu < 1 ? per_cu : 1);
    }
    if (grid < 0) return;
    (void)hipMemsetAsync((char*)d_ws + WS_CTL, 0, CTL_ZERO_BYTES, stream);
    Args a{};
    for (int i = 0; i < N_IN; ++i) a.in[i] = (const float*)d_in[i];
    a.out = (float*)d_out; a.ws = (unsigned char*)d_ws;
#if MK_ONE_LAUNCH
    a.ph_lo = 0; a.ph_hi = N_PHASES;
    void* kargs[] = {(void*)&a};
    hipError_t e = hipLaunchCooperativeKernel((const void*)mk_fwd, dim3(grid), dim3(NTHR), kargs, LDS_BYTES, stream);
    if (e != hipSuccess) fprintf(stderr, "kernel_launch: cooperative launch failed: %s (grid %d)\n", hipGetErrorString(e), grid);
#else
    for (int p = 0; p < N_PHASES; ++p) { a.ph_lo = p; a.ph_hi = p + 1; hipLaunchKernelGGL(mk_fwd, dim3(grid), dim3(NTHR), LDS_BYTES, stream, a); }
#endif
}
```

```cpp
#include <hip/hip_runtime.h>
#include <cstdio>
#include <cstdint>

#ifndef PROBE_DUP
#define PROBE_DUP -1
#endif
#define DUPN(k) ((PROBE_DUP == (k)) ? 2 : 1)
#ifndef MK_ONE_LAUNCH
#define MK_ONE_LAUNCH 1
#endif

#define GAS __attribute__((address_space(1)))
#define LAS __attribute__((address_space(3)))
typedef unsigned short bf16;
typedef unsigned v4u __attribute__((ext_vector_type(4)));
typedef unsigned v2u __attribute__((ext_vector_type(2)));
typedef float f32x4 __attribute__((ext_vector_type(4)));
typedef float f32x2 __attribute__((ext_vector_type(2)));
typedef short bf16x8 __attribute__((ext_vector_type(8)));

constexpr int D = 1024, DEPTH = 4, NSEQ_P = 8, T_P = 2048, NSEQ_S = 128, T_S = 8;
constexpr int MP = NSEQ_P * T_P, MS = NSEQ_S * T_S, M = MP + MS;
constexpr int NSEQ = NSEQ_P + NSEQ_S;
constexpr int MIX = 512, HS = 64, NH = 8, POOLW = 512, PGRP = 128, PBUF = 15, DFF = 4096;
constexpr int RWKV_COLS = 1792, IN_COLS = 4352;
constexpr int C_R = 0, C_K = 512, C_V = 1024, C_XW = 1536, C_XA = 1600, C_XG = 1664, C_PP = 1792, C_GR = 2304, C_GP = 3328;
constexpr int MODW = 8 * 3072;
constexpr int NWAVES = 8, NTHR = 512;

enum { I_XP = 0, I_XS, I_SSHIFT, I_SPOOL, I_SWKV, I_CP, I_CS, I_WADAMIX, I_BADAMIX, I_NORMMIX, I_WIN, I_MU, I_W0, I_W2, I_A0, I_A2, I_G2,
       I_V0, I_V1, I_V2, I_KK, I_KA, I_RK, I_LNW, I_LNB, I_POOLW, I_POOLS, I_WBRR, I_WBRP, I_WOUT, I_WADAMLP, I_BADAMLP, I_NORMMLP, I_WFF1, I_WFF2, I_NORMF, N_IN };
constexpr size_t O_Y = 0, O_SHP = (size_t)M * D, O_POP = O_SHP + 4 * 8 * 1792, O_WKP = O_POP + 4 * 8 * 15 * 512, O_SHS = O_WKP + 4 * 8 * 8 * 4096,
                 O_POS = O_SHS + 4 * 128 * 1792, O_WKS = O_POS + (size_t)4 * 128 * 15 * 512, O_END = O_WKS + (size_t)4 * 128 * 8 * 4096;

constexpr size_t MiB = 1u << 20;
constexpr size_t WS_CTL = 0, CTL_ZERO_BYTES = 1 * MiB;
constexpr size_t WS_MOD = 1 * MiB;
constexpr size_t WS_SC = 14 * MiB;
constexpr size_t WS_WIN = 16 * MiB;
constexpr size_t WS_WBR = 25 * MiB;
constexpr size_t WS_WOUT = 27 * MiB;
constexpr size_t WS_WFF1 = 29 * MiB;
constexpr size_t WS_WFF2 = 37 * MiB;
constexpr size_t WS_WSM = 45 * MiB;
constexpr size_t SM_W2 = 0, SM_A2 = 65536, SM_G2 = 131072, SM_V1 = 262144, SM_V2 = 294912, SM_PW = 327680;
constexpr size_t WS_H = 48 * MiB;
constexpr size_t WS_P = 82 * MiB;
constexpr size_t WS_R = 227 * MiB, WS_K2 = 244 * MiB, WS_V = 261 * MiB, WS_KK = 278 * MiB, WS_B = 295 * MiB;
constexpr size_t WS_W = 312 * MiB;
constexpr size_t WS_ORP = 346 * MiB;
constexpr size_t WS_G = 380 * MiB;
constexpr size_t WS_VF = 397 * MiB;
constexpr size_t WS_Y = 414 * MiB;
constexpr size_t WS_END = 448 * MiB;

constexpr int CW_BAR = 4096;

constexpr int RING_BYTES = 131072, LDSCTL_OFF = RING_BYTES, MISC_OFF = LDSCTL_OFF + 320, LDS_BYTES = 147456;

typedef __bf16 bf16x2_t __attribute__((ext_vector_type(2)));
__device__ __forceinline__ unsigned cvt_pk_bf16(float lo, float hi) { f32x2 v = {lo, hi}; bf16x2_t b = __builtin_convertvector(v, bf16x2_t); return __builtin_bit_cast(unsigned, b); }
__device__ __forceinline__ float bf_lo(unsigned u) { return __builtin_bit_cast(float, u << 16); }
__device__ __forceinline__ float bf_hi(unsigned u) { return __builtin_bit_cast(float, u & 0xffff0000u); }
__device__ __forceinline__ float sigmoidf_(float x) { return 1.0f / (1.0f + __expf(-x)); }
__device__ __forceinline__ float tanhf_(float x) { return 1.0f - 2.0f / (1.0f + __expf(2.0f * x)); }
__device__ __forceinline__ float wave_sum(float v) {
#pragma unroll
    for (int o = 1; o < 64; o <<= 1) v += __shfl_xor(v, o);
    return v;
}
__device__ __forceinline__ int launder_tid() { int t = threadIdx.x; asm volatile("" : "+v"(t)); return t; }
template <int CTRL> __device__ __forceinline__ float dpp_f(float x) { return __builtin_bit_cast(float, __builtin_amdgcn_update_dpp(0, __builtin_bit_cast(int, x), CTRL, 0xF, 0xF, true)); }
__device__ __forceinline__ float row16_sum(float x) { x += dpp_f<0xB1>(x); x += dpp_f<0x4E>(x); x += dpp_f<0x141>(x); x += dpp_f<0x140>(x); return x; }
#define LDS_WAIT() asm volatile("s_waitcnt lgkmcnt(0)" ::: "memory")
#define VM_WAIT() asm volatile("s_waitcnt vmcnt(0)" ::: "memory")

namespace pg8 {
#define PG8_LAS __attribute__((address_space(3)))
typedef unsigned short bf16_t;
constexpr int BM = 256, BK = 64, HALF = 128, HTB = HALF * BK * 2, STAGE_BYTES = 8 * HTB, NXCD = 8, WGM = 8;

__host__ __device__ __forceinline__ int lds_byte(int r, int c) { const int st = (r >> 4) * 2 + (c >> 5), rr = r & 15, cc = c & 31, ob = rr * 64 + cc * 2; return st * 1024 + (ob ^ (((ob >> 9) & 1) << 5)); }
__host__ __device__ __forceinline__ void stage_rc(int b, int& R, int& C) { const int st = b / 1024, sb = b % 1024, swz = sb ^ (((sb >> 9) & 1) << 5); R = (st >> 1) * 16 + swz / 64; C = (st & 1) * 32 + (swz % 64) / 2; }
__host__ __device__ __forceinline__ int perm32(int rho) { const int n = rho >> 4, i = rho & 15; return 8 * (i >> 2) + 4 * n + (i & 3); }

struct Unit { int pm, pn; };
struct Gemm { const bf16_t* A; const bf16_t* Bt; int M, N, K; };

struct StaticOrder {
    int nM, nN, nwg, G, c;
    __host__ __device__ void init(int M_, int N_, int G_, int c_) { nM = M_ / BM; nN = N_ / BM; nwg = nM * nN; G = G_; c = c_; }
    __host__ __device__ bool next(int i, Unit& u) const {
        const long L = (long)i * G + c; if (L >= nwg) return false;
        int wgid = (int)L; { const int q = nwg / NXCD, r = nwg % NXCD, xcd = wgid % NXCD, off = wgid / NXCD; wgid = (xcd < r ? xcd * (q + 1) : r * (q + 1) + (xcd - r) * q) + off; }
        const int nig = WGM * nN, gid = wgid / nig, fm = gid * WGM, gsz = (nM - fm) < WGM ? (nM - fm) : WGM;
        u.pm = fm + ((wgid % nig) % gsz); u.pn = (wgid % nig) / gsz; return true;
    }
};

template <class Epi, class Sched, bool ALIGN_EPI = false, bool SP2 = false>
__device__ __forceinline__ void gemm_phase(PG8_LAS unsigned char* lds, const Gemm g, const Sched& S, const Epi& E) {
    const int tid = launder_tid(), wid = __builtin_amdgcn_readfirstlane(tid >> 6), lane = tid & 63, wr = wid >> 2, wc = wid & 3, fr = lane & 15, fq = lane >> 4;
    const int K = g.K, nt = K / BK;
    unsigned voffA[2], voffB[2];
#pragma unroll
    for (int i = 0; i < 2; ++i) { int R, C; stage_rc(tid * 16 + i * 8192, R, C); const int Rb = (R & ~31) + perm32(R & 31);
        voffA[i] = (unsigned)(R * K + C) * 2u; voffB[i] = (unsigned)(Rb * K + C) * 2u; }
    const size_t kstep = (size_t)(BK * 2);
    const size_t hstep = (size_t)HALF * K * 2;
    const size_t tstep = 2 * hstep;
    const unsigned ldsw = (unsigned)wid * 1024u;
    const int aoff = lds_byte(wr * 64 + fr, fq * 8), boff = lds_byte(wc * 32 + fr, fq * 8);
#define PG8_SA(b, h) (((b) * 2 + (h)) * HTB)
#define PG8_SB(b, h) ((4 + (b) * 2 + (h)) * HTB)
#define PG8_STAGE(bufoff, gbase, voff) do { _Pragma("unroll") for (int _i = 0; _i < 2; ++_i) \
        __builtin_amdgcn_global_load_lds((const unsigned*)((const char*)(gbase) + (voff)[_i]), (PG8_LAS unsigned*)(lds + (bufoff) + ldsw + _i * 8192), 16, 0, 0); } while (0)
#define PG8_LDA(dst, b, h) do { _Pragma("unroll") for (int m = 0; m < 4; ++m) _Pragma("unroll") for (int k = 0; k < 2; ++k) dst[m][k] = *(const PG8_LAS bf16x8*)(lds + PG8_SA(b, h) + aoff + m * 2048 + k * 1024); } while (0)
#define PG8_LDB(dst, b, h) do { _Pragma("unroll") for (int n = 0; n < 2; ++n) _Pragma("unroll") for (int k = 0; k < 2; ++k) dst[n][k] = *(const PG8_LAS bf16x8*)(lds + PG8_SB(b, h) + boff + n * 2048 + k * 1024); } while (0)
#define PG8_MMA(ai, bj, At, Bt) do { __builtin_amdgcn_s_setprio(1); _Pragma("unroll") for (int m = 0; m < 4; ++m) _Pragma("unroll") for (int n = 0; n < 2; ++n) _Pragma("unroll") for (int k = 0; k < 2; ++k) \
        acc[ai][bj][m][n] = __builtin_amdgcn_mfma_f32_16x16x32_bf16(Bt[n][k], At[m][k], acc[ai][bj][m][n], 0, 0, 0); __builtin_amdgcn_s_setprio(0); } while (0)
#define PG8_WAIT_V(n) asm volatile("s_waitcnt vmcnt(" #n ")" ::: "memory")
#define PG8_WAIT_L(n) asm volatile("s_waitcnt lgkmcnt(" #n ")" ::: "memory")
#define PG8_BAR __builtin_amdgcn_s_barrier()
#define PG8_SCHED __builtin_amdgcn_sched_barrier(0)
    Unit cur, nxt; int ui = 0;
    if (!S.next(0, cur)) return;
    f32x4 acc[2][2][4][2];
#pragma unroll
    for (int a = 0; a < 2; ++a)
#pragma unroll
        for (int b = 0; b < 2; ++b)
#pragma unroll
            for (int m = 0; m < 4; ++m)
#pragma unroll
                for (int n = 0; n < 2; ++n) acc[a][b][m][n] = (f32x4){0.f, 0.f, 0.f, 0.f};
    bf16x8 At[4][2], B0[2][2], B1[2][2];
    const char* cA = (const char*)g.A + (size_t)cur.pm * tstep; const char* cB = (const char*)g.Bt + (size_t)cur.pn * tstep;
    if constexpr (SP2) {
        PG8_STAGE(PG8_SB(0, 0), cB, voffB); PG8_STAGE(PG8_SB(0, 1), cB + hstep, voffB); PG8_STAGE(PG8_SA(0, 0), cA, voffA); PG8_STAGE(PG8_SA(0, 1), cA + hstep, voffA);
        if (wr == 1) PG8_BAR;
        PG8_WAIT_V(2); PG8_BAR;
        PG8_STAGE(PG8_SB(1, 0), cB + kstep, voffB); PG8_STAGE(PG8_SA(1, 0), cA + kstep, voffA); PG8_STAGE(PG8_SB(1, 1), cB + hstep + kstep, voffB);
        PG8_WAIT_V(6); PG8_BAR;
    } else {
        PG8_STAGE(PG8_SB(0, 0), cB, voffB); PG8_STAGE(PG8_SA(0, 0), cA, voffA); PG8_STAGE(PG8_SB(0, 1), cB + hstep, voffB); PG8_STAGE(PG8_SA(0, 1), cA + hstep, voffA);
        if (wr == 1) PG8_BAR;
        PG8_WAIT_V(4); PG8_BAR;
        PG8_STAGE(PG8_SB(1, 0), cB + kstep, voffB); PG8_STAGE(PG8_SA(1, 0), cA + kstep, voffA); PG8_STAGE(PG8_SB(1, 1), cB + hstep + kstep, voffB);
        PG8_WAIT_V(6); PG8_BAR;
    }
    for (;;) {
        const bool has_next = S.next(ui + 1, nxt);
        const char* nA = has_next ? (const char*)g.A + (size_t)nxt.pm * tstep : cA; const char* nB = has_next ? (const char*)g.Bt + (size_t)nxt.pn * tstep : cB;
        for (int t = 0; t < nt; t += 2) {
            const bool last = (t == nt - 2);
            const char* a1 = cA + (size_t)(t + 1) * kstep;
            const char* a2 = last ? nA : cA + (size_t)(t + 2) * kstep; const char* b2 = last ? nB : cB + (size_t)(t + 2) * kstep;
            const char* a3 = a2 + kstep; const char* b3 = b2 + kstep;
            if constexpr (Epi::HOOK) { if (t == E.hook_t) E.hook(acc, cur, wr, wc, fr, fq); }
            if constexpr (SP2) {
            PG8_LDB(B0, 0, 0); PG8_LDB(B1, 0, 1); PG8_SCHED; PG8_LDA(At, 0, 0); PG8_STAGE(PG8_SA(1, 1), a1 + hstep, voffA);
            PG8_WAIT_V(8); PG8_WAIT_L(0); PG8_BAR; PG8_MMA(0, 0, At, B0); PG8_MMA(0, 1, At, B1); PG8_BAR; PG8_SCHED;
            PG8_LDA(At, 0, 1); PG8_STAGE(PG8_SB(0, 0), b2, voffB); PG8_STAGE(PG8_SB(0, 1), b2 + hstep, voffB); PG8_STAGE(PG8_SA(0, 0), a2, voffA);
            PG8_WAIT_V(8); PG8_WAIT_L(0); PG8_BAR; PG8_MMA(1, 0, At, B0); PG8_MMA(1, 1, At, B1); PG8_BAR; PG8_SCHED;
            PG8_LDB(B0, 1, 0); PG8_LDB(B1, 1, 1); PG8_SCHED; PG8_LDA(At, 1, 0); PG8_STAGE(PG8_SA(0, 1), a2 + hstep, voffA);
            PG8_WAIT_V(8); PG8_WAIT_L(0); PG8_BAR; PG8_MMA(0, 0, At, B0); PG8_MMA(0, 1, At, B1); PG8_BAR; PG8_SCHED;
            PG8_LDA(At, 1, 1); PG8_STAGE(PG8_SB(1, 0), b3, voffB); PG8_STAGE(PG8_SB(1, 1), b3 + hstep, voffB); PG8_STAGE(PG8_SA(1, 0), a3, voffA);
            PG8_WAIT_V(8); PG8_WAIT_L(0); PG8_BAR; PG8_MMA(1, 0, At, B0); PG8_MMA(1, 1, At, B1); PG8_BAR; PG8_SCHED;
            } else {
            PG8_LDB(B0, 0, 0); PG8_SCHED; PG8_LDA(At, 0, 0); PG8_STAGE(PG8_SA(1, 1), a1 + hstep, voffA);
            PG8_WAIT_L(8); PG8_BAR; PG8_WAIT_L(0); PG8_MMA(0, 0, At, B0); PG8_BAR; PG8_SCHED;
            PG8_LDB(B1, 0, 1); PG8_STAGE(PG8_SB(0, 0), b2, voffB);
            PG8_BAR; PG8_WAIT_L(0); PG8_MMA(0, 1, At, B1); PG8_BAR;
            PG8_LDA(At, 0, 1); PG8_STAGE(PG8_SA(0, 0), a2, voffA);
            PG8_BAR; PG8_WAIT_L(0); PG8_MMA(1, 0, At, B0); PG8_BAR; PG8_SCHED;
            PG8_STAGE(PG8_SB(0, 1), b2 + hstep, voffB);
            PG8_WAIT_V(6); PG8_BAR; PG8_MMA(1, 1, At, B1); PG8_BAR;
            PG8_LDB(B0, 1, 0); PG8_SCHED; PG8_LDA(At, 1, 0); PG8_STAGE(PG8_SA(0, 1), a2 + hstep, voffA);
            PG8_WAIT_L(8); PG8_BAR; PG8_WAIT_L(0); PG8_MMA(0, 0, At, B0); PG8_BAR; PG8_SCHED;
            PG8_LDB(B1, 1, 1); PG8_STAGE(PG8_SB(1, 0), b3, voffB);
            PG8_BAR; PG8_WAIT_L(0); PG8_MMA(0, 1, At, B1); PG8_BAR;
            PG8_LDA(At, 1, 1); PG8_STAGE(PG8_SA(1, 0), a3, voffA);
            PG8_BAR; PG8_WAIT_L(0); PG8_MMA(1, 0, At, B0); PG8_BAR; PG8_SCHED;
            PG8_STAGE(PG8_SB(1, 1), b3 + hstep, voffB);
            PG8_WAIT_V(6); PG8_BAR; PG8_MMA(1, 1, At, B1); PG8_BAR;
            }
        }
        if constexpr (ALIGN_EPI) { if (wr == 0) PG8_BAR; }
        E(acc, cur, wr, wc, fr, fq);
        if (!has_next) break;
#pragma unroll
        for (int a = 0; a < 2; ++a)
#pragma unroll
            for (int b = 0; b < 2; ++b)
#pragma unroll
                for (int m = 0; m < 4; ++m)
#pragma unroll
                    for (int n = 0; n < 2; ++n) acc[a][b][m][n] = (f32x4){0.f, 0.f, 0.f, 0.f};
        cur = nxt; cA = nA; cB = nB; ++ui;
        if constexpr (ALIGN_EPI) { if (wr == 1) PG8_BAR; }
    }
    PG8_WAIT_V(0);
    if constexpr (!ALIGN_EPI) { if (wr == 0) PG8_BAR; }
    PG8_BAR;
#undef PG8_SA
#undef PG8_SB
#undef PG8_STAGE
#undef PG8_LDA
#undef PG8_LDB
#undef PG8_MMA
#undef PG8_WAIT_V
#undef PG8_WAIT_L
#undef PG8_BAR
#undef PG8_SCHED
}
}

__device__ __forceinline__ int row_seq(int m) { return m < MP ? (m >> 11) : NSEQ_P + ((m - MP) >> 3); }
__device__ __forceinline__ int row_t(int m) { return m < MP ? (m & (T_P - 1)) : ((m - MP) & (T_S - 1)); }

struct EpiBase { static constexpr bool HOOK = false; int hook_t; };

struct EpiStoreBf16 {
    static constexpr bool HOOK = false; int hook_t;
    bf16* O; int ldc; int act;
    __device__ __forceinline__ void hook_apply(int, int, f32x4&, f32x4&) const {}
    __device__ __forceinline__ void apply(int row, int col, f32x4 v0, f32x4 v1) const {
        if (act == 1) {
#pragma unroll
            for (int j = 0; j < 4; ++j) { float a = fmaxf(v0[j], 0.f), b = fmaxf(v1[j], 0.f); v0[j] = a * a; v1[j] = b * b; } }
        v4u w; w.x = cvt_pk_bf16(v0[0], v0[1]); w.y = cvt_pk_bf16(v0[2], v0[3]); w.z = cvt_pk_bf16(v1[0], v1[1]); w.w = cvt_pk_bf16(v1[2], v1[3]);
        *(v4u*)(O + (size_t)row * ldc + col) = w;
    }
    __device__ __forceinline__ void hook(f32x4 (&)[2][2][4][2], const pg8::Unit&, int, int, int, int) const {}
    __device__ __forceinline__ void operator()(const f32x4 (&acc)[2][2][4][2], const pg8::Unit& u, int wr, int wc, int fr, int fq) const {
        asm volatile("" : "+v"(fr), "+v"(fq));
        const int row0 = u.pm * 256 + wr * 64 + fr, col0 = u.pn * 256 + wc * 32 + 8 * fq;
#pragma unroll
        for (int ai = 0; ai < 2; ++ai)
#pragma unroll
            for (int m = 0; m < 4; ++m) { bf16* rowp = O + (size_t)(row0 + ai * 128 + m * 16) * ldc + col0;
#pragma unroll
                for (int bj = 0; bj < 2; ++bj) { f32x4 v0 = acc[ai][bj][m][0], v1 = acc[ai][bj][m][1];
                    if (act == 1) {
#pragma unroll
                        for (int j = 0; j < 4; ++j) { float a = fmaxf(v0[j], 0.f), b = fmaxf(v1[j], 0.f); v0[j] = a * a; v1[j] = b * b; } }
                    v4u w; w.x = cvt_pk_bf16(v0[0], v0[1]); w.y = cvt_pk_bf16(v0[2], v0[3]); w.z = cvt_pk_bf16(v1[0], v1[1]); w.w = cvt_pk_bf16(v1[2], v1[3]);
                    *(v4u*)(rowp + bj * 128) = w; } }
    }
};

struct EpiMod {
    static constexpr bool HOOK = false; int hook_t;
    float* O; const float* bmix; const float* bmlp;
    __device__ __forceinline__ void hook(f32x4 (&)[2][2][4][2], const pg8::Unit&, int, int, int, int) const {}
    __device__ __forceinline__ void operator()(const f32x4 (&acc)[2][2][4][2], const pg8::Unit& u, int wr, int wc, int fr, int fq) const {
        asm volatile("" : "+v"(fr), "+v"(fq));
        const int row0 = u.pm * 256 + wr * 64 + fr, col0 = u.pn * 256 + wc * 32 + 8 * fq;
        const int mat = (u.pn * 256) / 3072, l = mat >> 1, which = mat & 1;
        const float* bias = (which ? bmlp : bmix) + l * 3072 - mat * 3072;
#pragma unroll
        for (int ai = 0; ai < 2; ++ai)
#pragma unroll
            for (int m = 0; m < 4; ++m) { const int row = row0 + ai * 128 + m * 16; if (row >= NSEQ) continue;
#pragma unroll
                for (int bj = 0; bj < 2; ++bj) { const int col = col0 + bj * 128;
                    const f32x4 b0 = *(const f32x4*)(bias + col), b1 = *(const f32x4*)(bias + col + 4);
                    *(f32x4*)(O + (size_t)row * MODW + col) = acc[ai][bj][m][0] + b0; *(f32x4*)(O + (size_t)row * MODW + col + 4) = acc[ai][bj][m][1] + b1; } }
    }
};

struct EpiRes {
    static constexpr bool HOOK = false; int hook_t;
    float* X; const float* gate;
    __device__ __forceinline__ void hook_apply(int, int, f32x4&, f32x4&) const {}
    __device__ __forceinline__ void apply(int row, int col, f32x4 v0, f32x4 v1) const {
        const float* gr = gate + (size_t)row_seq(row) * MODW + col; float* xr = X + (size_t)row * D + col;
        const f32x4 g0 = *(const f32x4*)gr, g1 = *(const f32x4*)(gr + 4);
        f32x4 x0 = *(const f32x4*)xr, x1 = *(const f32x4*)(xr + 4);
        x0 += g0 * v0; x1 += g1 * v1;
        *(f32x4*)xr = x0; *(f32x4*)(xr + 4) = x1;
    }
    __device__ __forceinline__ void hook(f32x4 (&)[2][2][4][2], const pg8::Unit&, int, int, int, int) const {}
    __device__ __forceinline__ void operator()(const f32x4 (&acc)[2][2][4][2], const pg8::Unit& u, int wr, int wc, int fr, int fq) const {
        asm volatile("" : "+v"(fr), "+v"(fq));
        const int row0 = u.pm * 256 + wr * 64 + fr, col0 = u.pn * 256 + wc * 32 + 8 * fq;
#pragma unroll
        for (int ai = 0; ai < 2; ++ai)
#pragma unroll
            for (int m = 0; m < 4; ++m) { const int row = row0 + ai * 128 + m * 16; const float* gr = gate + (size_t)row_seq(row) * MODW; float* xr = X + (size_t)row * D;
#pragma unroll
                for (int bj = 0; bj < 2; ++bj) { const int col = col0 + bj * 128;
                    const f32x4 g0 = *(const f32x4*)(gr + col), g1 = *(const f32x4*)(gr + col + 4);
                    f32x4 x0 = *(const f32x4*)(xr + col), x1 = *(const f32x4*)(xr + col + 4);
                    x0 += g0 * acc[ai][bj][m][0]; x1 += g1 * acc[ai][bj][m][1];
                    *(f32x4*)(xr + col) = x0; *(f32x4*)(xr + col + 4) = x1; } }
    }
};

struct EpiMerge {
    static constexpr bool HOOK = true; int hook_t;
    const bf16* P; bf16* O;
    __device__ __forceinline__ void hook_apply(int row, int col, f32x4& v0, f32x4& v1) const {
        const bf16* pr = P + (size_t)row * IN_COLS + col; const v4u a = *(const v4u*)(pr + C_GR), b = *(const v4u*)(pr + C_GP);
        const float ga[8] = {bf_lo(a.x), bf_hi(a.x), bf_lo(a.y), bf_hi(a.y), bf_lo(a.z), bf_hi(a.z), bf_lo(a.w), bf_hi(a.w)};
        const float gb[8] = {bf_lo(b.x), bf_hi(b.x), bf_lo(b.y), bf_hi(b.y), bf_lo(b.z), bf_hi(b.z), bf_lo(b.w), bf_hi(b.w)};
#pragma unroll
        for (int j = 0; j < 4; ++j) { v0[j] *= (1.0f + __expf(-gb[j])) / (1.0f + __expf(-ga[j])); v1[j] *= (1.0f + __expf(-gb[4 + j])) / (1.0f + __expf(-ga[4 + j])); }
    }
    __device__ __forceinline__ void apply(int row, int col, f32x4 v0, f32x4 v1) const {
        const v4u b = *(const v4u*)(P + (size_t)row * IN_COLS + C_GP + col);
        const float gb[8] = {bf_lo(b.x), bf_hi(b.x), bf_lo(b.y), bf_hi(b.y), bf_lo(b.z), bf_hi(b.z), bf_lo(b.w), bf_hi(b.w)};
#pragma unroll
        for (int j = 0; j < 4; ++j) { v0[j] *= sigmoidf_(gb[j]); v1[j] *= sigmoidf_(gb[4 + j]); }
        v4u w; w.x = cvt_pk_bf16(v0[0], v0[1]); w.y = cvt_pk_bf16(v0[2], v0[3]); w.z = cvt_pk_bf16(v1[0], v1[1]); w.w = cvt_pk_bf16(v1[2], v1[3]);
        *(v4u*)(O + (size_t)row * D + col) = w;
    }
    __device__ __forceinline__ void hook(f32x4 (&acc)[2][2][4][2], const pg8::Unit& u, int wr, int wc, int fr, int fq) const {
        asm volatile("" : "+v"(fr), "+v"(fq));
        const int row0 = u.pm * 256 + wr * 64 + fr, col0 = u.pn * 256 + wc * 32 + 8 * fq;
#pragma unroll
        for (int ai = 0; ai < 2; ++ai)
#pragma unroll
            for (int m = 0; m < 4; ++m) { const bf16* pr = P + (size_t)(row0 + ai * 128 + m * 16) * IN_COLS + col0;
#pragma unroll
                for (int bj = 0; bj < 2; ++bj) { const v4u a = *(const v4u*)(pr + C_GR + bj * 128), b = *(const v4u*)(pr + C_GP + bj * 128);
                    float ga[8] = {bf_lo(a.x), bf_hi(a.x), bf_lo(a.y), bf_hi(a.y), bf_lo(a.z), bf_hi(a.z), bf_lo(a.w), bf_hi(a.w)};
                    float gb[8] = {bf_lo(b.x), bf_hi(b.x), bf_lo(b.y), bf_hi(b.y), bf_lo(b.z), bf_hi(b.z), bf_lo(b.w), bf_hi(b.w)};
#pragma unroll
                    for (int j = 0; j < 4; ++j) { acc[ai][bj][m][0][j] *= (1.0f + __expf(-gb[j])) / (1.0f + __expf(-ga[j]));
                                                  acc[ai][bj][m][1][j] *= (1.0f + __expf(-gb[4 + j])) / (1.0f + __expf(-ga[4 + j])); } } }
    }
    __device__ __forceinline__ void operator()(const f32x4 (&acc)[2][2][4][2], const pg8::Unit& u, int wr, int wc, int fr, int fq) const {
        asm volatile("" : "+v"(fr), "+v"(fq));
        const int row0 = u.pm * 256 + wr * 64 + fr, col0 = u.pn * 256 + wc * 32 + 8 * fq;
#pragma unroll
        for (int ai = 0; ai < 2; ++ai)
#pragma unroll
            for (int m = 0; m < 4; ++m) { const size_t row = (size_t)(row0 + ai * 128 + m * 16); const bf16* pr = P + row * IN_COLS + col0;
#pragma unroll
                for (int bj = 0; bj < 2; ++bj) { const v4u b = *(const v4u*)(pr + C_GP + bj * 128);
                    float gb[8] = {bf_lo(b.x), bf_hi(b.x), bf_lo(b.y), bf_hi(b.y), bf_lo(b.z), bf_hi(b.z), bf_lo(b.w), bf_hi(b.w)};
                    f32x4 v0 = acc[ai][bj][m][0], v1 = acc[ai][bj][m][1];
#pragma unroll
                    for (int j = 0; j < 4; ++j) { v0[j] *= sigmoidf_(gb[j]); v1[j] *= sigmoidf_(gb[4 + j]); }
                    v4u w; w.x = cvt_pk_bf16(v0[0], v0[1]); w.y = cvt_pk_bf16(v0[2], v0[3]); w.z = cvt_pk_bf16(v1[0], v1[1]); w.w = cvt_pk_bf16(v1[2], v1[3]);
                    *(v4u*)(O + row * D + col0 + bj * 128) = w; } }
    }
};

#define MFMA16(a, b, c) __builtin_amdgcn_mfma_f32_16x16x32_bf16((a), (b), (c), 0, 0, 0)
template <class Epi>
__device__ __forceinline__ void sgemm_tiles(LAS unsigned char* lds, const bf16* A, const bf16* Bt, int N, int K, const Epi& E, int t0, int tstep, int tend) {
    const int tid = launder_tid(), wid = __builtin_amdgcn_readfirstlane(tid >> 6), lane = tid & 63, fr = lane & 15, fq = lane >> 4, wm = wid & 3, wn = wid >> 2;
    int R, C; pg8::stage_rc(tid * 16, R, C);
    const int Rb = (R & ~31) + pg8::perm32(R & 31);
    const unsigned ldsw = (unsigned)wid * 1024u;
    const int aoff = pg8::lds_byte(wm * 16 + fr, fq * 8), boff = 8192 + pg8::lds_byte(wn * 32 + fr, fq * 8);
    const int nk = K / 64;
#define SG_STAGE(slot, kt) do { __builtin_amdgcn_global_load_lds((const unsigned*)(ag + (size_t)(kt) * 64), (LAS unsigned*)(lds + (slot) * 16384 + ldsw), 16, 0, 0); \
                                __builtin_amdgcn_global_load_lds((const unsigned*)(bg + (size_t)(kt) * 64), (LAS unsigned*)(lds + (slot) * 16384 + 8192 + ldsw), 16, 0, 0); } while (0)
    for (int t = t0; t < tend; t += tstep) {
        const int rt = t & 15, ct = t >> 4, r0 = MP + 64 * rt, c0 = 64 * ct;
        const bf16* ag = A + (size_t)(r0 + R) * K + C; const bf16* bg = Bt + (size_t)(c0 + Rb) * K + C;
        f32x4 acc0 = (f32x4){0.f, 0.f, 0.f, 0.f}, acc1 = acc0;
        SG_STAGE(0, 0); SG_STAGE(1, 1); SG_STAGE(2, 2);
        for (int kt = 0; kt < nk; ++kt) {
            if (kt + 2 < nk) asm volatile("s_waitcnt vmcnt(4)" ::: "memory"); else if (kt + 1 < nk) asm volatile("s_waitcnt vmcnt(2)" ::: "memory"); else asm volatile("s_waitcnt vmcnt(0)" ::: "memory");
            __builtin_amdgcn_s_barrier();
            if (kt + 3 < nk) SG_STAGE((kt + 3) & 3, kt + 3);
            if constexpr (Epi::HOOK) { if (kt == E.hook_t) E.hook_apply(r0 + wm * 16 + fr, c0 + wn * 32 + 8 * fq, acc0, acc1); }
            const LAS unsigned char* sl = lds + (kt & 3) * 16384;
            const bf16x8 a0 = *(const LAS bf16x8*)(sl + aoff), a1 = *(const LAS bf16x8*)(sl + aoff + 1024);
            const bf16x8 b00 = *(const LAS bf16x8*)(sl + boff), b01 = *(const LAS bf16x8*)(sl + boff + 1024), b10 = *(const LAS bf16x8*)(sl + boff + 2048), b11 = *(const LAS bf16x8*)(sl + boff + 3072);
            acc0 = MFMA16(b00, a0, acc0); acc1 = MFMA16(b10, a0, acc1);
            acc0 = MFMA16(b01, a1, acc0); acc1 = MFMA16(b11, a1, acc1);
        }
        E.apply(r0 + wm * 16 + fr, c0 + wn * 32 + 8 * fq, acc0, acc1);
        __builtin_amdgcn_s_barrier();
    }
#undef SG_STAGE
}

#define XB_TMO      128
#define XB_XCNT(j)  (256  + 64 * (j))
#define XB_XSUB(j)  (1280 + 64 * (j))
#define XB_XGEN(j)  (2304 + 64 * (j))
#define XB_TOP      3328
#define XB_TOPGEN   3392
#define XCD_BAR_WORDS 3456
#define XB_SPIN_CAP (1u << 22)

__device__ __forceinline__ unsigned xb_ld(unsigned* p)              { return __hip_atomic_load(p, __ATOMIC_RELAXED, __HIP_MEMORY_SCOPE_AGENT); }
__device__ __forceinline__ unsigned xb_add(unsigned* p, unsigned v) { return __hip_atomic_fetch_add(p, v, __ATOMIC_RELAXED, __HIP_MEMORY_SCOPE_AGENT); }
__device__ __forceinline__ unsigned xb_xcc_id() { return (unsigned)__builtin_amdgcn_s_getreg((3 << 11) | 20) & 0xFu; }
#define XB_SPIN(cond, bar) do { unsigned _sp = 0; while (cond) { __builtin_amdgcn_s_sleep(1); \
    if ((++_sp & 255u) == 0u) { if (xb_ld(&(bar)[XB_TMO])) break; if (_sp > XB_SPIN_CAP) { atomicAdd(&(bar)[XB_TMO], 1u); break; } } } } while (0)

struct XcdBarrier { unsigned* bar; unsigned x; volatile LAS unsigned* st; };

__device__ __forceinline__ XcdBarrier xcd_barrier_post(unsigned* bar, volatile LAS unsigned* st) {
    XcdBarrier b; b.bar = bar; b.x = xb_xcc_id(); b.st = st;
    if (threadIdx.x == 0) (void)xb_add(&bar[XB_XCNT(b.x)], 1u);
    return b;
}
__device__ __forceinline__ void xcd_barrier_complete(unsigned* bar, unsigned x, unsigned& nloc, unsigned& nx) {
    const unsigned G = gridDim.x * gridDim.y * gridDim.z;
    unsigned sum, cnt, mine, sp = 0u;
    for (;;) {
        sum = 0u; cnt = 0u; mine = 0u;
#pragma unroll
        for (unsigned j = 0; j < 16; ++j) { const unsigned c = xb_ld(&bar[XB_XCNT(j)]); sum += c; cnt += (c > 0u) ? 1u : 0u; mine = (j == x) ? c : mine; }
        if (sum == G) break;
        __builtin_amdgcn_s_sleep(1);
        if ((++sp & 255u) == 0u) { if (xb_ld(&bar[XB_TMO])) break; if (sp > XB_SPIN_CAP) { atomicAdd(&bar[XB_TMO], 1u); break; } }
    }
    nloc = mine > 0u ? mine : 1u; nx = cnt > 0u ? cnt : 1u;
}
__device__ __forceinline__ void xcd_barrier(const XcdBarrier& b) {
    asm volatile("s_waitcnt vmcnt(0)" ::: "memory");
    __syncthreads();
    if (threadIdx.x == 0) {
        unsigned* bar = b.bar;
        __builtin_amdgcn_s_waitcnt(0);
        unsigned nloc = b.st[0], nx = b.st[1];
        if (nloc == 0u) { xcd_barrier_complete(bar, b.x, nloc, nx); b.st[0] = nloc; b.st[1] = nx; }
        const unsigned old = xb_add(&bar[XB_XSUB(b.x)], 1u);
        const unsigned gen = old / nloc;
        if (old + 1u == (gen + 1u) * nloc) {
            __builtin_amdgcn_fence(__ATOMIC_RELEASE, "agent");
            asm volatile("s_waitcnt vmcnt(0)" ::: "memory");
            const unsigned og = xb_add(&bar[XB_TOP], 1u);
            const unsigned tg = og / nx;
            if (og + 1u == (tg + 1u) * nx) xb_add(&bar[XB_TOPGEN], 1u);
            else XB_SPIN(xb_ld(&bar[XB_TOPGEN]) == tg, bar);
            __builtin_amdgcn_fence(__ATOMIC_ACQUIRE, "agent");
            xb_add(&bar[XB_XGEN(b.x)], 1u);
            asm volatile("s_waitcnt vmcnt(0)" ::: "memory");
        } else {
            XB_SPIN(xb_ld(&bar[XB_XGEN(b.x)]) == gen, bar);
            __builtin_amdgcn_fence(__ATOMIC_ACQUIRE, "agent");
            asm volatile("s_waitcnt vmcnt(0)" ::: "memory");
        }
    }
    __syncthreads();
}

struct Args { const float* in[N_IN]; float* out; unsigned char* ws; int ph_lo, ph_hi; };

__device__ __forceinline__ void transpose_item(const float* W, int N, bf16* WT, int ldt, int item, LAS float* scr, int lane) {
    const int nblk = N / 32, kb = item / nblk, nb = item % nblk, k0 = 64 * kb, n0 = 32 * nb;
#pragma unroll 8
    for (int i = 0; i < 32; ++i) { const int kk = 2 * i + (lane >> 5); scr[kk * 33 + (lane & 31)] = W[(size_t)(k0 + kk) * N + n0 + (lane & 31)]; }
    LDS_WAIT(); asm volatile("" ::: "memory");
    const int c = lane & 7;
#pragma unroll
    for (int j = 0; j < 4; ++j) { const int n = (lane >> 3) + 8 * j; const LAS float* s = scr + (8 * c) * 33 + n;
        v4u o; o.x = cvt_pk_bf16(s[0 * 33], s[1 * 33]); o.y = cvt_pk_bf16(s[2 * 33], s[3 * 33]); o.z = cvt_pk_bf16(s[4 * 33], s[5 * 33]); o.w = cvt_pk_bf16(s[6 * 33], s[7 * 33]);
        *(v4u*)(WT + (size_t)(n0 + n) * ldt + k0 + 8 * c) = o; }
    LDS_WAIT(); asm volatile("" ::: "memory");
}

struct PrepCtx {
    const bf16* P; const float* sshift; const float* spool; const float* mu;
};
__device__ __forceinline__ void load_xl8(const PrepCtx& c, int m, int seq, int t, int col, float (&o)[8]) {
    const v4u cu = *(const v4u*)(c.P + (size_t)m * IN_COLS + col);
    float cur[8] = {bf_lo(cu.x), bf_hi(cu.x), bf_lo(cu.y), bf_hi(cu.y), bf_lo(cu.z), bf_hi(cu.z), bf_lo(cu.w), bf_hi(cu.w)};
    float pv[8];
    if (t > 0) { const v4u pu = *(const v4u*)(c.P + (size_t)(m - 1) * IN_COLS + col);
        pv[0] = bf_lo(pu.x); pv[1] = bf_hi(pu.x); pv[2] = bf_lo(pu.y); pv[3] = bf_hi(pu.y); pv[4] = bf_lo(pu.z); pv[5] = bf_hi(pu.z); pv[6] = bf_lo(pu.w); pv[7] = bf_hi(pu.w); }
    else if (seq >= NSEQ_P) { const float* s = c.sshift + (size_t)(seq - NSEQ_P) * RWKV_COLS + col; const f32x4 a = *(const f32x4*)s, b = *(const f32x4*)(s + 4);
        pv[0] = a[0]; pv[1] = a[1]; pv[2] = a[2]; pv[3] = a[3]; pv[4] = b[0]; pv[5] = b[1]; pv[6] = b[2]; pv[7] = b[3]; }
    else {
#pragma unroll
        for (int i = 0; i < 8; ++i) pv[i] = 0.f; }
    const f32x4 m0 = *(const f32x4*)(c.mu + col), m1 = *(const f32x4*)(c.mu + col + 4);
#pragma unroll
    for (int i = 0; i < 4; ++i) { o[i] = cur[i] + (pv[i] - cur[i]) * m0[i]; o[4 + i] = cur[4 + i] + (pv[4 + i] - cur[4 + i]) * m1[i]; }
}
__device__ __forceinline__ void load_xl4(const PrepCtx& c, int m, int seq, int t, int col, float (&o)[4]) {
    const v2u cu = *(const v2u*)(c.P + (size_t)m * IN_COLS + col);
    float cur[4] = {bf_lo(cu.x), bf_hi(cu.x), bf_lo(cu.y), bf_hi(cu.y)};
    float pv[4];
    if (t > 0) { const v2u pu = *(const v2u*)(c.P + (size_t)(m - 1) * IN_COLS + col); pv[0] = bf_lo(pu.x); pv[1] = bf_hi(pu.x); pv[2] = bf_lo(pu.y); pv[3] = bf_hi(pu.y); }
    else if (seq >= NSEQ_P) { const f32x4 a = *(const f32x4*)(c.sshift + (size_t)(seq - NSEQ_P) * RWKV_COLS + col); pv[0] = a[0]; pv[1] = a[1]; pv[2] = a[2]; pv[3] = a[3]; }
    else { pv[0] = pv[1] = pv[2] = pv[3] = 0.f; }
    const f32x4 m0 = *(const f32x4*)(c.mu + col);
#pragma unroll
    for (int i = 0; i < 4; ++i) o[i] = cur[i] + (pv[i] - cur[i]) * m0[i];
}
__device__ __forceinline__ bf16x8 pack8(const float (&f)[8]) {
    v4u u; u.x = cvt_pk_bf16(f[0], f[1]); u.y = cvt_pk_bf16(f[2], f[3]); u.z = cvt_pk_bf16(f[4], f[5]); u.w = cvt_pk_bf16(f[6], f[7]);
    return __builtin_bit_cast(bf16x8, u);
}
__device__ __forceinline__ v2u pack4(float a, float b, float c, float d) { v2u u; u.x = cvt_pk_bf16(a, b); u.y = cvt_pk_bf16(c, d); return u; }

__global__ void __launch_bounds__(NTHR, 2) mk_fwd(Args args) {
    extern __shared__ __attribute__((aligned(16))) unsigned char lds_raw[];
    LAS unsigned char* lds = (LAS unsigned char*)lds_raw;
    const int G = gridDim.x, NGW = G * NWAVES;
#define PH_IDS() const int tid = launder_tid(), lane = tid & 63, wave = __builtin_amdgcn_readfirstlane(tid >> 6), gw = blockIdx.x * NWAVES + wave; LAS float* scr = (LAS float*)(lds + wave * 16384); (void)lane; (void)gw; (void)scr
    unsigned char* ws = args.ws;
    float* out = args.out;
    unsigned* ctl = (unsigned*)(ws + WS_CTL);
    volatile LAS unsigned* MISC = (volatile LAS unsigned*)(lds + MISC_OFF);
    for (int u = threadIdx.x; u < (LDS_BYTES - LDSCTL_OFF) / 4; u += NTHR) ((LAS unsigned*)(lds + LDSCTL_OFF))[u] = 0u;
    __syncthreads();
    const int lo = args.ph_lo, hi = args.ph_hi;
    XcdBarrier bar; bar.bar = ctl + CW_BAR; bar.x = 0; bar.st = nullptr;
    if (hi - lo > 1) bar = xcd_barrier_post(ctl + CW_BAR, MISC + 8);
#define IN(k) (lo <= (k) && (k) < hi)
#define SEAM(k) do { if (IN(k) && IN((k) + 1)) xcd_barrier(bar); } while (0)
#define SAMPLE_TILES(Abuf, Btp, N_, K_, E_, nbig) do { const int nt_ = 16 * ((N_) / 64), rem_ = (nbig) % G; int first_ = 0, cnt_ = G; if (rem_ > 0 && rem_ <= G / 2) { first_ = rem_; cnt_ = G - rem_; } \
        if ((int)blockIdx.x >= first_) sgemm_tiles(lds, Abuf, Btp, N_, K_, E_, (int)blockIdx.x - first_, cnt_, nt_); } while (0)

    float* X = out + O_Y;
    float* MOD = (float*)(ws + WS_MOD);
    bf16* SC = (bf16*)(ws + WS_SC);
    bf16* H = (bf16*)(ws + WS_H);
    bf16* P = (bf16*)(ws + WS_P);
    bf16* Rb = (bf16*)(ws + WS_R); bf16* K2b = (bf16*)(ws + WS_K2); bf16* Vb = (bf16*)(ws + WS_V); bf16* KKb = (bf16*)(ws + WS_KK); bf16* Bb = (bf16*)(ws + WS_B);
    float* Wd = (float*)(ws + WS_W);
    bf16* ORP = (bf16*)(ws + WS_ORP); bf16* Gb = (bf16*)(ws + WS_G); bf16* VF = (bf16*)(ws + WS_VF);
    float* Y = (float*)(ws + WS_Y);
    bf16* WIN_T = (bf16*)(ws + WS_WIN); bf16* WBR_T = (bf16*)(ws + WS_WBR); bf16* WOUT_T = (bf16*)(ws + WS_WOUT); bf16* WFF1_T = (bf16*)(ws + WS_WFF1); bf16* WFF2_T = (bf16*)(ws + WS_WFF2);
    bf16* W2T = (bf16*)(ws + WS_WSM + SM_W2); bf16* A2T = (bf16*)(ws + WS_WSM + SM_A2); bf16* G2T = (bf16*)(ws + WS_WSM + SM_G2);
    bf16* V1T = (bf16*)(ws + WS_WSM + SM_V1); bf16* V2T = (bf16*)(ws + WS_WSM + SM_V2); bf16* PWT = (bf16*)(ws + WS_WSM + SM_PW);
    bf16* ADA_T = P;

    int ph = 0;
    if (IN(ph)) for (int rep_ = 0; rep_ < DUPN(10); ++rep_) { PH_IDS();
        constexpr int I_ADA = (D / 64) * (3072 / 32);
        for (int it = gw; it < 8 * I_ADA; it += NGW) { const int mat = it / I_ADA, r = it % I_ADA, l = mat >> 1, which = mat & 1;
            const float* W = (which ? args.in[I_WADAMLP] : args.in[I_WADAMIX]) + (size_t)l * D * 3072;
            transpose_item(W, 3072, ADA_T + (size_t)mat * 3072 * D, D, r, scr, lane); }
        for (int r = gw; r < 256; r += NGW) {
            const float* c = r < NSEQ_P ? args.in[I_CP] + (size_t)r * D : args.in[I_CS] + (size_t)(r - NSEQ_P) * D;
#pragma unroll
            for (int j = 0; j < 4; ++j) { f32x4 v = (f32x4){0.f, 0.f, 0.f, 0.f}; if (r < NSEQ) v = *(const f32x4*)(c + 4 * lane + 256 * j);
#pragma unroll
                for (int i = 0; i < 4; ++i) v[i] = v[i] * sigmoidf_(v[i]);
                *(v2u*)(SC + (size_t)r * D + 4 * lane + 256 * j) = pack4(v[0], v[1], v[2], v[3]); } }
        for (int m = gw; m < M; m += NGW) {
            const float* src = m < MP ? args.in[I_XP] + (size_t)m * D : args.in[I_XS] + (size_t)(m - MP) * D;
#pragma unroll
            for (int j = 0; j < 4; ++j) *(f32x4*)(X + (size_t)m * D + 4 * lane + 256 * j) = *(const f32x4*)(src + 4 * lane + 256 * j); }
    }
    SEAM(ph); ++ph;
    if (IN(ph)) for (int rep_ = 0; rep_ < DUPN(11); ++rep_) {
        pg8::Gemm g{SC, ADA_T, 256, MODW, D}; pg8::StaticOrder S; S.init(256, MODW, G, (int)blockIdx.x);
        EpiMod E{0, MOD, args.in[I_BADAMIX], args.in[I_BADAMLP]};
        pg8::gemm_phase<EpiMod, pg8::StaticOrder, true, true>(lds, g, S, E);
    }
    SEAM(ph); ++ph;

    for (int l = 0; l < DEPTH; ++l) {
        const float* modmix = MOD + (size_t)(2 * l) * 3072;
        const float* modmlp = MOD + (size_t)(2 * l + 1) * 3072;
        if (IN(ph)) for (int rep_ = 0; rep_ < DUPN(0); ++rep_) { PH_IDS();
            constexpr int N_IN_ = (D / 64) * (IN_COLS / 32), N_BR = (MIX / 64) * (D / 32), N_OUT = (D / 64) * (D / 32), N_F1 = (D / 64) * (DFF / 32), N_F2 = (DFF / 64) * (D / 32);
            constexpr int N_W2 = 1 * 16, N_G2 = 2 * 16, N_V1 = 8 * 1, N_PW = 4 * (2 * 4);
            constexpr int TOT = N_IN_ + 2 * N_BR + N_OUT + N_F1 + N_F2 + 2 * N_W2 + N_G2 + N_V1 + N_PW;
            for (int it = gw; it < TOT; it += NGW) { int r = it;
                if (r < N_IN_) { transpose_item(args.in[I_WIN] + (size_t)l * D * IN_COLS, IN_COLS, WIN_T, D, r, scr, lane); continue; } r -= N_IN_;
                if (r < N_BR) { transpose_item(args.in[I_WBRR] + (size_t)l * MIX * D, D, WBR_T, D, r, scr, lane); continue; } r -= N_BR;
                if (r < N_BR) { transpose_item(args.in[I_WBRP] + (size_t)l * POOLW * D, D, WBR_T + MIX, D, r, scr, lane); continue; } r -= N_BR;
                if (r < N_OUT) { transpose_item(args.in[I_WOUT] + (size_t)l * D * D, D, WOUT_T, D, r, scr, lane); continue; } r -= N_OUT;
                if (r < N_F1) { transpose_item(args.in[I_WFF1] + (size_t)l * D * DFF, DFF, WFF1_T, D, r, scr, lane); continue; } r -= N_F1;
                if (r < N_F2) { transpose_item(args.in[I_WFF2] + (size_t)l * DFF * D, D, WFF2_T, DFF, r, scr, lane); continue; } r -= N_F2;
                if (r < N_W2) { transpose_item(args.in[I_W2] + (size_t)l * 64 * MIX, MIX, W2T, 64, r, scr, lane); continue; } r -= N_W2;
                if (r < N_W2) { transpose_item(args.in[I_A2] + (size_t)l * 64 * MIX, MIX, A2T, 64, r, scr, lane); continue; } r -= N_W2;
                if (r < N_G2) { transpose_item(args.in[I_G2] + (size_t)l * 128 * MIX, MIX, G2T, 128, r, scr, lane); continue; } r -= N_G2;
                if (r < N_V1) { if (l > 0) transpose_item(args.in[I_V1] + (size_t)(l - 1) * MIX * 32, 32, V1T, MIX, r, scr, lane); continue; } r -= N_V1;
                { const int gi = r / 8; transpose_item(args.in[I_POOLW] + ((size_t)l * 4 + gi) * PGRP * PGRP, PGRP, PWT + (size_t)gi * PGRP * PGRP, PGRP, r % 8, scr, lane); }
            }
            if (l > 0) {
                const float* v2 = args.in[I_V2] + (size_t)(l - 1) * 32 * MIX;
                for (int e = blockIdx.x * NTHR + tid; e < 32 * MIX; e += G * NTHR) { const int n = e >> 5, k = e & 31; V2T[e] = (bf16)(cvt_pk_bf16(v2[(size_t)k * MIX + n], 0.f) & 0xffffu); }
            }
            const float* nw = args.in[I_NORMMIX] + (size_t)l * D;
            for (int m = gw; m < M; m += NGW) {
                const float* xr = X + (size_t)m * D; const float* mo = modmix + (size_t)row_seq(m) * MODW;
                f32x4 v[4]; float s = 0.f;
#pragma unroll
                for (int j = 0; j < 4; ++j) { v[j] = *(const f32x4*)(xr + 4 * lane + 256 * j); s += (v[j][0] * v[j][0] + v[j][1] * v[j][1]) + (v[j][2] * v[j][2] + v[j][3] * v[j][3]); }
                const float rstd = 1.0f / sqrtf(wave_sum(s) * (1.0f / D) + 1e-6f);
#pragma unroll
                for (int j = 0; j < 4; ++j) { const int c = 4 * lane + 256 * j; const f32x4 g = *(const f32x4*)(nw + c), sh = *(const f32x4*)(mo + c), sc = *(const f32x4*)(mo + 1024 + c);
                    f32x4 o;
#pragma unroll
                    for (int i = 0; i < 4; ++i) o[i] = v[j][i] * rstd * g[i] * (1.0f + sc[i]) + sh[i];
                    *(v2u*)(H + (size_t)m * D + c) = pack4(o[0], o[1], o[2], o[3]); }
            }
        }
        SEAM(ph); ++ph;
        if (IN(ph)) for (int rep_ = 0; rep_ < DUPN(1); ++rep_) {
            pg8::Gemm g{H, WIN_T, MP, IN_COLS, D}; pg8::StaticOrder S; S.init(MP, IN_COLS, G, (int)blockIdx.x);
            EpiStoreBf16 E{0, P, IN_COLS, 0};
            pg8::gemm_phase<EpiStoreBf16, pg8::StaticOrder, true, true>(lds, g, S, E);
            SAMPLE_TILES(H, WIN_T, IN_COLS, D, E, (MP / 256) * (IN_COLS / 256));
        }
        SEAM(ph); ++ph;
        if (IN(ph)) for (int rep_ = 0; rep_ < DUPN(2); ++rep_) { PH_IDS();
            PrepCtx pc; pc.P = P; pc.sshift = args.in[I_SSHIFT] + (size_t)l * NSEQ_S * RWKV_COLS; pc.spool = args.in[I_SPOOL] + (size_t)l * NSEQ_S * PBUF * POOLW; pc.mu = args.in[I_MU] + (size_t)l * RWKV_COLS;
            const float* w0 = args.in[I_W0] + (size_t)l * MIX; const float* a0 = args.in[I_A0] + (size_t)l * MIX;
            const float* kkw = args.in[I_KK] + (size_t)l * MIX; const float* kaw = args.in[I_KA] + (size_t)l * MIX;
            const float* v0 = l > 0 ? args.in[I_V0] + (size_t)(l - 1) * MIX : nullptr;
            const float* pscale = args.in[I_POOLS] + (size_t)l * POOLW;
            constexpr int NTILE = M / 16, NTASK = 6 * NTILE + NSEQ;
            for (int task = gw; task < NTASK; task += NGW) {
                int ln_ = lane; asm volatile("" : "+v"(ln_));
                const int tok = ln_ & 15, q = ln_ >> 4;
                if (task >= 6 * NTILE) {
                    const int seq = task - 6 * NTILE;
                    if (seq < NSEQ_P) {
                        const int mlast = seq * T_P + T_P - 1;
                        float* so = out + O_SHP + ((size_t)l * NSEQ_P + seq) * RWKV_COLS;
                        for (int c = lane; c < RWKV_COLS; c += 64) so[c] = bf_lo((unsigned)P[(size_t)mlast * IN_COLS + c]);
                        float* po = out + O_POP + ((size_t)l * NSEQ_P + seq) * PBUF * POOLW;
                        for (int e = lane; e < PBUF * POOLW; e += 64) { const int i = e >> 9, c = e & 511; po[e] = bf_lo((unsigned)P[(size_t)(mlast - 14 + i) * IN_COLS + C_PP + c]); }
                    } else {
                        const int b = seq - NSEQ_P, mfirst = MP + b * T_S;
                        float* so = out + O_SHS + ((size_t)l * NSEQ_S + b) * RWKV_COLS;
                        for (int c = lane; c < RWKV_COLS; c += 64) so[c] = bf_lo((unsigned)P[(size_t)(mfirst + T_S - 1) * IN_COLS + c]);
                        float* po = out + O_POS + ((size_t)l * NSEQ_S + b) * PBUF * POOLW; const float* sp = pc.spool + (size_t)b * PBUF * POOLW;
                        for (int e = lane; e < PBUF * POOLW; e += 64) { const int i = e >> 9, c = e & 511;
                            po[e] = i < 7 ? sp[(size_t)(8 + i) * POOLW + c] : bf_lo((unsigned)P[(size_t)(mfirst + i - 7) * IN_COLS + C_PP + c]); }
                    }
                    continue;
                }
                const int type = task / NTILE, tile = task % NTILE, m = tile * 16 + tok, seq = row_seq(m), t = row_t(m);
                if (type == 0) {
#pragma unroll 2
                    for (int cb = q; cb < 64; cb += 4) { float x[8]; load_xl8(pc, m, seq, t, C_R + 8 * cb, x);
                        *(bf16x8*)(Rb + (size_t)m * MIX + 8 * cb) = pack8(x); }
                    if (l == 0)
#pragma unroll 2
                    for (int cb = q; cb < 64; cb += 4) { float x[8]; load_xl8(pc, m, seq, t, C_V + 8 * cb, x); const bf16x8 pk = pack8(x);
                        *(bf16x8*)(Vb + (size_t)m * MIX + 8 * cb) = pk; *(bf16x8*)(VF + (size_t)m * MIX + 8 * cb) = pk; }
                } else if (type == 1) {
                    bf16x8 af[2];
#pragma unroll
                    for (int ks = 0; ks < 2; ++ks) { float x[8]; load_xl8(pc, m, seq, t, C_XW + 32 * ks + 8 * q, x);
#pragma unroll
                        for (int i = 0; i < 8; ++i) x[i] = tanhf_(x[i]);
                        af[ks] = pack8(x); }
#pragma unroll 2
                    for (int nt = 0; nt < 32; ++nt) { f32x4 acc = (f32x4){0.f, 0.f, 0.f, 0.f};
#pragma unroll
                        for (int ks = 0; ks < 2; ++ks) { const bf16x8 wf = *(const bf16x8*)(W2T + (size_t)(16 * nt + tok) * 64 + 32 * ks + 8 * q); acc = MFMA16(wf, af[ks], acc); }
                        const int c = 16 * nt + 4 * q; const f32x4 w0v = *(const f32x4*)(w0 + c); f32x4 o;
#pragma unroll
                        for (int r = 0; r < 4; ++r) o[r] = __expf(-0.6065306597126334f * sigmoidf_(w0v[r] + acc[r]));
                        *(f32x4*)(Wd + (size_t)m * MIX + c) = o; }
                } else if (type == 2) {
                    bf16x8 af[2];
#pragma unroll
                    for (int ks = 0; ks < 2; ++ks) { float x[8]; load_xl8(pc, m, seq, t, C_XA + 32 * ks + 8 * q, x); af[ks] = pack8(x); }
#pragma unroll 1
                    for (int hh = 0; hh < NH; ++hh) {
                        float kv[4][4], av[4][4], kkv[4][4]; float ss = 0.f;
#pragma unroll
                        for (int n4 = 0; n4 < 4; ++n4) { const int nt = 4 * hh + n4; f32x4 acc = (f32x4){0.f, 0.f, 0.f, 0.f};
#pragma unroll
                            for (int ks = 0; ks < 2; ++ks) { const bf16x8 wf = *(const bf16x8*)(A2T + (size_t)(16 * nt + tok) * 64 + 32 * ks + 8 * q); acc = MFMA16(wf, af[ks], acc); }
                            const int c = 16 * nt + 4 * q; const f32x4 a0v = *(const f32x4*)(a0 + c), kkwv = *(const f32x4*)(kkw + c);
                            load_xl4(pc, m, seq, t, C_K + c, kv[n4]);
#pragma unroll
                            for (int r = 0; r < 4; ++r) { av[n4][r] = sigmoidf_(a0v[r] + acc[r]); kkv[n4][r] = kv[n4][r] * kkwv[r]; ss += kkv[n4][r] * kkv[n4][r]; } }
                        ss += __shfl_xor(ss, 16); ss += __shfl_xor(ss, 32);
                        const float rn = 1.0f / sqrtf(ss + 1e-12f);
#pragma unroll
                        for (int n4 = 0; n4 < 4; ++n4) { const int c = 16 * (4 * hh + n4) + 4 * q; const f32x4 kav = *(const f32x4*)(kaw + c);
                            float k2[4], kn[4], bb[4];
#pragma unroll
                            for (int r = 0; r < 4; ++r) { kn[r] = kkv[n4][r] * rn; k2[r] = kv[n4][r] * (1.0f + (av[n4][r] - 1.0f) * kav[r]); bb[r] = kn[r] * av[n4][r]; }
                            *(v2u*)(K2b + (size_t)m * MIX + c) = pack4(k2[0], k2[1], k2[2], k2[3]);
                            *(v2u*)(KKb + (size_t)m * MIX + c) = pack4(kn[0], kn[1], kn[2], kn[3]);
                            *(v2u*)(Bb + (size_t)m * MIX + c) = pack4(bb[0], bb[1], bb[2], bb[3]); }
                    }
                } else if (type == 3) {
                    bf16x8 af[4];
#pragma unroll
                    for (int ks = 0; ks < 4; ++ks) { float x[8]; load_xl8(pc, m, seq, t, C_XG + 32 * ks + 8 * q, x);
#pragma unroll
                        for (int i = 0; i < 8; ++i) x[i] = sigmoidf_(x[i]);
                        af[ks] = pack8(x); }
#pragma unroll 2
                    for (int nt = 0; nt < 32; ++nt) { f32x4 acc = (f32x4){0.f, 0.f, 0.f, 0.f};
#pragma unroll
                        for (int ks = 0; ks < 4; ++ks) { const bf16x8 wf = *(const bf16x8*)(G2T + (size_t)(16 * nt + tok) * 128 + 32 * ks + 8 * q); acc = MFMA16(wf, af[ks], acc); }
                        *(v2u*)(Gb + (size_t)m * MIX + 16 * nt + 4 * q) = pack4(acc[0], acc[1], acc[2], acc[3]); }
                } else if (type == 4) {
                    if (l > 0) {
                        f32x4 a1[2] = {(f32x4){0.f, 0.f, 0.f, 0.f}, (f32x4){0.f, 0.f, 0.f, 0.f}};
#pragma unroll 2
                        for (int ks = 0; ks < 16; ++ks) { float x[8]; load_xl8(pc, m, seq, t, C_V + 32 * ks + 8 * q, x); const bf16x8 af = pack8(x);
#pragma unroll
                            for (int nt = 0; nt < 2; ++nt) { const bf16x8 wf = *(const bf16x8*)(V1T + (size_t)(16 * nt + tok) * MIX + 32 * ks + 8 * q); a1[nt] = MFMA16(wf, af, a1[nt]); } }
                        float tt[8] = {a1[0][0], a1[0][1], a1[0][2], a1[0][3], a1[1][0], a1[1][1], a1[1][2], a1[1][3]};
                        const bf16x8 tf = pack8(tt);
#pragma unroll 2
                        for (int nt = 0; nt < 32; ++nt) {
                            const v2u wa = *(const v2u*)(V2T + (size_t)(16 * nt + tok) * 32 + 4 * q), wb = *(const v2u*)(V2T + (size_t)(16 * nt + tok) * 32 + 16 + 4 * q);
                            v4u wu; wu.x = wa.x; wu.y = wa.y; wu.z = wb.x; wu.w = wb.y;
                            const f32x4 acc = MFMA16(__builtin_bit_cast(bf16x8, wu), tf, ((f32x4){0.f, 0.f, 0.f, 0.f}));
                            const int c = 16 * nt + 4 * q; float vv[4]; load_xl4(pc, m, seq, t, C_V + c, vv);
                            const f32x4 v0v = *(const f32x4*)(v0 + c); const v2u vfu = *(const v2u*)(VF + (size_t)m * MIX + c);
                            const float vf[4] = {bf_lo(vfu.x), bf_hi(vfu.x), bf_lo(vfu.y), bf_hi(vfu.y)}; float o[4];
#pragma unroll
                            for (int r = 0; r < 4; ++r) o[r] = vv[r] + (vf[r] - vv[r]) * sigmoidf_(v0v[r] + acc[r]);
                            *(v2u*)(Vb + (size_t)m * MIX + c) = pack4(o[0], o[1], o[2], o[3]); }
                    }
                } else {
#pragma unroll 1
                    for (int gi = 0; gi < 4; ++gi) { const int win = 2 << gi; bf16x8 af[4];
#pragma unroll
                        for (int ks = 0; ks < 4; ++ks) { const int c = PGRP * gi + 32 * ks + 8 * q; float sum[8], cur[8];
                            __builtin_amdgcn_sched_barrier(0);
#pragma unroll
                            for (int i = 0; i < 8; ++i) { sum[i] = 0.f; cur[i] = 0.f; }
#pragma unroll 2
                            for (int i = 0; i < win; ++i) { const int tt = t - i; float x[8];
                                if (tt >= 0) { const v4u u = *(const v4u*)(P + (size_t)(m - i) * IN_COLS + C_PP + c);
                                    x[0] = bf_lo(u.x); x[1] = bf_hi(u.x); x[2] = bf_lo(u.y); x[3] = bf_hi(u.y); x[4] = bf_lo(u.z); x[5] = bf_hi(u.z); x[6] = bf_lo(u.w); x[7] = bf_hi(u.w); }
                                else if (seq >= NSEQ_P) { const float* s = pc.spool + ((size_t)(seq - NSEQ_P) * PBUF + (PBUF + tt)) * POOLW + c; const f32x4 a = *(const f32x4*)s, b = *(const f32x4*)(s + 4);
                                    x[0] = a[0]; x[1] = a[1]; x[2] = a[2]; x[3] = a[3]; x[4] = b[0]; x[5] = b[1]; x[6] = b[2]; x[7] = b[3]; }
                                else {
#pragma unroll
                                    for (int j = 0; j < 8; ++j) x[j] = 0.f; }
#pragma unroll
                                for (int j = 0; j < 8; ++j) { sum[j] += x[j]; if (i == 0) cur[j] = x[j]; } }
                            const float inv = 1.0f / (float)((seq < NSEQ_P && t + 1 < win) ? t + 1 : win);
#pragma unroll
                            for (int j = 0; j < 8; ++j) sum[j] = sum[j] * inv - cur[j];
                            af[ks] = pack8(sum); }
#pragma unroll 2
                        for (int nt = 0; nt < 8; ++nt) { f32x4 acc = (f32x4){0.f, 0.f, 0.f, 0.f};
#pragma unroll
                            for (int ks = 0; ks < 4; ++ks) { const bf16x8 wf = *(const bf16x8*)(PWT + ((size_t)gi * PGRP + 16 * nt + tok) * PGRP + 32 * ks + 8 * q); acc = MFMA16(wf, af[ks], acc); }
                            const int d = PGRP * gi + 16 * nt + 4 * q; const f32x4 sc = *(const f32x4*)(pscale + d);
                            *(v2u*)(ORP + (size_t)m * D + MIX + d) = pack4(acc[0] * sc[0], acc[1] * sc[1], acc[2] * sc[2], acc[3] * sc[3]); } }
                }
            }
        }
        SEAM(ph); ++ph;
        if (IN(ph)) for (int rep_ = 0; rep_ < DUPN(3); ++rep_) { PH_IDS();
            constexpr int SB_F = 5 * 1024 + 256 + 4096;
            LAS float* lbase = (LAS float*)lds;
            constexpr int NITEM = NSEQ * NH * 4;
            const bool is_ld = wave >= 4;
            const int rl = lane >> 4, kq = lane & 15, lrow = (wave & 3) * 4 + rl;
            const int j = tid - 256, js = j >> 4, jk = (j & 15) * 4, jr = j & 15;
            for (int item = blockIdx.x; item < NITEM; item += G) {
                const int seq = item >> 5, hh = (item >> 2) & 7, qtr = item & 3;
                const int T = seq < NSEQ_P ? T_P : T_S, mbase = seq < NSEQ_P ? seq * T_P : MP + (seq - NSEQ_P) * T_S;
                const int CH = T < 16 ? T : 16, nch = T / CH;
                const int vg = 16 * qtr + lrow;
                f32x4 S = (f32x4){0.f, 0.f, 0.f, 0.f};
                if (!is_ld && seq >= NSEQ_P) S = *(const f32x4*)(args.in[I_SWKV] + ((((size_t)l * NSEQ_S + (seq - NSEQ_P)) * NH + hh) * HS + vg) * HS + 4 * kq);
                f32x4 pw = (f32x4){0.f, 0.f, 0.f, 0.f}; v2u pkk = (v2u){0u, 0u}, pb = pkk, pk = pkk, pr = pkk; unsigned short pv = 0;
                const bool sact = is_ld && js < CH;
#define SCAN_LOAD(c0) do { if (sact) { const size_t mm = (size_t)(mbase + (c0) + js) * MIX + 64 * hh; pw = *(const f32x4*)(Wd + mm + jk); pkk = *(const v2u*)(KKb + mm + jk); pb = *(const v2u*)(Bb + mm + jk); \
                    pk = *(const v2u*)(K2b + mm + jk); pr = *(const v2u*)(Rb + mm + jk); pv = Vb[mm + 16 * qtr + jr]; } } while (0)
#define SCAN_STORE(bf) do { if (sact) { LAS float* b_ = lbase + (bf) * SB_F; *(LAS f32x4*)(b_ + js * 64 + jk) = pw; *(LAS f32x4*)(b_ + 1024 + js * 64 + jk) = (f32x4){bf_lo(pkk.x), bf_hi(pkk.x), bf_lo(pkk.y), bf_hi(pkk.y)}; \
                    *(LAS f32x4*)(b_ + 2048 + js * 64 + jk) = (f32x4){-bf_lo(pb.x), -bf_hi(pb.x), -bf_lo(pb.y), -bf_hi(pb.y)}; *(LAS f32x4*)(b_ + 3072 + js * 64 + jk) = (f32x4){bf_lo(pk.x), bf_hi(pk.x), bf_lo(pk.y), bf_hi(pk.y)}; \
                    *(LAS f32x4*)(b_ + 4096 + js * 64 + jk) = (f32x4){bf_lo(pr.x), bf_hi(pr.x), bf_lo(pr.y), bf_hi(pr.y)}; b_[5120 + js * 16 + jr] = bf_lo((unsigned)pv); } } while (0)
#define SCAN_YOUT(bf, c0) do { if (sact) { const LAS float* y_ = lbase + (bf) * SB_F + 5376 + js * 256 + jr * 16; const f32x4 a_ = *(const LAS f32x4*)y_, b2_ = *(const LAS f32x4*)(y_ + 4), c_ = *(const LAS f32x4*)(y_ + 8), d_ = *(const LAS f32x4*)(y_ + 12); \
                    const f32x4 t_ = (a_ + b2_) + (c_ + d_); Y[(size_t)(mbase + (c0) + js) * MIX + 64 * hh + 16 * qtr + jr] = (t_[0] + t_[1]) + (t_[2] + t_[3]); } } while (0)
                SCAN_LOAD(0);
                SCAN_STORE(0);
                if (nch > 1) SCAN_LOAD(CH);
                __syncthreads();
                for (int ch = 0; ch < nch; ++ch) {
                    const int bf = ch & 1;
                    if (is_ld) {
                        if (ch + 1 < nch) SCAN_STORE(bf ^ 1);
                        if (ch + 2 < nch) SCAN_LOAD((ch + 2) * CH);
                        if (ch > 0) SCAN_YOUT(bf ^ 1, (ch - 1) * CH);
                    } else {
                        const LAS float* b_ = lbase + bf * SB_F;
                        LAS float* yp_ = lbase + bf * SB_F + 5376 + lrow * 16 + kq;
                        f32x2 Slo = __builtin_shufflevector(S, S, 0, 1), Shi = __builtin_shufflevector(S, S, 2, 3);
#define SCAN_CP(X, s2) { const f32x2 vv2 = (f32x2){vv##X, vv##X}; \
                                f32x2 dp = Slo * __builtin_shufflevector(kk4##X, kk4##X, 0, 1); dp = Shi * __builtin_shufflevector(kk4##X, kk4##X, 2, 3) + dp; \
                                const float sa = row16_sum(dp[0] + dp[1]); \
                                const f32x2 sa2 = (f32x2){sa, sa}; \
                                f32x2 tlo = Slo * __builtin_shufflevector(w4##X, w4##X, 0, 1), thi = Shi * __builtin_shufflevector(w4##X, w4##X, 2, 3); \
                                tlo = vv2 * __builtin_shufflevector(k4##X, k4##X, 0, 1) + tlo; thi = vv2 * __builtin_shufflevector(k4##X, k4##X, 2, 3) + thi; \
                                Slo = sa2 * __builtin_shufflevector(nb4##X, nb4##X, 0, 1) + tlo; Shi = sa2 * __builtin_shufflevector(nb4##X, nb4##X, 2, 3) + thi; \
                                f32x2 yp = Slo * __builtin_shufflevector(r4##X, r4##X, 0, 1); yp = Shi * __builtin_shufflevector(r4##X, r4##X, 2, 3) + yp; \
                                yv[s2] = yp[0] + yp[1]; }
#define SCAN_ALD(X, s) asm volatile("ds_read_b128 %0, %6 offset:%8\n\tds_read_b128 %1, %6 offset:%9\n\tds_read_b128 %2, %6 offset:%10\n\tds_read_b128 %3, %6 offset:%11\n\tds_read_b128 %4, %6 offset:%12\n\tds_read_b32 %5, %7 offset:%13" \
                                : "=&v"(w4##X), "=&v"(kk4##X), "=&v"(nb4##X), "=&v"(k4##X), "=&v"(r4##X), "=&v"(vv##X) : "v"(a4_), "v"(av_), "n"((s) * 256), "n"(4096 + (s) * 256), "n"(8192 + (s) * 256), "n"(12288 + (s) * 256), "n"(16384 + (s) * 256), "n"(20480 + (s) * 64)); \
                                __builtin_amdgcn_sched_barrier(0);
#define SCAN_AW(X) __builtin_amdgcn_sched_barrier(0); asm volatile("s_waitcnt lgkmcnt(0)" : "+v"(w4##X), "+v"(kk4##X), "+v"(nb4##X), "+v"(k4##X), "+v"(r4##X), "+v"(vv##X)); __builtin_amdgcn_sched_barrier(0);
#define SCAN_PAIR(s) SCAN_ALD(B, (s) + 1) SCAN_CP(A, s) SCAN_AW(B) SCAN_ALD(A, (s) + 2) SCAN_CP(B, (s) + 1) SCAN_AW(A)
                        float yv[16];
                        if (CH == 16) {
                            const unsigned a4_ = (unsigned)(unsigned long long)(b_ + 4 * kq), av_ = (unsigned)(unsigned long long)(b_ + lrow);
                            f32x4 w4A, kk4A, nb4A, k4A, r4A, w4B, kk4B, nb4B, k4B, r4B; float vvA, vvB;
                            SCAN_ALD(A, 0) SCAN_AW(A)
                            SCAN_PAIR(0) SCAN_PAIR(2) SCAN_PAIR(4) SCAN_PAIR(6) SCAN_PAIR(8) SCAN_PAIR(10) SCAN_PAIR(12)
                            SCAN_ALD(B, 15) SCAN_CP(A, 14) SCAN_AW(B) SCAN_CP(B, 15)
#pragma unroll
                            for (int s2 = 0; s2 < 16; ++s2) yp_[s2 * 256] = yv[s2];
                        } else {
#pragma unroll
                            for (int s2 = 0; s2 < 8; ++s2) {
                                const f32x4 w4Z = *(const LAS f32x4*)(b_ + s2 * 64 + 4 * kq), kk4Z = *(const LAS f32x4*)(b_ + 1024 + s2 * 64 + 4 * kq), nb4Z = *(const LAS f32x4*)(b_ + 2048 + s2 * 64 + 4 * kq),
                                            k4Z = *(const LAS f32x4*)(b_ + 3072 + s2 * 64 + 4 * kq), r4Z = *(const LAS f32x4*)(b_ + 4096 + s2 * 64 + 4 * kq); const float vvZ = b_[5120 + s2 * 16 + lrow];
                                SCAN_CP(Z, s2) }
#pragma unroll
                            for (int s2 = 0; s2 < 8; ++s2) yp_[s2 * 256] = yv[s2];
                        }
#undef SCAN_ALD
#undef SCAN_AW
#undef SCAN_CP
#undef SCAN_PAIR
                        S = (f32x4){Slo[0], Slo[1], Shi[0], Shi[1]};
                    }
                    __syncthreads();
                }
                if (is_ld) SCAN_YOUT((nch - 1) & 1, (nch - 1) * CH);
                else { float* so = seq < NSEQ_P ? out + O_WKP + ((((size_t)l * NSEQ_P + seq) * NH + hh) * HS + vg) * HS + 4 * kq
                                                : out + O_WKS + ((((size_t)l * NSEQ_S + (seq - NSEQ_P)) * NH + hh) * HS + vg) * HS + 4 * kq;
                    *(f32x4*)so = S; }
                __syncthreads();
            }
#undef SCAN_LOAD
#undef SCAN_STORE
#undef SCAN_YOUT
        }
        SEAM(ph); ++ph;
        if (IN(ph)) for (int rep_ = 0; rep_ < DUPN(4); ++rep_) { PH_IDS();
            const float* lnw = args.in[I_LNW] + (size_t)l * MIX; const float* lnb = args.in[I_LNB] + (size_t)l * MIX; const float* rk = args.in[I_RK] + (size_t)l * MIX;
            const int c = 8 * lane;
            for (int m = gw; m < M; m += NGW) {
                const f32x4 y0 = *(const f32x4*)(Y + (size_t)m * MIX + c), y1 = *(const f32x4*)(Y + (size_t)m * MIX + c + 4);
                float y[8] = {y0[0], y0[1], y0[2], y0[3], y1[0], y1[1], y1[2], y1[3]};
                float s = 0.f;
#pragma unroll
                for (int i = 0; i < 8; ++i) s += y[i];
                s += __shfl_xor(s, 1); s += __shfl_xor(s, 2); s += __shfl_xor(s, 4);
                const float mean = s * (1.0f / 64.0f); float q2 = 0.f;
#pragma unroll
                for (int i = 0; i < 8; ++i) { y[i] -= mean; q2 += y[i] * y[i]; }
                q2 += __shfl_xor(q2, 1); q2 += __shfl_xor(q2, 2); q2 += __shfl_xor(q2, 4);
                const float rstd = 1.0f / sqrtf(q2 * (1.0f / 64.0f) + 64e-5f);
                const v4u ru = *(const v4u*)(Rb + (size_t)m * MIX + c), ku = *(const v4u*)(K2b + (size_t)m * MIX + c), vu = *(const v4u*)(Vb + (size_t)m * MIX + c), gu = *(const v4u*)(Gb + (size_t)m * MIX + c);
                const float rr[8] = {bf_lo(ru.x), bf_hi(ru.x), bf_lo(ru.y), bf_hi(ru.y), bf_lo(ru.z), bf_hi(ru.z), bf_lo(ru.w), bf_hi(ru.w)};
                const float kk[8] = {bf_lo(ku.x), bf_hi(ku.x), bf_lo(ku.y), bf_hi(ku.y), bf_lo(ku.z), bf_hi(ku.z), bf_lo(ku.w), bf_hi(ku.w)};
                const float vv[8] = {bf_lo(vu.x), bf_hi(vu.x), bf_lo(vu.y), bf_hi(vu.y), bf_lo(vu.z), bf_hi(vu.z), bf_lo(vu.w), bf_hi(vu.w)};
                const float gg[8] = {bf_lo(gu.x), bf_hi(gu.x), bf_lo(gu.y), bf_hi(gu.y), bf_lo(gu.z), bf_hi(gu.z), bf_lo(gu.w), bf_hi(gu.w)};
                const f32x4 rk0 = *(const f32x4*)(rk + c), rk1 = *(const f32x4*)(rk + c + 4), w0 = *(const f32x4*)(lnw + c), w1 = *(const f32x4*)(lnw + c + 4), b0 = *(const f32x4*)(lnb + c), b1 = *(const f32x4*)(lnb + c + 4);
                float bs = 0.f;
#pragma unroll
                for (int i = 0; i < 4; ++i) bs += rr[i] * kk[i] * rk0[i] + rr[4 + i] * kk[4 + i] * rk1[i];
                bs += __shfl_xor(bs, 1); bs += __shfl_xor(bs, 2); bs += __shfl_xor(bs, 4);
                float o[8];
#pragma unroll
                for (int i = 0; i < 4; ++i) { o[i] = (y[i] * rstd * w0[i] + b0[i] + bs * vv[i]) * gg[i]; o[4 + i] = (y[4 + i] * rstd * w1[i] + b1[i] + bs * vv[4 + i]) * gg[4 + i]; }
                *(bf16x8*)(ORP + (size_t)m * D + c) = pack8(o);
            }
        }
        SEAM(ph); ++ph;
        if (IN(ph)) for (int rep_ = 0; rep_ < DUPN(5); ++rep_) {
            pg8::Gemm g{ORP, WBR_T, MP, D, D}; pg8::StaticOrder S; S.init(MP, D, G, (int)blockIdx.x);
            EpiMerge E{8, P, H};
            pg8::gemm_phase<EpiMerge, pg8::StaticOrder, true, true>(lds, g, S, E);
            SAMPLE_TILES(ORP, WBR_T, D, D, E, (MP / 256) * (D / 256));
        }
        SEAM(ph); ++ph;
        if (IN(ph)) for (int rep_ = 0; rep_ < DUPN(6); ++rep_) {
            pg8::Gemm g{H, WOUT_T, MP, D, D}; pg8::StaticOrder S; S.init(MP, D, G, (int)blockIdx.x);
            EpiRes E{0, X, modmix + 2048};
            pg8::gemm_phase<EpiRes, pg8::StaticOrder, true, true>(lds, g, S, E);
            SAMPLE_TILES(H, WOUT_T, D, D, E, (MP / 256) * (D / 256));
        }
        SEAM(ph); ++ph;
        if (IN(ph)) for (int rep_ = 0; rep_ < DUPN(7); ++rep_) { PH_IDS();
            const float* nw = args.in[I_NORMMLP] + (size_t)l * D;
            for (int m = gw; m < M; m += NGW) {
                const float* xr = X + (size_t)m * D; const float* mo = modmlp + (size_t)row_seq(m) * MODW;
                f32x4 v[4]; float s = 0.f;
#pragma unroll
                for (int j = 0; j < 4; ++j) { v[j] = *(const f32x4*)(xr + 4 * lane + 256 * j); s += (v[j][0] * v[j][0] + v[j][1] * v[j][1]) + (v[j][2] * v[j][2] + v[j][3] * v[j][3]); }
                const float rstd = 1.0f / sqrtf(wave_sum(s) * (1.0f / D) + 1e-6f);
#pragma unroll
                for (int j = 0; j < 4; ++j) { const int c = 4 * lane + 256 * j; const f32x4 g = *(const f32x4*)(nw + c), sh = *(const f32x4*)(mo + c), sc = *(const f32x4*)(mo + 1024 + c);
                    f32x4 o;
#pragma unroll
                    for (int i = 0; i < 4; ++i) o[i] = v[j][i] * rstd * g[i] * (1.0f + sc[i]) + sh[i];
                    *(v2u*)(H + (size_t)m * D + c) = pack4(o[0], o[1], o[2], o[3]); }
            }
        }
        SEAM(ph); ++ph;
        if (IN(ph)) for (int rep_ = 0; rep_ < DUPN(8); ++rep_) {
            pg8::Gemm g{H, WFF1_T, MP, DFF, D}; pg8::StaticOrder S; S.init(MP, DFF, G, (int)blockIdx.x);
            EpiStoreBf16 E{0, P, DFF, 1};
            pg8::gemm_phase<EpiStoreBf16, pg8::StaticOrder, true, true>(lds, g, S, E);
            SAMPLE_TILES(H, WFF1_T, DFF, D, E, (MP / 256) * (DFF / 256));
        }
        SEAM(ph); ++ph;
        if (IN(ph)) for (int rep_ = 0; rep_ < DUPN(9); ++rep_) {
            pg8::Gemm g{P, WFF2_T, MP, D, DFF}; pg8::StaticOrder S; S.init(MP, D, G, (int)blockIdx.x);
            EpiRes E{0, X, modmlp + 2048};
            pg8::gemm_phase<EpiRes, pg8::StaticOrder, true, true>(lds, g, S, E);
            SAMPLE_TILES(P, WFF2_T, D, DFF, E, (MP / 256) * (D / 256));
        }
        SEAM(ph); ++ph;
    }
    if (IN(ph)) for (int rep_ = 0; rep_ < DUPN(12); ++rep_) { PH_IDS();
        const float* nw = args.in[I_NORMF];
        for (int m = gw; m < M; m += NGW) {
            float* xr = X + (size_t)m * D;
            f32x4 v[4]; float s = 0.f;
#pragma unroll
            for (int j = 0; j < 4; ++j) { v[j] = *(const f32x4*)(xr + 4 * lane + 256 * j); s += (v[j][0] * v[j][0] + v[j][1] * v[j][1]) + (v[j][2] * v[j][2] + v[j][3] * v[j][3]); }
            const float rstd = 1.0f / sqrtf(wave_sum(s) * (1.0f / D) + 1e-6f);
#pragma unroll
            for (int j = 0; j < 4; ++j) { const int c = 4 * lane + 256 * j; const f32x4 g = *(const f32x4*)(nw + c); *(f32x4*)(xr + c) = v[j] * rstd * g; }
        }
    }
#undef IN
#undef SEAM
}

constexpr int N_PHASES = 2 + DEPTH * 10 + 1;

extern "C" void kernel_launch(void* const* d_in, const int* in_sizes, int n_in, void* d_out, int out_size, void* d_ws, size_t ws_size, hipStream_t stream) {
    static int grid = 0;
    if (grid == 0) {
        if (n_in != N_IN || (size_t)out_size != O_END || ws_size < WS_END) { fprintf(stderr, "kernel_launch: shape mismatch n_in %d out %d ws %zu\n", n_in, out_size, ws_size); grid = -1; return; }
        int dev = 0, cus = 0, per_cu = 0;
        if (hipGetDevice(&dev) != hipSuccess || hipDeviceGetAttribute(&cus, hipDeviceAttributeMultiprocessorCount, dev) != hipSuccess) { grid = -1; return; }
        if (hipFuncSetAttribute((const void*)mk_fwd, hipFuncAttributeMaxDynamicSharedMemorySize, LDS_BYTES) != hipSuccess) { fprintf(stderr, "kernel_launch: hipFuncSetAttribute failed\n"); grid = -1; return; }
        if (hipOccupancyMaxActiveBlocksPerMultiprocessor(&per_cu, (const void*)mk_fwd, NTHR, LDS_BYTES) != hipSuccess || per_cu < 1) { fprintf(stderr, "kernel_launch: occupancy query says %d\n", per_cu); per_cu = 1; }
        (void)hipGetLastError();
        grid = cus * (per_cu < 1 ? per_cu : 1);
    }
    if (grid < 0) return;
    (void)hipMemsetAsync((char*)d_ws + WS_CTL, 0, CTL_ZERO_BYTES, stream);
    Args a{};
    for (int i = 0; i < N_IN; ++i) a.in[i] = (const float*)d_in[i];
    a.out = (float*)d_out; a.ws = (unsigned char*)d_ws;
#if MK_ONE_LAUNCH
    a.ph_lo = 0; a.ph_hi = N_PHASES;
    void* kargs[] = {(void*)&a};
    hipError_t e = hipLaunchCooperativeKernel((const void*)mk_fwd, dim3(grid), dim3(NTHR), kargs, LDS_BYTES, stream);
    if (e != hipSuccess) fprintf(stderr, "kernel_launch: cooperative launch failed: %s (grid %d)\n", hipGetErrorString(e), grid);
#else
    for (int p = 0; p < N_PHASES; ++p) { a.ph_lo = p; a.ph_hi = p + 1; hipLaunchKernelGGL(mk_fwd, dim3(grid), dim3(NTHR), LDS_BYTES, stream, a); }
#endif
}
```

```cpp
#include <hip/hip_runtime.h>
#include <cstdio>
#include <cstdint>

#ifndef PROBE_DUP
#define PROBE_DUP -1
#endif
#define DUPN(k) ((args.dup == (k)) ? 2 : 1)
#ifndef MK_ONE_LAUNCH
#define MK_ONE_LAUNCH 1
#endif

#define GAS __attribute__((address_space(1)))
#define LAS __attribute__((address_space(3)))
typedef unsigned short bf16;
typedef unsigned v4u __attribute__((ext_vector_type(4)));
typedef unsigned v2u __attribute__((ext_vector_type(2)));
typedef float f32x4 __attribute__((ext_vector_type(4)));
typedef float f32x2 __attribute__((ext_vector_type(2)));
typedef short bf16x8 __attribute__((ext_vector_type(8)));

constexpr int D = 1024, DEPTH = 4, NSEQ_P = 8, T_P = 2048, NSEQ_S = 128, T_S = 8;
constexpr int MP = NSEQ_P * T_P, MS = NSEQ_S * T_S, M = MP + MS;
constexpr int NSEQ = NSEQ_P + NSEQ_S;
constexpr int MIX = 512, HS = 64, NH = 8, POOLW = 512, PGRP = 128, PBUF = 15, DFF = 4096;
constexpr int RWKV_COLS = 1792, IN_COLS = 4352;
constexpr int C_R = 0, C_K = 512, C_V = 1024, C_XW = 1536, C_XA = 1600, C_XG = 1664, C_PP = 1792, C_GR = 2304, C_GP = 3328;
constexpr int MODW = 8 * 3072;
constexpr int NWAVES = 8, NTHR = 512;

enum { I_XP = 0, I_XS, I_SSHIFT, I_SPOOL, I_SWKV, I_CP, I_CS, I_WADAMIX, I_BADAMIX, I_NORMMIX, I_WIN, I_MU, I_W0, I_W2, I_A0, I_A2, I_G2,
       I_V0, I_V1, I_V2, I_KK, I_KA, I_RK, I_LNW, I_LNB, I_POOLW, I_POOLS, I_WBRR, I_WBRP, I_WOUT, I_WADAMLP, I_BADAMLP, I_NORMMLP, I_WFF1, I_WFF2, I_NORMF, N_IN };
constexpr size_t O_Y = 0, O_SHP = (size_t)M * D, O_POP = O_SHP + 4 * 8 * 1792, O_WKP = O_POP + 4 * 8 * 15 * 512, O_SHS = O_WKP + 4 * 8 * 8 * 4096,
                 O_POS = O_SHS + 4 * 128 * 1792, O_WKS = O_POS + (size_t)4 * 128 * 15 * 512, O_END = O_WKS + (size_t)4 * 128 * 8 * 4096;

constexpr size_t MiB = 1u << 20;
constexpr size_t WS_CTL = 0, CTL_ZERO_BYTES = 1 * MiB;
constexpr size_t WS_MOD = 1 * MiB;
constexpr size_t WS_SC = 14 * MiB;
constexpr size_t WS_SH0 = 14 * MiB + 512 * 1024;
constexpr size_t WS_PH0 = 448 * MiB;
constexpr size_t WS_WIN = 16 * MiB;
constexpr size_t WS_WBR = 25 * MiB;
constexpr size_t WS_WOUT = 27 * MiB;
constexpr size_t WS_WFF1 = 29 * MiB;
constexpr size_t WS_WFF2 = 37 * MiB;
constexpr size_t WS_WSM = 45 * MiB;
constexpr size_t SM_LORA = 0, SM_POOL = 786432, SM_V12 = 1310720;
constexpr size_t WS_H = 48 * MiB;
constexpr size_t WS_P = 82 * MiB;
constexpr size_t WS_R = 227 * MiB, WS_K2 = 244 * MiB, WS_V = 261 * MiB, WS_KK = 278 * MiB, WS_B = 295 * MiB;
constexpr size_t WS_W = 312 * MiB;
constexpr size_t WS_ORP = 346 * MiB;
constexpr size_t WS_G = 380 * MiB;
constexpr size_t WS_VF = 397 * MiB;
constexpr size_t WS_Y = 414 * MiB;
constexpr size_t WS_POOLED = 414 * MiB, WS_XA = 431 * MiB;
constexpr size_t WS_END = 451 * MiB;

constexpr int CW_BAR = 4096;

constexpr int RING_BYTES = 131072, LDSCTL_OFF = RING_BYTES, MISC_OFF = LDSCTL_OFF + 320, LDS_BYTES = 147456;

typedef __bf16 bf16x2_t __attribute__((ext_vector_type(2)));
__device__ __forceinline__ unsigned cvt_pk_bf16(float lo, float hi) { f32x2 v = {lo, hi}; bf16x2_t b = __builtin_convertvector(v, bf16x2_t); return __builtin_bit_cast(unsigned, b); }
__device__ __forceinline__ float bf_lo(unsigned u) { return __builtin_bit_cast(float, u << 16); }
__device__ __forceinline__ float bf_hi(unsigned u) { return __builtin_bit_cast(float, u & 0xffff0000u); }
__device__ __forceinline__ float sigmoidf_(float x) { return 1.0f / (1.0f + __expf(-x)); }
__device__ __forceinline__ float tanhf_(float x) { return 1.0f - 2.0f / (1.0f + __expf(2.0f * x)); }
template <int CTRL> __device__ __forceinline__ float dpp_f(float x) { return __builtin_bit_cast(float, __builtin_amdgcn_update_dpp(0, __builtin_bit_cast(int, x), CTRL, 0xF, 0xF, true)); }
__device__ __forceinline__ float row16_sum(float x) { x += dpp_f<0xB1>(x); x += dpp_f<0x4E>(x); x += dpp_f<0x141>(x); x += dpp_f<0x140>(x); return x; }
__device__ __forceinline__ float row8_sum(float x) { x += dpp_f<0xB1>(x); x += dpp_f<0x4E>(x); x += dpp_f<0x141>(x); return x; }
__device__ __forceinline__ float wave_sum(float v) {
    v = row16_sum(v);
    const float a = __builtin_bit_cast(float, __builtin_amdgcn_readlane(__builtin_bit_cast(int, v), 0)), b = __builtin_bit_cast(float, __builtin_amdgcn_readlane(__builtin_bit_cast(int, v), 16)),
                c = __builtin_bit_cast(float, __builtin_amdgcn_readlane(__builtin_bit_cast(int, v), 32)), d = __builtin_bit_cast(float, __builtin_amdgcn_readlane(__builtin_bit_cast(int, v), 48));
    return (a + b) + (c + d);
}
__device__ __forceinline__ int lane_fresh() { int t; asm volatile("v_mbcnt_lo_u32_b32 %0, -1, 0\n\tv_mbcnt_hi_u32_b32 %0, -1, %0" : "=v"(t)); return t; }
__device__ __forceinline__ int launder_tid(int wave_u) { return wave_u * 64 + lane_fresh(); }
__device__ __forceinline__ int lane_id_() { return lane_fresh(); }
#define LDS_WAIT() asm volatile("s_waitcnt lgkmcnt(0)" ::: "memory")
#define VM_WAIT() asm volatile("s_waitcnt vmcnt(0)" ::: "memory")

namespace pg8 {
#define PG8_LAS __attribute__((address_space(3)))
typedef unsigned short bf16_t;
constexpr int BM = 256, BK = 64, HALF = 128, HTB = HALF * BK * 2, STAGE_BYTES = 8 * HTB, NXCD = 8, WGM = 8;

__host__ __device__ __forceinline__ int lds_byte(int r, int c) { const int st = (r >> 4) * 2 + (c >> 5), rr = r & 15, cc = c & 31, ob = rr * 64 + cc * 2; return st * 1024 + (ob ^ (((ob >> 9) & 1) << 5)); }
__host__ __device__ __forceinline__ void stage_rc(int b, int& R, int& C) { const int st = b / 1024, sb = b % 1024, swz = sb ^ (((sb >> 9) & 1) << 5); R = (st >> 1) * 16 + swz / 64; C = (st & 1) * 32 + (swz % 64) / 2; }
__host__ __device__ __forceinline__ int perm32(int rho) { const int n = rho >> 4, i = rho & 15; return 8 * (i >> 2) + 4 * n + (i & 3); }

struct Unit { int pm, pn; };
struct Gemm { const bf16_t* A; const bf16_t* Bt; int M, N, K; };

struct StaticOrder {
    int nM, nN, nwg, G, c;
    __host__ __device__ void init(int M_, int N_, int G_, int c_) { nM = M_ / BM; nN = N_ / BM; nwg = nM * nN; G = G_; c = c_; }
    __host__ __device__ bool next(int i, Unit& u) const {
        const long L = (long)i * G + c; if (L >= nwg) return false;
        int wgid = (int)L; { const int q = nwg / NXCD, r = nwg % NXCD, xcd = wgid % NXCD, off = wgid / NXCD; wgid = (xcd < r ? xcd * (q + 1) : r * (q + 1) + (xcd - r) * q) + off; }
        const int nig = WGM * nN, gid = wgid / nig, fm = gid * WGM, gsz = (nM - fm) < WGM ? (nM - fm) : WGM;
        u.pm = fm + ((wgid % nig) % gsz); u.pn = (wgid % nig) / gsz; return true;
    }
};

template <class Epi, class Sched, bool ALIGN_EPI = false, bool SP2 = false>
__device__ __forceinline__ void gemm_phase(PG8_LAS unsigned char* lds, const Gemm g, const Sched& S, const Epi& E, const int wave_u) {
    const int tid = launder_tid(wave_u), wid = __builtin_amdgcn_readfirstlane(tid >> 6), lane = tid & 63, wr = wid >> 2, wc = wid & 3, fr = lane & 15, fq = lane >> 4;
    const int K = g.K, nt = K / BK;
    unsigned voffA, voffB;
    { int R, C; stage_rc(tid * 16, R, C); const int Rb = (R & ~31) + perm32(R & 31); voffA = (unsigned)(R * K + C) * 2u; voffB = (unsigned)(Rb * K + C) * 2u; }
    const size_t r64step = (size_t)64 * K * 2;
    const size_t kstep = (size_t)(BK * 2);
    const size_t hstep = (size_t)HALF * K * 2;
    const size_t tstep = 2 * hstep;
    const unsigned ldsw = (unsigned)wid * 1024u;
    const int aoff = lds_byte(wr * 64 + fr, fq * 8), boff = lds_byte(wc * 32 + fr, fq * 8);
#define PG8_SA(b, h) (((b) * 2 + (h)) * HTB)
#define PG8_SB(b, h) ((4 + (b) * 2 + (h)) * HTB)
#define PG8_STAGE(bufoff, gbase, voff) do { _Pragma("unroll") for (int _i = 0; _i < 2; ++_i) \
        __builtin_amdgcn_global_load_lds((const unsigned*)((const char*)(gbase) + _i * r64step + (voff)), (PG8_LAS unsigned*)(lds + (bufoff) + ldsw + _i * 8192), 16, 0, 0); } while (0)
#define PG8_LDA(dst, b, h) do { _Pragma("unroll") for (int m = 0; m < 4; ++m) _Pragma("unroll") for (int k = 0; k < 2; ++k) dst[m][k] = *(const PG8_LAS bf16x8*)(lds + PG8_SA(b, h) + aoff + m * 2048 + k * 1024); } while (0)
#define PG8_LDB(dst, b, h) do { _Pragma("unroll") for (int n = 0; n < 2; ++n) _Pragma("unroll") for (int k = 0; k < 2; ++k) dst[n][k] = *(const PG8_LAS bf16x8*)(lds + PG8_SB(b, h) + boff + n * 2048 + k * 1024); } while (0)
#define PG8_MMA(ai, bj, At, Bt) do { __builtin_amdgcn_s_setprio(1); _Pragma("unroll") for (int m = 0; m < 4; ++m) _Pragma("unroll") for (int n = 0; n < 2; ++n) _Pragma("unroll") for (int k = 0; k < 2; ++k) \
        acc[ai][bj][m][n] = __builtin_amdgcn_mfma_f32_16x16x32_bf16(Bt[n][k], At[m][k], acc[ai][bj][m][n], 0, 0, 0); __builtin_amdgcn_s_setprio(0); } while (0)
#define PG8_WAIT_V(n) asm volatile("s_waitcnt vmcnt(" #n ")" ::: "memory")
#define PG8_WAIT_L(n) asm volatile("s_waitcnt lgkmcnt(" #n ")" ::: "memory")
#define PG8_BAR __builtin_amdgcn_s_barrier()
#define PG8_SCHED __builtin_amdgcn_sched_barrier(0)
    Unit cur, nxt; int ui = 0;
    if (!S.next(0, cur)) return;
    f32x4 acc[2][2][4][2];
#pragma unroll
    for (int a = 0; a < 2; ++a)
#pragma unroll
        for (int b = 0; b < 2; ++b)
#pragma unroll
            for (int m = 0; m < 4; ++m)
#pragma unroll
                for (int n = 0; n < 2; ++n) acc[a][b][m][n] = (f32x4){0.f, 0.f, 0.f, 0.f};
    bf16x8 At[4][2], B0[2][2], B1[2][2];
    const char* cA = (const char*)g.A + (size_t)cur.pm * tstep; const char* cB = (const char*)g.Bt + (size_t)cur.pn * tstep;
    if constexpr (SP2) {
        PG8_STAGE(PG8_SB(0, 0), cB, voffB); PG8_STAGE(PG8_SB(0, 1), cB + hstep, voffB); PG8_STAGE(PG8_SA(0, 0), cA, voffA); PG8_STAGE(PG8_SA(0, 1), cA + hstep, voffA);
        if (wr == 1) PG8_BAR;
        PG8_WAIT_V(2); PG8_BAR;
        PG8_STAGE(PG8_SB(1, 0), cB + kstep, voffB); PG8_STAGE(PG8_SA(1, 0), cA + kstep, voffA); PG8_STAGE(PG8_SB(1, 1), cB + hstep + kstep, voffB);
        PG8_WAIT_V(6); PG8_BAR;
    } else {
        PG8_STAGE(PG8_SB(0, 0), cB, voffB); PG8_STAGE(PG8_SA(0, 0), cA, voffA); PG8_STAGE(PG8_SB(0, 1), cB + hstep, voffB); PG8_STAGE(PG8_SA(0, 1), cA + hstep, voffA);
        if (wr == 1) PG8_BAR;
        PG8_WAIT_V(4); PG8_BAR;
        PG8_STAGE(PG8_SB(1, 0), cB + kstep, voffB); PG8_STAGE(PG8_SA(1, 0), cA + kstep, voffA); PG8_STAGE(PG8_SB(1, 1), cB + hstep + kstep, voffB);
        PG8_WAIT_V(6); PG8_BAR;
    }
    for (;;) {
        const bool has_next = S.next(ui + 1, nxt);
        const char* nA = has_next ? (const char*)g.A + (size_t)nxt.pm * tstep : cA; const char* nB = has_next ? (const char*)g.Bt + (size_t)nxt.pn * tstep : cB;
        for (int t = 0; t < nt; t += 2) {
            const bool last = (t == nt - 2);
            const char* a1 = cA + (size_t)(t + 1) * kstep;
            const char* a2 = last ? nA : cA + (size_t)(t + 2) * kstep; const char* b2 = last ? nB : cB + (size_t)(t + 2) * kstep;
            const char* a3 = a2 + kstep; const char* b3 = b2 + kstep;
            if constexpr (Epi::HOOK) { if (t == E.hook_t) E.hook(acc, cur, wr, wc, fr, fq); }
            if constexpr (SP2) {
            PG8_LDB(B0, 0, 0); PG8_LDB(B1, 0, 1); PG8_SCHED; PG8_LDA(At, 0, 0); PG8_STAGE(PG8_SA(1, 1), a1 + hstep, voffA);
            PG8_WAIT_V(8); PG8_WAIT_L(0); PG8_BAR; PG8_MMA(0, 0, At, B0); PG8_MMA(0, 1, At, B1); PG8_BAR; PG8_SCHED;
            PG8_LDA(At, 0, 1); PG8_STAGE(PG8_SB(0, 0), b2, voffB); PG8_STAGE(PG8_SB(0, 1), b2 + hstep, voffB); PG8_STAGE(PG8_SA(0, 0), a2, voffA);
            PG8_WAIT_V(8); PG8_WAIT_L(0); PG8_BAR; PG8_MMA(1, 0, At, B0); PG8_MMA(1, 1, At, B1); PG8_BAR; PG8_SCHED;
            PG8_LDB(B0, 1, 0); PG8_LDB(B1, 1, 1); PG8_SCHED; PG8_LDA(At, 1, 0); PG8_STAGE(PG8_SA(0, 1), a2 + hstep, voffA);
            PG8_WAIT_V(8); PG8_WAIT_L(0); PG8_BAR; PG8_MMA(0, 0, At, B0); PG8_MMA(0, 1, At, B1); PG8_BAR; PG8_SCHED;
            PG8_LDA(At, 1, 1); PG8_STAGE(PG8_SB(1, 0), b3, voffB); PG8_STAGE(PG8_SB(1, 1), b3 + hstep, voffB); PG8_STAGE(PG8_SA(1, 0), a3, voffA);
            PG8_WAIT_V(8); PG8_WAIT_L(0); PG8_BAR; PG8_MMA(1, 0, At, B0); PG8_MMA(1, 1, At, B1); PG8_BAR; PG8_SCHED;
            } else {
            PG8_LDB(B0, 0, 0); PG8_SCHED; PG8_LDA(At, 0, 0); PG8_STAGE(PG8_SA(1, 1), a1 + hstep, voffA);
            PG8_WAIT_L(8); PG8_BAR; PG8_WAIT_L(0); PG8_MMA(0, 0, At, B0); PG8_BAR; PG8_SCHED;
            PG8_LDB(B1, 0, 1); PG8_STAGE(PG8_SB(0, 0), b2, voffB);
            PG8_BAR; PG8_WAIT_L(0); PG8_MMA(0, 1, At, B1); PG8_BAR;
            PG8_LDA(At, 0, 1); PG8_STAGE(PG8_SA(0, 0), a2, voffA);
            PG8_BAR; PG8_WAIT_L(0); PG8_MMA(1, 0, At, B0); PG8_BAR; PG8_SCHED;
            PG8_STAGE(PG8_SB(0, 1), b2 + hstep, voffB);
            PG8_WAIT_V(6); PG8_BAR; PG8_MMA(1, 1, At, B1); PG8_BAR;
            PG8_LDB(B0, 1, 0); PG8_SCHED; PG8_LDA(At, 1, 0); PG8_STAGE(PG8_SA(0, 1), a2 + hstep, voffA);
            PG8_WAIT_L(8); PG8_BAR; PG8_WAIT_L(0); PG8_MMA(0, 0, At, B0); PG8_BAR; PG8_SCHED;
            PG8_LDB(B1, 1, 1); PG8_STAGE(PG8_SB(1, 0), b3, voffB);
            PG8_BAR; PG8_WAIT_L(0); PG8_MMA(0, 1, At, B1); PG8_BAR;
            PG8_LDA(At, 1, 1); PG8_STAGE(PG8_SA(1, 0), a3, voffA);
            PG8_BAR; PG8_WAIT_L(0); PG8_MMA(1, 0, At, B0); PG8_BAR; PG8_SCHED;
            PG8_STAGE(PG8_SB(1, 1), b3 + hstep, voffB);
            PG8_WAIT_V(6); PG8_BAR; PG8_MMA(1, 1, At, B1); PG8_BAR;
            }
        }
        if constexpr (ALIGN_EPI) { if (wr == 0) PG8_BAR; }
        E(acc, cur, wr, wc, fr, fq);
        if (!has_next) break;
#pragma unroll
        for (int a = 0; a < 2; ++a)
#pragma unroll
            for (int b = 0; b < 2; ++b)
#pragma unroll
                for (int m = 0; m < 4; ++m)
#pragma unroll
                    for (int n = 0; n < 2; ++n) acc[a][b][m][n] = (f32x4){0.f, 0.f, 0.f, 0.f};
        cur = nxt; cA = nA; cB = nB; ++ui;
        if constexpr (ALIGN_EPI) { if (wr == 1) PG8_BAR; }
    }
    PG8_WAIT_V(0);
    if constexpr (!ALIGN_EPI) { if (wr == 0) PG8_BAR; }
    PG8_BAR;
#undef PG8_SA
#undef PG8_SB
#undef PG8_STAGE
#undef PG8_LDA
#undef PG8_LDB
#undef PG8_MMA
#undef PG8_WAIT_V
#undef PG8_WAIT_L
#undef PG8_BAR
#undef PG8_SCHED
}
}

__device__ __forceinline__ int row_seq(int m) { return m < MP ? (m >> 11) : NSEQ_P + ((m - MP) >> 3); }
__device__ __forceinline__ int row_t(int m) { return m < MP ? (m & (T_P - 1)) : ((m - MP) & (T_S - 1)); }

struct EpiBase { static constexpr bool HOOK = false; int hook_t; };

struct EpiStoreBf16 {
    static constexpr bool HOOK = false; int hook_t;
    bf16* O; int ldc; int act;
    __device__ __forceinline__ void hook_apply(int, int, f32x4&, f32x4&) const {}
    __device__ __forceinline__ void apply(int row, int col, f32x4 v0, f32x4 v1) const {
        if (act == 1) {
#pragma unroll
            for (int j = 0; j < 4; ++j) { float a = fmaxf(v0[j], 0.f), b = fmaxf(v1[j], 0.f); v0[j] = a * a; v1[j] = b * b; } }
        v4u w; w.x = cvt_pk_bf16(v0[0], v0[1]); w.y = cvt_pk_bf16(v0[2], v0[3]); w.z = cvt_pk_bf16(v1[0], v1[1]); w.w = cvt_pk_bf16(v1[2], v1[3]);
        *(v4u*)(O + (size_t)row * ldc + col) = w;
    }
    __device__ __forceinline__ void hook(f32x4 (&)[2][2][4][2], const pg8::Unit&, int, int, int, int) const {}
    __device__ __forceinline__ void operator()(const f32x4 (&acc)[2][2][4][2], const pg8::Unit& u, int wr, int wc, int fr, int fq) const {
        { const int ln__ = lane_fresh(); fr = ln__ & 15; fq = ln__ >> 4; }
        const int row0 = u.pm * 256 + wr * 64 + fr, col0 = u.pn * 256 + wc * 32 + 8 * fq;
#pragma unroll
        for (int ai = 0; ai < 2; ++ai)
#pragma unroll
            for (int m = 0; m < 4; ++m) { bf16* rowp = O + (size_t)(row0 + ai * 128 + m * 16) * ldc + col0;
#pragma unroll
                for (int bj = 0; bj < 2; ++bj) { f32x4 v0 = acc[ai][bj][m][0], v1 = acc[ai][bj][m][1];
                    if (act == 1) {
#pragma unroll
                        for (int j = 0; j < 4; ++j) { float a = fmaxf(v0[j], 0.f), b = fmaxf(v1[j], 0.f); v0[j] = a * a; v1[j] = b * b; } }
                    v4u w; w.x = cvt_pk_bf16(v0[0], v0[1]); w.y = cvt_pk_bf16(v0[2], v0[3]); w.z = cvt_pk_bf16(v1[0], v1[1]); w.w = cvt_pk_bf16(v1[2], v1[3]);
                    *(v4u*)(rowp + bj * 128) = w; } }
    }
};

struct EpiMod {
    static constexpr bool HOOK = false; int hook_t;
    float* O; const float* bmix; const float* bmlp;
    __device__ __forceinline__ void hook(f32x4 (&)[2][2][4][2], const pg8::Unit&, int, int, int, int) const {}
    __device__ __forceinline__ void operator()(const f32x4 (&acc)[2][2][4][2], const pg8::Unit& u, int wr, int wc, int fr, int fq) const {
        { const int ln__ = lane_fresh(); fr = ln__ & 15; fq = ln__ >> 4; }
        const int row0 = u.pm * 256 + wr * 64 + fr, col0 = u.pn * 256 + wc * 32 + 8 * fq;
        const int mat = (u.pn * 256) / 3072, l = mat >> 1, which = mat & 1;
        const float* bias = (which ? bmlp : bmix) + l * 3072 - mat * 3072;
#pragma unroll
        for (int ai = 0; ai < 2; ++ai)
#pragma unroll
            for (int m = 0; m < 4; ++m) { const int row = row0 + ai * 128 + m * 16; if (row >= NSEQ) continue;
#pragma unroll
                for (int bj = 0; bj < 2; ++bj) { const int col = col0 + bj * 128;
                    const f32x4 b0 = *(const f32x4*)(bias + col), b1 = *(const f32x4*)(bias + col + 4);
                    *(f32x4*)(O + (size_t)row * MODW + col) = acc[ai][bj][m][0] + b0; *(f32x4*)(O + (size_t)row * MODW + col + 4) = acc[ai][bj][m][1] + b1; } }
    }
};

struct EpiRes {
    static constexpr bool HOOK = false; int hook_t;
    float* X; const float* gate;
    __device__ __forceinline__ void hook_apply(int, int, f32x4&, f32x4&) const {}
    __device__ __forceinline__ void apply(int row, int col, f32x4 v0, f32x4 v1) const {
        const float* gr = gate + (size_t)row_seq(row) * MODW + col; float* xr = X + (size_t)row * D + col;
        const f32x4 g0 = *(const f32x4*)gr, g1 = *(const f32x4*)(gr + 4);
        f32x4 x0 = *(const f32x4*)xr, x1 = *(const f32x4*)(xr + 4);
        x0 += g0 * v0; x1 += g1 * v1;
        *(f32x4*)xr = x0; *(f32x4*)(xr + 4) = x1;
    }
    __device__ __forceinline__ void hook(f32x4 (&)[2][2][4][2], const pg8::Unit&, int, int, int, int) const {}
    __device__ __forceinline__ void operator()(const f32x4 (&acc)[2][2][4][2], const pg8::Unit& u, int wr, int wc, int fr, int fq) const {
        { const int ln__ = lane_fresh(); fr = ln__ & 15; fq = ln__ >> 4; }
        const int row0 = u.pm * 256 + wr * 64 + fr, col0 = u.pn * 256 + wc * 32 + 8 * fq;
#pragma unroll
        for (int ai = 0; ai < 2; ++ai)
#pragma unroll
            for (int m = 0; m < 4; ++m) { const int row = row0 + ai * 128 + m * 16; const float* gr = gate + (size_t)row_seq(row) * MODW; float* xr = X + (size_t)row * D;
#pragma unroll
                for (int bj = 0; bj < 2; ++bj) { const int col = col0 + bj * 128;
                    const f32x4 g0 = *(const f32x4*)(gr + col), g1 = *(const f32x4*)(gr + col + 4);
                    f32x4 x0 = *(const f32x4*)(xr + col), x1 = *(const f32x4*)(xr + col + 4);
                    x0 += g0 * acc[ai][bj][m][0]; x1 += g1 * acc[ai][bj][m][1];
                    *(f32x4*)(xr + col) = x0; *(f32x4*)(xr + col + 4) = x1; } }
    }
};

struct EpiMerge {
    static constexpr bool HOOK = true; int hook_t;
    const bf16* P; bf16* O;
    __device__ __forceinline__ void hook_apply(int row, int col, f32x4& v0, f32x4& v1) const {
        const bf16* pr = P + (size_t)row * IN_COLS + col; const v4u a = *(const v4u*)(pr + C_GR), b = *(const v4u*)(pr + C_GP);
        const float ga[8] = {bf_lo(a.x), bf_hi(a.x), bf_lo(a.y), bf_hi(a.y), bf_lo(a.z), bf_hi(a.z), bf_lo(a.w), bf_hi(a.w)};
        const float gb[8] = {bf_lo(b.x), bf_hi(b.x), bf_lo(b.y), bf_hi(b.y), bf_lo(b.z), bf_hi(b.z), bf_lo(b.w), bf_hi(b.w)};
#pragma unroll
        for (int j = 0; j < 4; ++j) { v0[j] *= (1.0f + __expf(-gb[j])) / (1.0f + __expf(-ga[j])); v1[j] *= (1.0f + __expf(-gb[4 + j])) / (1.0f + __expf(-ga[4 + j])); }
    }
    __device__ __forceinline__ void apply(int row, int col, f32x4 v0, f32x4 v1) const {
        const v4u b = *(const v4u*)(P + (size_t)row * IN_COLS + C_GP + col);
        const float gb[8] = {bf_lo(b.x), bf_hi(b.x), bf_lo(b.y), bf_hi(b.y), bf_lo(b.z), bf_hi(b.z), bf_lo(b.w), bf_hi(b.w)};
#pragma unroll
        for (int j = 0; j < 4; ++j) { v0[j] *= sigmoidf_(gb[j]); v1[j] *= sigmoidf_(gb[4 + j]); }
        v4u w; w.x = cvt_pk_bf16(v0[0], v0[1]); w.y = cvt_pk_bf16(v0[2], v0[3]); w.z = cvt_pk_bf16(v1[0], v1[1]); w.w = cvt_pk_bf16(v1[2], v1[3]);
        *(v4u*)(O + (size_t)row * D + col) = w;
    }
    __device__ __forceinline__ void hook(f32x4 (&acc)[2][2][4][2], const pg8::Unit& u, int wr, int wc, int fr, int fq) const {
        { const int ln__ = lane_fresh(); fr = ln__ & 15; fq = ln__ >> 4; }
        const int row0 = u.pm * 256 + wr * 64 + fr, col0 = u.pn * 256 + wc * 32 + 8 * fq;
#pragma unroll
        for (int ai = 0; ai < 2; ++ai)
#pragma unroll
            for (int m = 0; m < 4; ++m) { const bf16* pr = P + (size_t)(row0 + ai * 128 + m * 16) * IN_COLS + col0;
#pragma unroll
                for (int bj = 0; bj < 2; ++bj) { const v4u a = *(const v4u*)(pr + C_GR + bj * 128), b = *(const v4u*)(pr + C_GP + bj * 128);
                    float ga[8] = {bf_lo(a.x), bf_hi(a.x), bf_lo(a.y), bf_hi(a.y), bf_lo(a.z), bf_hi(a.z), bf_lo(a.w), bf_hi(a.w)};
                    float gb[8] = {bf_lo(b.x), bf_hi(b.x), bf_lo(b.y), bf_hi(b.y), bf_lo(b.z), bf_hi(b.z), bf_lo(b.w), bf_hi(b.w)};
#pragma unroll
                    for (int j = 0; j < 4; ++j) { acc[ai][bj][m][0][j] *= (1.0f + __expf(-gb[j])) / (1.0f + __expf(-ga[j]));
                                                  acc[ai][bj][m][1][j] *= (1.0f + __expf(-gb[4 + j])) / (1.0f + __expf(-ga[4 + j])); } } }
    }
    __device__ __forceinline__ void operator()(const f32x4 (&acc)[2][2][4][2], const pg8::Unit& u, int wr, int wc, int fr, int fq) const {
        { const int ln__ = lane_fresh(); fr = ln__ & 15; fq = ln__ >> 4; }
        const int row0 = u.pm * 256 + wr * 64 + fr, col0 = u.pn * 256 + wc * 32 + 8 * fq;
#pragma unroll
        for (int ai = 0; ai < 2; ++ai)
#pragma unroll
            for (int m = 0; m < 4; ++m) { const size_t row = (size_t)(row0 + ai * 128 + m * 16); const bf16* pr = P + row * IN_COLS + col0;
#pragma unroll
                for (int bj = 0; bj < 2; ++bj) { const v4u b = *(const v4u*)(pr + C_GP + bj * 128);
                    float gb[8] = {bf_lo(b.x), bf_hi(b.x), bf_lo(b.y), bf_hi(b.y), bf_lo(b.z), bf_hi(b.z), bf_lo(b.w), bf_hi(b.w)};
                    f32x4 v0 = acc[ai][bj][m][0], v1 = acc[ai][bj][m][1];
#pragma unroll
                    for (int j = 0; j < 4; ++j) { v0[j] *= sigmoidf_(gb[j]); v1[j] *= sigmoidf_(gb[4 + j]); }
                    v4u w; w.x = cvt_pk_bf16(v0[0], v0[1]); w.y = cvt_pk_bf16(v0[2], v0[3]); w.z = cvt_pk_bf16(v1[0], v1[1]); w.w = cvt_pk_bf16(v1[2], v1[3]);
                    *(v4u*)(O + row * D + col0 + bj * 128) = w; } }
    }
};

#define EPI_BIG_OPERATOR() \
    __device__ __forceinline__ void hook(f32x4 (&)[2][2][4][2], const pg8::Unit&, int, int, int, int) const {} \
    __device__ __forceinline__ void operator()(const f32x4 (&acc)[2][2][4][2], const pg8::Unit& u, int wr, int wc, int fr, int fq) const { \
        { const int ln__ = lane_fresh(); fr = ln__ & 15; fq = ln__ >> 4; } \
        const int row0 = u.pm * 256 + wr * 64 + fr, col0 = u.pn * 256 + wc * 32 + 8 * fq; \
        _Pragma("unroll") for (int ai = 0; ai < 2; ++ai) _Pragma("unroll") for (int m = 0; m < 4; ++m) _Pragma("unroll") for (int bj = 0; bj < 2; ++bj) \
            apply(row0 + ai * 128 + m * 16, col0 + bj * 128, acc[ai][bj][m][0], acc[ai][bj][m][1]); }

__device__ __forceinline__ void unpack8(const v4u u, float (&f)[8]) { f[0] = bf_lo(u.x); f[1] = bf_hi(u.x); f[2] = bf_lo(u.y); f[3] = bf_hi(u.y); f[4] = bf_lo(u.z); f[5] = bf_hi(u.z); f[6] = bf_lo(u.w); f[7] = bf_hi(u.w); }
__device__ __forceinline__ v4u pack8u(const float (&f)[8]) { v4u u; u.x = cvt_pk_bf16(f[0], f[1]); u.y = cvt_pk_bf16(f[2], f[3]); u.z = cvt_pk_bf16(f[4], f[5]); u.w = cvt_pk_bf16(f[6], f[7]); return u; }

struct EpiLora {
    static constexpr bool HOOK = false; int hook_t;
    float* Wd; const bf16* KX; bf16* K2; const bf16* KK; bf16* Bb; bf16* Gb; const float* w0; const float* a0; const float* ka;
    __device__ __forceinline__ void apply(int row, int col, f32x4 v0, f32x4 v1) const {
        const int ty = col >> 9, c = col & 511; const size_t o = (size_t)row * MIX + c;
        const float acc[8] = {v0[0], v0[1], v0[2], v0[3], v1[0], v1[1], v1[2], v1[3]};
        if (ty == 0) { const f32x4 b0 = *(const f32x4*)(w0 + c), b1 = *(const f32x4*)(w0 + c + 4); f32x4 o0, o1;
#pragma unroll
            for (int j = 0; j < 4; ++j) { o0[j] = __expf(-0.6065306597126334f * sigmoidf_(b0[j] + acc[j])); o1[j] = __expf(-0.6065306597126334f * sigmoidf_(b1[j] + acc[4 + j])); }
            *(f32x4*)(Wd + o) = o0; *(f32x4*)(Wd + o + 4) = o1;
        } else if (ty == 1) { const f32x4 b0 = *(const f32x4*)(a0 + c), b1 = *(const f32x4*)(a0 + c + 4), k0 = *(const f32x4*)(ka + c), k1 = *(const f32x4*)(ka + c + 4);
            float k[8], kk[8], k2[8], bb[8]; unpack8(*(const v4u*)(KX + o), k); unpack8(*(const v4u*)(KK + o), kk);
#pragma unroll
            for (int j = 0; j < 8; ++j) { const float a = sigmoidf_((j < 4 ? b0[j & 3] : b1[j & 3]) + acc[j]); k2[j] = k[j] * (1.0f + (a - 1.0f) * (j < 4 ? k0[j & 3] : k1[j & 3])); bb[j] = kk[j] * a; }
            *(v4u*)(K2 + o) = pack8u(k2); *(v4u*)(Bb + o) = pack8u(bb);
        } else { *(v4u*)(Gb + o) = pack8u(acc); }
    }
    EPI_BIG_OPERATOR()
};
struct EpiPool {
    static constexpr bool HOOK = false; int hook_t;
    bf16* ORP; const float* scale;
    __device__ __forceinline__ void apply(int row, int col, f32x4 v0, f32x4 v1) const {
        const f32x4 s0 = *(const f32x4*)(scale + col), s1 = *(const f32x4*)(scale + col + 4); v0 *= s0; v1 *= s1;
        v4u w; w.x = cvt_pk_bf16(v0[0], v0[1]); w.y = cvt_pk_bf16(v0[2], v0[3]); w.z = cvt_pk_bf16(v1[0], v1[1]); w.w = cvt_pk_bf16(v1[2], v1[3]);
        *(v4u*)(ORP + (size_t)row * D + MIX + col) = w;
    }
    EPI_BIG_OPERATOR()
};
struct EpiVmix {
    static constexpr bool HOOK = false; int hook_t;
    const bf16* VX; bf16* V; const bf16* VF; const float* v0p;
    __device__ __forceinline__ void apply(int row, int col, f32x4 a0_, f32x4 a1_) const {
        const size_t o = (size_t)row * MIX + col; const f32x4 b0 = *(const f32x4*)(v0p + col), b1 = *(const f32x4*)(v0p + col + 4);
        const float acc[8] = {a0_[0], a0_[1], a0_[2], a0_[3], a1_[0], a1_[1], a1_[2], a1_[3]};
        float v[8], vf[8], r[8]; unpack8(*(const v4u*)(VX + o), v); unpack8(*(const v4u*)(VF + o), vf);
#pragma unroll
        for (int j = 0; j < 8; ++j) r[j] = v[j] + (vf[j] - v[j]) * sigmoidf_((j < 4 ? b0[j & 3] : b1[j & 3]) + acc[j]);
        *(v4u*)(V + o) = pack8u(r);
    }
    EPI_BIG_OPERATOR()
};

#define MFMA16(a, b, c) __builtin_amdgcn_mfma_f32_16x16x32_bf16((a), (b), (c), 0, 0, 0)
template <class Epi>
__device__ __forceinline__ void sgemm_tiles(LAS unsigned char* lds, const bf16* A, const bf16* Bt, int N, int K, const Epi& E, int t0, int tstep, int tend, const int wave_u) {
    const int tid = launder_tid(wave_u), wid = __builtin_amdgcn_readfirstlane(tid >> 6), lane = tid & 63, fr = lane & 15, fq = lane >> 4, wm = wid & 3, wn = wid >> 2;
    int R, C; pg8::stage_rc(tid * 16, R, C);
    const int Rb = (R & ~31) + pg8::perm32(R & 31);
    const unsigned ldsw = (unsigned)wid * 1024u;
    const int aoff = pg8::lds_byte(wm * 16 + fr, fq * 8), boff = 8192 + pg8::lds_byte(wn * 32 + fr, fq * 8);
    const int nk = K / 64;
#define SG_STAGE(slot, kt) do { __builtin_amdgcn_global_load_lds((const unsigned*)(ag + (size_t)(kt) * 64), (LAS unsigned*)(lds + (slot) * 16384 + ldsw), 16, 0, 0); \
                                __builtin_amdgcn_global_load_lds((const unsigned*)(bg + (size_t)(kt) * 64), (LAS unsigned*)(lds + (slot) * 16384 + 8192 + ldsw), 16, 0, 0); } while (0)
    for (int t = t0; t < tend; t += tstep) {
        const int rt = t & 15, ct = t >> 4, r0 = MP + 64 * rt, c0 = 64 * ct;
        const bf16* ag = A + (size_t)(r0 + R) * K + C; const bf16* bg = Bt + (size_t)(c0 + Rb) * K + C;
        f32x4 acc0 = (f32x4){0.f, 0.f, 0.f, 0.f}, acc1 = acc0;
        SG_STAGE(0, 0); SG_STAGE(1, 1); SG_STAGE(2, 2);
        for (int kt = 0; kt < nk; ++kt) {
            if (kt + 2 < nk) asm volatile("s_waitcnt vmcnt(4)" ::: "memory"); else if (kt + 1 < nk) asm volatile("s_waitcnt vmcnt(2)" ::: "memory"); else asm volatile("s_waitcnt vmcnt(0)" ::: "memory");
            __builtin_amdgcn_s_barrier();
            if (kt + 3 < nk) SG_STAGE((kt + 3) & 3, kt + 3);
            if constexpr (Epi::HOOK) { if (kt == E.hook_t) E.hook_apply(r0 + wm * 16 + fr, c0 + wn * 32 + 8 * fq, acc0, acc1); }
            const LAS unsigned char* sl = lds + (kt & 3) * 16384;
            const bf16x8 a0 = *(const LAS bf16x8*)(sl + aoff), a1 = *(const LAS bf16x8*)(sl + aoff + 1024);
            const bf16x8 b00 = *(const LAS bf16x8*)(sl + boff), b01 = *(const LAS bf16x8*)(sl + boff + 1024), b10 = *(const LAS bf16x8*)(sl + boff + 2048), b11 = *(const LAS bf16x8*)(sl + boff + 3072);
            acc0 = MFMA16(b00, a0, acc0); acc1 = MFMA16(b10, a0, acc1);
            acc0 = MFMA16(b01, a1, acc0); acc1 = MFMA16(b11, a1, acc1);
        }
        E.apply(r0 + wm * 16 + fr, c0 + wn * 32 + 8 * fq, acc0, acc1);
        __builtin_amdgcn_s_barrier();
    }
#undef SG_STAGE
}

#define XB_TMO      128
#define XB_XCNT(j)  (256  + 64 * (j))
#define XB_XSUB(j)  (1280 + 64 * (j))
#define XB_XGEN(j)  (2304 + 64 * (j))
#define XB_TOP      3328
#define XB_TOPGEN   3392
#define XCD_BAR_WORDS 3456
#define XB_SPIN_CAP (1u << 22)

__device__ __forceinline__ unsigned xb_ld(unsigned* p)              { return __hip_atomic_load(p, __ATOMIC_RELAXED, __HIP_MEMORY_SCOPE_AGENT); }
__device__ __forceinline__ unsigned xb_add(unsigned* p, unsigned v) { return __hip_atomic_fetch_add(p, v, __ATOMIC_RELAXED, __HIP_MEMORY_SCOPE_AGENT); }
__device__ __forceinline__ unsigned xb_xcc_id() { return (unsigned)__builtin_amdgcn_s_getreg((3 << 11) | 20) & 0xFu; }
#define XB_SPIN(cond, bar) do { unsigned _sp = 0; while (cond) { __builtin_amdgcn_s_sleep(1); \
    if ((++_sp & 255u) == 0u) { if (xb_ld(&(bar)[XB_TMO])) break; if (_sp > XB_SPIN_CAP) { atomicAdd(&(bar)[XB_TMO], 1u); break; } } } } while (0)

struct XcdBarrier { unsigned* bar; unsigned x; volatile LAS unsigned* st; };

__device__ __forceinline__ XcdBarrier xcd_barrier_post(unsigned* bar, volatile LAS unsigned* st, const int wave_u) {
    XcdBarrier b; b.bar = bar; b.x = xb_xcc_id(); b.st = st;
    if (wave_u == 0 && lane_id_() == 0) (void)xb_add(&bar[XB_XCNT(b.x)], 1u);
    return b;
}
__device__ __forceinline__ void xcd_barrier_complete(unsigned* bar, unsigned x, unsigned& nloc, unsigned& nx) {
    const unsigned G = gridDim.x * gridDim.y * gridDim.z;
    unsigned sum, cnt, mine, sp = 0u;
    for (;;) {
        sum = 0u; cnt = 0u; mine = 0u;
#pragma unroll
        for (unsigned j = 0; j < 16; ++j) { const unsigned c = xb_ld(&bar[XB_XCNT(j)]); sum += c; cnt += (c > 0u) ? 1u : 0u; mine = (j == x) ? c : mine; }
        if (sum == G) break;
        __builtin_amdgcn_s_sleep(1);
        if ((++sp & 255u) == 0u) { if (xb_ld(&bar[XB_TMO])) break; if (sp > XB_SPIN_CAP) { atomicAdd(&bar[XB_TMO], 1u); break; } }
    }
    nloc = mine > 0u ? mine : 1u; nx = cnt > 0u ? cnt : 1u;
}
__device__ __forceinline__ void xcd_barrier(const XcdBarrier& b, const int wave_u) {
    asm volatile("s_waitcnt vmcnt(0)" ::: "memory");
    __syncthreads();
    if (wave_u == 0 && lane_id_() == 0) {
        unsigned* bar = b.bar;
        __builtin_amdgcn_s_waitcnt(0);
        unsigned nloc = b.st[0], nx = b.st[1];
        if (nloc == 0u) { xcd_barrier_complete(bar, b.x, nloc, nx); b.st[0] = nloc; b.st[1] = nx; }
        const unsigned old = xb_add(&bar[XB_XSUB(b.x)], 1u);
        const unsigned gen = old / nloc;
        if (old + 1u == (gen + 1u) * nloc) {
            __builtin_amdgcn_fence(__ATOMIC_RELEASE, "agent");
            asm volatile("s_waitcnt vmcnt(0)" ::: "memory");
            const unsigned og = xb_add(&bar[XB_TOP], 1u);
            const unsigned tg = og / nx;
            if (og + 1u == (tg + 1u) * nx) xb_add(&bar[XB_TOPGEN], 1u);
            else XB_SPIN(xb_ld(&bar[XB_TOPGEN]) == tg, bar);
            __builtin_amdgcn_fence(__ATOMIC_ACQUIRE, "agent");
            xb_add(&bar[XB_XGEN(b.x)], 1u);
            asm volatile("s_waitcnt vmcnt(0)" ::: "memory");
        } else {
            XB_SPIN(xb_ld(&bar[XB_XGEN(b.x)]) == gen, bar);
            __builtin_amdgcn_fence(__ATOMIC_ACQUIRE, "agent");
            asm volatile("s_waitcnt vmcnt(0)" ::: "memory");
        }
    }
    __syncthreads();
}

struct Args { const float* in[N_IN]; float* out; unsigned char* ws; int ph_lo, ph_hi, dup, pad; };

__device__ __forceinline__ void transpose_item(const float* W, int N, bf16* WT, int ldt, int item, LAS float* scr, int lane) {
    const int nblk = N / 32, kb = item / nblk, nb = item % nblk, k0 = 64 * kb, n0 = 32 * nb;
#pragma unroll 8
    for (int i = 0; i < 32; ++i) { const int kk = 2 * i + (lane >> 5); scr[kk * 33 + (lane & 31)] = W[(size_t)(k0 + kk) * N + n0 + (lane & 31)]; }
    LDS_WAIT(); asm volatile("" ::: "memory");
    const int c = lane & 7;
#pragma unroll
    for (int j = 0; j < 4; ++j) { const int n = (lane >> 3) + 8 * j; const LAS float* s = scr + (8 * c) * 33 + n;
        v4u o; o.x = cvt_pk_bf16(s[0 * 33], s[1 * 33]); o.y = cvt_pk_bf16(s[2 * 33], s[3 * 33]); o.z = cvt_pk_bf16(s[4 * 33], s[5 * 33]); o.w = cvt_pk_bf16(s[6 * 33], s[7 * 33]);
        *(v4u*)(WT + (size_t)(n0 + n) * ldt + k0 + 8 * c) = o; }
    LDS_WAIT(); asm volatile("" ::: "memory");
}

__device__ __forceinline__ void load_xl8(const bf16* prow, const bf16* pprev, const float* mu, float (&o)[8]) {
    const v4u cu = *(const v4u*)prow, pu = *(const v4u*)pprev;
    const f32x4 m0 = *(const f32x4*)mu, m1 = *(const f32x4*)(mu + 4);
    const float cur[8] = {bf_lo(cu.x), bf_hi(cu.x), bf_lo(cu.y), bf_hi(cu.y), bf_lo(cu.z), bf_hi(cu.z), bf_lo(cu.w), bf_hi(cu.w)};
    const float pv[8] = {bf_lo(pu.x), bf_hi(pu.x), bf_lo(pu.y), bf_hi(pu.y), bf_lo(pu.z), bf_hi(pu.z), bf_lo(pu.w), bf_hi(pu.w)};
#pragma unroll
    for (int i = 0; i < 4; ++i) { o[i] = cur[i] + (pv[i] - cur[i]) * m0[i]; o[4 + i] = cur[4 + i] + (pv[4 + i] - cur[4 + i]) * m1[i]; }
}
__device__ __forceinline__ void load_xl4(const bf16* prow, const bf16* pprev, const float* mu, float (&o)[4]) {
    const v2u cu = *(const v2u*)prow, pu = *(const v2u*)pprev; const f32x4 m0 = *(const f32x4*)mu;
    const float cur[4] = {bf_lo(cu.x), bf_hi(cu.x), bf_lo(cu.y), bf_hi(cu.y)}, pv[4] = {bf_lo(pu.x), bf_hi(pu.x), bf_lo(pu.y), bf_hi(pu.y)};
#pragma unroll
    for (int i = 0; i < 4; ++i) o[i] = cur[i] + (pv[i] - cur[i]) * m0[i];
}
__device__ __forceinline__ bf16x8 pack8(const float (&f)[8]) {
    v4u u; u.x = cvt_pk_bf16(f[0], f[1]); u.y = cvt_pk_bf16(f[2], f[3]); u.z = cvt_pk_bf16(f[4], f[5]); u.w = cvt_pk_bf16(f[6], f[7]);
    return __builtin_bit_cast(bf16x8, u);
}
__device__ __forceinline__ v2u pack4(float a, float b, float c, float d) { v2u u; u.x = cvt_pk_bf16(a, b); u.y = cvt_pk_bf16(c, d); return u; }

__device__ __forceinline__ const float* arg_in(const Args& a, int i) { asm volatile("" : "+s"(i)); return a.in[i]; }
__global__ void __launch_bounds__(NTHR, 2) mk_fwd(Args args) {
    extern __shared__ __attribute__((aligned(16))) unsigned char lds_raw[];
    LAS unsigned char* lds = (LAS unsigned char*)lds_raw;
    const int G = gridDim.x, NGW = G * NWAVES;
#define PH_IDS() const int tid = launder_tid(wave_u), lane = tid & 63, wave = __builtin_amdgcn_readfirstlane(tid >> 6), gw = blockIdx.x * NWAVES + wave; LAS float* scr = (LAS float*)(lds + wave * 16384); (void)lane; (void)gw; (void)scr
    unsigned* ctl = (unsigned*)(args.ws + WS_CTL);
    volatile LAS unsigned* MISC = (volatile LAS unsigned*)(lds + MISC_OFF);
    const int wave_u = __builtin_amdgcn_readfirstlane((int)threadIdx.x >> 6);
    for (int u = wave_u * 64 + lane_id_(); u < (LDS_BYTES - LDSCTL_OFF) / 4; u += NTHR) ((LAS unsigned*)(lds + LDSCTL_OFF))[u] = 0u;
    __syncthreads();
    const int lo = args.ph_lo, hi = args.ph_hi;
    XcdBarrier bar; bar.bar = ctl + CW_BAR; bar.x = 0; bar.st = nullptr;
    if (hi - lo > 1) bar = xcd_barrier_post(ctl + CW_BAR, MISC + 8, wave_u);
#define IN(k) (lo <= (k) && (k) < hi)
#define SEAM(k) do { if (IN(k) && IN((k) + 1)) xcd_barrier(bar, wave_u); } while (0)
#define SAMPLE_TILES(Abuf, Btp, N_, K_, E_, nbig) do { const int nt_ = 16 * ((N_) / 64), rem_ = (nbig) % G; int first_ = 0, cnt_ = G; if (rem_ > 0 && rem_ <= G / 2) { first_ = rem_; cnt_ = G - rem_; } \
        if ((int)blockIdx.x >= first_) sgemm_tiles(lds, Abuf, Btp, N_, K_, E_, (int)blockIdx.x - first_, cnt_, nt_, wave_u); } while (0)

#define PH_PTRS() unsigned char* ws = args.ws; float* out = args.out; int l = L_; asm volatile("" : "+s"(ws), "+s"(out), "+s"(l)); (void)l; \
    float* X = out + O_Y; \
    float* MOD = (float*)(ws + WS_MOD); \
    bf16* SC = (bf16*)(ws + WS_SC); \
    bf16* H = (bf16*)(ws + WS_H); \
    bf16* P = (bf16*)(ws + WS_P); \
    bf16* Rb = (bf16*)(ws + WS_R); bf16* K2b = (bf16*)(ws + WS_K2); bf16* Vb = (bf16*)(ws + WS_V); bf16* KKb = (bf16*)(ws + WS_KK); bf16* Bb = (bf16*)(ws + WS_B); \
    float* Wd = (float*)(ws + WS_W); \
    bf16* ORP = (bf16*)(ws + WS_ORP); bf16* Gb = (bf16*)(ws + WS_G); bf16* VF = (bf16*)(ws + WS_VF); \
    float* Y = (float*)(ws + WS_Y); \
    bf16* WIN_T = (bf16*)(ws + WS_WIN); bf16* WBR_T = (bf16*)(ws + WS_WBR); bf16* WOUT_T = (bf16*)(ws + WS_WOUT); bf16* WFF1_T = (bf16*)(ws + WS_WFF1); bf16* WFF2_T = (bf16*)(ws + WS_WFF2); \
    bf16* WLORA_T = (bf16*)(ws + WS_WSM + SM_LORA); bf16* WPOOL_T = (bf16*)(ws + WS_WSM + SM_POOL); bf16* V12_T = (bf16*)(ws + WS_WSM + SM_V12); \
    bf16* POOLED = (bf16*)(ws + WS_POOLED); bf16* XA = (bf16*)(ws + WS_XA); \
    bf16* ADA_T = P; \
    (void)X; (void)MOD; (void)SC; (void)H; (void)P; (void)Rb; (void)K2b; (void)Vb; (void)KKb; (void)Bb; (void)Wd; (void)ORP; (void)Gb; (void)VF; (void)Y; (void)WIN_T; (void)WBR_T; (void)WOUT_T; (void)WFF1_T; (void)WFF2_T; (void)WLORA_T; (void)WPOOL_T; (void)V12_T; (void)POOLED; (void)XA; (void)ADA_T
#define ARG(i) arg_in(args, (i))
    int ph = 0, L_ = 0;
    if (IN(ph)) for (int rep_ = 0; rep_ < DUPN(10); ++rep_) { PH_PTRS(); PH_IDS();
        constexpr int I_ADA = (D / 64) * (3072 / 32);
        for (int it = gw; it < 8 * I_ADA; it += NGW) { const int mat = it / I_ADA, r = it % I_ADA, l = mat >> 1, which = mat & 1;
            const float* W = (which ? ARG(I_WADAMLP) : ARG(I_WADAMIX)) + (size_t)l * D * 3072;
            transpose_item(W, 3072, ADA_T + (size_t)mat * 3072 * D, D, r, scr, lane); }
        for (int r = gw; r < 256; r += NGW) {
            const float* c = r < NSEQ_P ? ARG(I_CP) + (size_t)r * D : ARG(I_CS) + (size_t)(r - NSEQ_P) * D;
#pragma unroll
            for (int j = 0; j < 4; ++j) { f32x4 v = (f32x4){0.f, 0.f, 0.f, 0.f}; if (r < NSEQ) v = *(const f32x4*)(c + 4 * lane + 256 * j);
#pragma unroll
                for (int i = 0; i < 4; ++i) v[i] = v[i] * sigmoidf_(v[i]);
                *(v2u*)(SC + (size_t)r * D + 4 * lane + 256 * j) = pack4(v[0], v[1], v[2], v[3]); } }
        for (int m = gw; m < M; m += NGW) {
            const float* src = m < MP ? ARG(I_XP) + (size_t)m * D : ARG(I_XS) + (size_t)(m - MP) * D;
#pragma unroll
            for (int j = 0; j < 4; ++j) *(f32x4*)(X + (size_t)m * D + 4 * lane + 256 * j) = *(const f32x4*)(src + 4 * lane + 256 * j); }
    }
    SEAM(ph); ++ph;
    if (IN(ph)) for (int rep_ = 0; rep_ < DUPN(11); ++rep_) { PH_PTRS();
        pg8::Gemm g{SC, ADA_T, 256, MODW, D}; pg8::StaticOrder S; S.init(256, MODW, G, (int)blockIdx.x);
        EpiMod E{0, MOD, ARG(I_BADAMIX), ARG(I_BADAMLP)};
        pg8::gemm_phase<EpiMod, pg8::StaticOrder, true, true>(lds, g, S, E, wave_u);
    }
    SEAM(ph); ++ph;

    for (L_ = 0; L_ < DEPTH; ++L_) {
#define modmix (MOD + (size_t)(2 * l) * 3072)
#define modmlp (MOD + (size_t)(2 * l + 1) * 3072)
        if (IN(ph)) for (int rep_ = 0; rep_ < DUPN(0); ++rep_) { PH_PTRS(); PH_IDS();
            constexpr int N_IN_ = (D / 64) * (IN_COLS / 32), N_BR = (MIX / 64) * (D / 32), N_OUT = (D / 64) * (D / 32), N_F1 = (D / 64) * (DFF / 32), N_F2 = (DFF / 64) * (D / 32);
            constexpr int TOT = N_IN_ + 2 * N_BR + N_OUT + N_F1 + N_F2;
            for (int it = gw; it < TOT; it += NGW) { int r = it;
                if (r < N_IN_) { transpose_item(ARG(I_WIN) + (size_t)l * D * IN_COLS, IN_COLS, WIN_T, D, r, scr, lane); continue; } r -= N_IN_;
                if (r < N_BR) { transpose_item(ARG(I_WBRR) + (size_t)l * MIX * D, D, WBR_T, D, r, scr, lane); continue; } r -= N_BR;
                if (r < N_BR) { transpose_item(ARG(I_WBRP) + (size_t)l * POOLW * D, D, WBR_T + MIX, D, r, scr, lane); continue; } r -= N_BR;
                if (r < N_OUT) { transpose_item(ARG(I_WOUT) + (size_t)l * D * D, D, WOUT_T, D, r, scr, lane); continue; } r -= N_OUT;
                if (r < N_F1) { transpose_item(ARG(I_WFF1) + (size_t)l * D * DFF, DFF, WFF1_T, D, r, scr, lane); continue; } r -= N_F1;
                transpose_item(ARG(I_WFF2) + (size_t)l * DFF * D, D, WFF2_T, DFF, r, scr, lane);
            }
            {
                const float* w2 = ARG(I_W2) + (size_t)l * 64 * MIX; const float* a2 = ARG(I_A2) + (size_t)l * 64 * MIX; const float* g2 = ARG(I_G2) + (size_t)l * 128 * MIX;
                const float* pw = ARG(I_POOLW) + (size_t)l * 4 * PGRP * PGRP;
                const int gt = blockIdx.x * NTHR + tid, GT = G * NTHR;
                for (int e = gt; e < 1536 * 256; e += GT) { const int n = e >> 8, k = e & 255, ty = n >> 9, nn = n & 511; float v = 0.f;
                    if (ty == 0) { if (k < 64) v = w2[(size_t)k * MIX + nn]; } else if (ty == 1) { if (k >= 64 && k < 128) v = a2[(size_t)(k - 64) * MIX + nn]; } else { if (k >= 128) v = g2[(size_t)(k - 128) * MIX + nn]; }
                    WLORA_T[e] = (bf16)(cvt_pk_bf16(v, 0.f) & 0xffffu); }
                for (int e = gt; e < 512 * 512; e += GT) { const int d = e >> 9, k = e & 511, g = d >> 7; float v = 0.f;
                    if ((k >> 7) == g) v = pw[((size_t)g * PGRP + (k & 127)) * PGRP + (d & 127)];
                    WPOOL_T[e] = (bf16)(cvt_pk_bf16(v, 0.f) & 0xffffu); }
                if (l > 0) { const float* v1 = ARG(I_V1) + (size_t)(l - 1) * MIX * 32; const float* v2 = ARG(I_V2) + (size_t)(l - 1) * 32 * MIX;
                    for (int e = gt; e < 512 * 512; e += GT) { const int n = e >> 9, k = e & 511; float acc = 0.f;
#pragma unroll 8
                        for (int j = 0; j < 32; ++j) acc += v1[(size_t)k * 32 + j] * v2[(size_t)j * MIX + n];
                        V12_T[e] = (bf16)(cvt_pk_bf16(acc, 0.f) & 0xffffu); } }
            }
            {
                bf16* SH0 = (bf16*)(ws + WS_SH0); bf16* PH0 = (bf16*)(ws + WS_PH0);
                const float* ss = ARG(I_SSHIFT) + (size_t)l * NSEQ_S * RWKV_COLS; const float* sp = ARG(I_SPOOL) + (size_t)l * NSEQ_S * PBUF * POOLW;
                for (int e = blockIdx.x * NTHR + tid; e < NSEQ * RWKV_COLS / 2; e += G * NTHR) { const int e2 = 2 * e - NSEQ_P * RWKV_COLS;
                    *(unsigned*)(SH0 + 2 * e) = e2 >= 0 ? cvt_pk_bf16(ss[e2], ss[e2 + 1]) : 0u; }
                for (int e = blockIdx.x * NTHR + tid; e < NSEQ * PBUF * POOLW / 2; e += G * NTHR) { const int e2 = 2 * e - NSEQ_P * PBUF * POOLW;
                    *(unsigned*)(PH0 + 2 * e) = e2 >= 0 ? cvt_pk_bf16(sp[e2], sp[e2 + 1]) : 0u; }
            }
            const float* nw = ARG(I_NORMMIX) + (size_t)l * D;
            for (int m = gw; m < M; m += NGW) {
                const float* xr = X + (size_t)m * D; const float* mo = modmix + (size_t)row_seq(m) * MODW;
                f32x4 v[4]; float s = 0.f;
#pragma unroll
                for (int j = 0; j < 4; ++j) { v[j] = *(const f32x4*)(xr + 4 * lane + 256 * j); s += (v[j][0] * v[j][0] + v[j][1] * v[j][1]) + (v[j][2] * v[j][2] + v[j][3] * v[j][3]); }
                const float rstd = 1.0f / sqrtf(wave_sum(s) * (1.0f / D) + 1e-6f);
#pragma unroll
                for (int j = 0; j < 4; ++j) { const int c = 4 * lane + 256 * j; const f32x4 g = *(const f32x4*)(nw + c), sh = *(const f32x4*)(mo + c), sc = *(const f32x4*)(mo + 1024 + c);
                    f32x4 o;
#pragma unroll
                    for (int i = 0; i < 4; ++i) o[i] = v[j][i] * rstd * g[i] * (1.0f + sc[i]) + sh[i];
                    *(v2u*)(H + (size_t)m * D + c) = pack4(o[0], o[1], o[2], o[3]); }
            }
        }
        SEAM(ph); ++ph;
        if (IN(ph)) for (int rep_ = 0; rep_ < DUPN(1); ++rep_) { PH_PTRS();
            pg8::Gemm g{H, WIN_T, MP, IN_COLS, D}; pg8::StaticOrder S; S.init(MP, IN_COLS, G, (int)blockIdx.x);
            EpiStoreBf16 E{0, P, IN_COLS, 0};
            pg8::gemm_phase<EpiStoreBf16, pg8::StaticOrder, true, true>(lds, g, S, E, wave_u);
            SAMPLE_TILES(H, WIN_T, IN_COLS, D, E, (MP / 256) * (IN_COLS / 256));
        }
        SEAM(ph); ++ph;
        if (IN(ph)) for (int rep_ = 0; rep_ < DUPN(2); ++rep_) { PH_PTRS(); PH_IDS();
            const float* spool = ARG(I_SPOOL) + (size_t)l * NSEQ_S * PBUF * POOLW; const float* mu = ARG(I_MU) + (size_t)l * RWKV_COLS; const float* kkw = ARG(I_KK) + (size_t)l * MIX;
            const bf16* SH0 = (const bf16*)(ws + WS_SH0); const bf16* PH0 = (const bf16*)(ws + WS_PH0);
            for (int idx = blockIdx.x * NTHR + tid; idx < NSEQ * (RWKV_COLS / 4 + PBUF * POOLW / 4); idx += G * NTHR) {
                if (idx < NSEQ * (RWKV_COLS / 4)) {
                    const int seq = idx / (RWKV_COLS / 4), c = 4 * (idx % (RWKV_COLS / 4));
                    const int mlast = seq < NSEQ_P ? seq * T_P + T_P - 1 : MP + (seq - NSEQ_P) * T_S + T_S - 1;
                    const v2u u = *(const v2u*)(P + (size_t)mlast * IN_COLS + c);
                    float* so = seq < NSEQ_P ? out + O_SHP + ((size_t)l * NSEQ_P + seq) * RWKV_COLS + c : out + O_SHS + ((size_t)l * NSEQ_S + (seq - NSEQ_P)) * RWKV_COLS + c;
                    *(f32x4*)so = (f32x4){bf_lo(u.x), bf_hi(u.x), bf_lo(u.y), bf_hi(u.y)};
                } else {
                    const int r = idx - NSEQ * (RWKV_COLS / 4), seq = r / (PBUF * POOLW / 4), rem = r % (PBUF * POOLW / 4), i = rem / (POOLW / 4), c = 4 * (rem % (POOLW / 4));
                    f32x4 v;
                    if (seq >= NSEQ_P && i < 7) v = *(const f32x4*)(spool + ((size_t)(seq - NSEQ_P) * PBUF + 8 + i) * POOLW + c);
                    else { const int row = seq < NSEQ_P ? seq * T_P + T_P - 15 + i : MP + (seq - NSEQ_P) * T_S + i - 7;
                        const v2u u = *(const v2u*)(P + (size_t)row * IN_COLS + C_PP + c); v = (f32x4){bf_lo(u.x), bf_hi(u.x), bf_lo(u.y), bf_hi(u.y)}; }
                    float* po = seq < NSEQ_P ? out + O_POP + (((size_t)l * NSEQ_P + seq) * PBUF + i) * POOLW + c : out + O_POS + (((size_t)l * NSEQ_S + (seq - NSEQ_P)) * PBUF + i) * POOLW + c;
                    *(f32x4*)po = v;
                }
            }
            for (int m = gw; m < M; m += NGW) {
                const int seq = row_seq(m), t = row_t(m);
                const bf16* prow = P + (size_t)m * IN_COLS; const bf16* pprev = t > 0 ? prow - IN_COLS : SH0 + (size_t)seq * RWKV_COLS;
                const int c8 = 8 * lane; const size_t o = (size_t)m * MIX + c8;
                float xr[8], xk[8], xv[8];
                load_xl8(prow + C_R + c8, pprev + C_R + c8, mu + C_R + c8, xr);
                load_xl8(prow + C_K + c8, pprev + C_K + c8, mu + C_K + c8, xk);
                load_xl8(prow + C_V + c8, pprev + C_V + c8, mu + C_V + c8, xv);
                *(v4u*)(Rb + o) = pack8u(xr); *(v4u*)(H + (size_t)M * MIX + o) = pack8u(xk);
                { const v4u pv = pack8u(xv); if (l == 0) { *(v4u*)(Vb + o) = pv; *(v4u*)(VF + o) = pv; } else *(v4u*)(H + o) = pv; }
                { const f32x4 w0_ = *(const f32x4*)(kkw + c8), w1_ = *(const f32x4*)(kkw + c8 + 4); float kk[8]; float ss = 0.f;
#pragma unroll
                  for (int j = 0; j < 8; ++j) { kk[j] = xk[j] * (j < 4 ? w0_[j & 3] : w1_[j & 3]); ss += kk[j] * kk[j]; }
                  ss = row8_sum(ss);
                  const float rn = 1.0f / sqrtf(ss + 1e-12f);
#pragma unroll
                  for (int j = 0; j < 8; ++j) kk[j] *= rn;
                  *(v4u*)(KKb + o) = pack8u(kk); }
                if (lane < 32) { float xx[8]; load_xl8(prow + C_XW + c8, pprev + C_XW + c8, mu + C_XW + c8, xx);
#pragma unroll
                    for (int j = 0; j < 8; ++j) xx[j] = lane < 8 ? tanhf_(xx[j]) : (lane < 16 ? xx[j] : sigmoidf_(xx[j]));
                    *(v4u*)(XA + (size_t)m * 256 + c8) = pack8u(xx); }
                { const int win = 2 << (lane >> 4); float sum[8], cur[8];
                  unpack8(*(const v4u*)(prow + C_PP + c8), cur);
#pragma unroll
                  for (int j = 0; j < 8; ++j) sum[j] = cur[j];
#pragma unroll 5
                  for (int i = 1; i < 16; ++i) { if (i < win) { const int tt = t - i;
                      const bf16* src = tt >= 0 ? prow - (size_t)i * IN_COLS + C_PP + c8 : PH0 + ((size_t)seq * PBUF + (PBUF + tt)) * POOLW + c8;
                      float x[8]; unpack8(*(const v4u*)src, x);
#pragma unroll
                      for (int j = 0; j < 8; ++j) sum[j] += x[j]; } }
                  const float inv = 1.0f / (float)((seq < NSEQ_P && t + 1 < win) ? t + 1 : win);
#pragma unroll
                  for (int j = 0; j < 8; ++j) sum[j] = sum[j] * inv - cur[j];
                  *(v4u*)(POOLED + o) = pack8u(sum); }
            }
        }
        SEAM(ph); ++ph;
        if (IN(ph)) for (int rep_ = 0; rep_ < DUPN(13); ++rep_) { PH_PTRS();
            { pg8::Gemm g{XA, WLORA_T, M, 1536, 256}; pg8::StaticOrder S; S.init(M, 1536, G, (int)blockIdx.x);
              EpiLora E{0, Wd, H + (size_t)M * MIX, K2b, KKb, Bb, Gb, ARG(I_W0) + (size_t)l * MIX, ARG(I_A0) + (size_t)l * MIX, ARG(I_KA) + (size_t)l * MIX};
              pg8::gemm_phase<EpiLora, pg8::StaticOrder, true, true>(lds, g, S, E, wave_u); }
            { pg8::Gemm g{POOLED, WPOOL_T, M, 512, 512}; pg8::StaticOrder S; S.init(M, 512, G, (int)((blockIdx.x + 104) % G));
              EpiPool E{0, ORP, ARG(I_POOLS) + (size_t)l * POOLW};
              pg8::gemm_phase<EpiPool, pg8::StaticOrder, true, true>(lds, g, S, E, wave_u); }
            if (l > 0) { pg8::Gemm g{H, V12_T, M, 512, 512}; pg8::StaticOrder S; S.init(M, 512, G, (int)((blockIdx.x + 224) % G));
              EpiVmix E{0, H, Vb, VF, ARG(I_V0) + (size_t)(l - 1) * MIX};
              pg8::gemm_phase<EpiVmix, pg8::StaticOrder, true, true>(lds, g, S, E, wave_u); }
        }
        SEAM(ph); ++ph;
        if (IN(ph)) for (int rep_ = 0; rep_ < DUPN(3); ++rep_) { PH_PTRS(); PH_IDS();
            constexpr int SB_F = 5 * 1024 + 256 + 4096;
            LAS float* lbase = (LAS float*)lds;
            constexpr int NITEM = NSEQ * NH * 4;
            const bool is_ld = wave >= 4;
            const int rl = lane >> 4, kq = lane & 15, lrow = (wave & 3) * 4 + rl;
            const int j = tid - 256, js = j >> 4, jk = (j & 15) * 4, jr = j & 15;
            for (int item = blockIdx.x; item < NITEM; item += G) {
                const int seq = item >> 5, hh = (item >> 2) & 7, qtr = item & 3;
                const int T = seq < NSEQ_P ? T_P : T_S, mbase = seq < NSEQ_P ? seq * T_P : MP + (seq - NSEQ_P) * T_S;
                const int CH = T < 16 ? T : 16, nch = T / CH;
                const int vg = 16 * qtr + lrow;
                f32x4 S = (f32x4){0.f, 0.f, 0.f, 0.f};
                if (!is_ld && seq >= NSEQ_P) S = *(const f32x4*)(ARG(I_SWKV) + ((((size_t)l * NSEQ_S + (seq - NSEQ_P)) * NH + hh) * HS + vg) * HS + 4 * kq);
                f32x4 pw = (f32x4){0.f, 0.f, 0.f, 0.f}; v2u pkk = (v2u){0u, 0u}, pb = pkk, pk = pkk, pr = pkk; unsigned short pv = 0;
                const bool sact = is_ld && js < CH;
#define SCAN_LOAD(c0) do { if (sact) { const size_t mm = (size_t)(mbase + (c0) + js) * MIX + 64 * hh; pw = *(const f32x4*)(Wd + mm + jk); pkk = *(const v2u*)(KKb + mm + jk); pb = *(const v2u*)(Bb + mm + jk); \
                    pk = *(const v2u*)(K2b + mm + jk); pr = *(const v2u*)(Rb + mm + jk); pv = Vb[mm + 16 * qtr + jr]; } } while (0)
#define SCAN_STORE(bf) do { if (sact) { LAS float* b_ = lbase + (bf) * SB_F; *(LAS f32x4*)(b_ + js * 64 + jk) = pw; *(LAS f32x4*)(b_ + 1024 + js * 64 + jk) = (f32x4){bf_lo(pkk.x), bf_hi(pkk.x), bf_lo(pkk.y), bf_hi(pkk.y)}; \
                    *(LAS f32x4*)(b_ + 2048 + js * 64 + jk) = (f32x4){-bf_lo(pb.x), -bf_hi(pb.x), -bf_lo(pb.y), -bf_hi(pb.y)}; *(LAS f32x4*)(b_ + 3072 + js * 64 + jk) = (f32x4){bf_lo(pk.x), bf_hi(pk.x), bf_lo(pk.y), bf_hi(pk.y)}; \
                    *(LAS f32x4*)(b_ + 4096 + js * 64 + jk) = (f32x4){bf_lo(pr.x), bf_hi(pr.x), bf_lo(pr.y), bf_hi(pr.y)}; b_[5120 + js * 16 + jr] = bf_lo((unsigned)pv); } } while (0)
#define SCAN_YOUT(bf, c0) do { if (sact) { const LAS float* y_ = lbase + (bf) * SB_F + 5376 + js * 256 + jr * 16; const f32x4 a_ = *(const LAS f32x4*)y_, b2_ = *(const LAS f32x4*)(y_ + 4), c_ = *(const LAS f32x4*)(y_ + 8), d_ = *(const LAS f32x4*)(y_ + 12); \
                    const f32x4 t_ = (a_ + b2_) + (c_ + d_); Y[(size_t)(mbase + (c0) + js) * MIX + 64 * hh + 16 * qtr + jr] = (t_[0] + t_[1]) + (t_[2] + t_[3]); } } while (0)
                SCAN_LOAD(0);
                SCAN_STORE(0);
                if (nch > 1) SCAN_LOAD(CH);
                __syncthreads();
                for (int ch = 0; ch < nch; ++ch) {
                    const int bf = ch & 1;
                    if (is_ld) {
                        if (ch + 1 < nch) SCAN_STORE(bf ^ 1);
                        if (ch + 2 < nch) SCAN_LOAD((ch + 2) * CH);
                        if (ch > 0) SCAN_YOUT(bf ^ 1, (ch - 1) * CH);
                    } else {
                        const LAS float* b_ = lbase + bf * SB_F;
                        LAS float* yp_ = lbase + bf * SB_F + 5376 + lrow * 16 + kq;
                        f32x2 Slo = __builtin_shufflevector(S, S, 0, 1), Shi = __builtin_shufflevector(S, S, 2, 3);
#define SCAN_CP(X, s2) { const f32x2 vv2 = (f32x2){vv##X, vv##X}; \
                                f32x2 dp = Slo * __builtin_shufflevector(kk4##X, kk4##X, 0, 1); dp = Shi * __builtin_shufflevector(kk4##X, kk4##X, 2, 3) + dp; \
                                const float sa = row16_sum(dp[0] + dp[1]); \
                                const f32x2 sa2 = (f32x2){sa, sa}; \
                                f32x2 tlo = Slo * __builtin_shufflevector(w4##X, w4##X, 0, 1), thi = Shi * __builtin_shufflevector(w4##X, w4##X, 2, 3); \
                                tlo = vv2 * __builtin_shufflevector(k4##X, k4##X, 0, 1) + tlo; thi = vv2 * __builtin_shufflevector(k4##X, k4##X, 2, 3) + thi; \
                                Slo = sa2 * __builtin_shufflevector(nb4##X, nb4##X, 0, 1) + tlo; Shi = sa2 * __builtin_shufflevector(nb4##X, nb4##X, 2, 3) + thi; \
                                f32x2 yp = Slo * __builtin_shufflevector(r4##X, r4##X, 0, 1); yp = Shi * __builtin_shufflevector(r4##X, r4##X, 2, 3) + yp; \
                                yv[s2] = yp[0] + yp[1]; }
#define SCAN_ALD(X, s) asm volatile("ds_read_b128 %0, %6 offset:%8\n\tds_read_b128 %1, %6 offset:%9\n\tds_read_b128 %2, %6 offset:%10\n\tds_read_b128 %3, %6 offset:%11\n\tds_read_b128 %4, %6 offset:%12\n\tds_read_b32 %5, %7 offset:%13" \
                                : "=&v"(w4##X), "=&v"(kk4##X), "=&v"(nb4##X), "=&v"(k4##X), "=&v"(r4##X), "=&v"(vv##X) : "v"(a4_), "v"(av_), "n"((s) * 256), "n"(4096 + (s) * 256), "n"(8192 + (s) * 256), "n"(12288 + (s) * 256), "n"(16384 + (s) * 256), "n"(20480 + (s) * 64)); \
                                __builtin_amdgcn_sched_barrier(0);
#define SCAN_AW(X) __builtin_amdgcn_sched_barrier(0); asm volatile("s_waitcnt lgkmcnt(0)" : "+v"(w4##X), "+v"(kk4##X), "+v"(nb4##X), "+v"(k4##X), "+v"(r4##X), "+v"(vv##X)); __builtin_amdgcn_sched_barrier(0);
#define SCAN_PAIR(s) SCAN_ALD(B, (s) + 1) SCAN_CP(A, s) SCAN_AW(B) SCAN_ALD(A, (s) + 2) SCAN_CP(B, (s) + 1) SCAN_AW(A)
                        float yv[16];
                        if (CH == 16) {
                            const unsigned a4_ = (unsigned)(unsigned long long)(b_ + 4 * kq), av_ = (unsigned)(unsigned long long)(b_ + lrow);
                            f32x4 w4A, kk4A, nb4A, k4A, r4A, w4B, kk4B, nb4B, k4B, r4B; float vvA, vvB;
                            SCAN_ALD(A, 0) SCAN_AW(A)
                            SCAN_PAIR(0) SCAN_PAIR(2) SCAN_PAIR(4) SCAN_PAIR(6) SCAN_PAIR(8) SCAN_PAIR(10) SCAN_PAIR(12)
                            SCAN_ALD(B, 15) SCAN_CP(A, 14) SCAN_AW(B) SCAN_CP(B, 15)
#pragma unroll
                            for (int s2 = 0; s2 < 16; ++s2) yp_[s2 * 256] = yv[s2];
                        } else {
#pragma unroll
                            for (int s2 = 0; s2 < 8; ++s2) {
                                const f32x4 w4Z = *(const LAS f32x4*)(b_ + s2 * 64 + 4 * kq), kk4Z = *(const LAS f32x4*)(b_ + 1024 + s2 * 64 + 4 * kq), nb4Z = *(const LAS f32x4*)(b_ + 2048 + s2 * 64 + 4 * kq),
                                            k4Z = *(const LAS f32x4*)(b_ + 3072 + s2 * 64 + 4 * kq), r4Z = *(const LAS f32x4*)(b_ + 4096 + s2 * 64 + 4 * kq); const float vvZ = b_[5120 + s2 * 16 + lrow];
                                SCAN_CP(Z, s2) }
#pragma unroll
                            for (int s2 = 0; s2 < 8; ++s2) yp_[s2 * 256] = yv[s2];
                        }
#undef SCAN_ALD
#undef SCAN_AW
#undef SCAN_CP
#undef SCAN_PAIR
                        S = (f32x4){Slo[0], Slo[1], Shi[0], Shi[1]};
                    }
                    __syncthreads();
                }
                if (is_ld) SCAN_YOUT((nch - 1) & 1, (nch - 1) * CH);
                else { float* so = seq < NSEQ_P ? out + O_WKP + ((((size_t)l * NSEQ_P + seq) * NH + hh) * HS + vg) * HS + 4 * kq
                                                : out + O_WKS + ((((size_t)l * NSEQ_S + (seq - NSEQ_P)) * NH + hh) * HS + vg) * HS + 4 * kq;
                    *(f32x4*)so = S; }
                __syncthreads();
            }
#undef SCAN_LOAD
#undef SCAN_STORE
#undef SCAN_YOUT
        }
        SEAM(ph); ++ph;
        if (IN(ph)) for (int rep_ = 0; rep_ < DUPN(4); ++rep_) { PH_PTRS(); PH_IDS();
            const float* lnw = ARG(I_LNW) + (size_t)l * MIX; const float* lnb = ARG(I_LNB) + (size_t)l * MIX; const float* rk = ARG(I_RK) + (size_t)l * MIX;
            const int c = 8 * lane;
            for (int m = gw; m < M; m += NGW) {
                const f32x4 y0 = *(const f32x4*)(Y + (size_t)m * MIX + c), y1 = *(const f32x4*)(Y + (size_t)m * MIX + c + 4);
                float y[8] = {y0[0], y0[1], y0[2], y0[3], y1[0], y1[1], y1[2], y1[3]};
                float s = 0.f;
#pragma unroll
                for (int i = 0; i < 8; ++i) s += y[i];
                s = row8_sum(s);
                const float mean = s * (1.0f / 64.0f); float q2 = 0.f;
#pragma unroll
                for (int i = 0; i < 8; ++i) { y[i] -= mean; q2 += y[i] * y[i]; }
                q2 = row8_sum(q2);
                const float rstd = 1.0f / sqrtf(q2 * (1.0f / 64.0f) + 64e-5f);
                const v4u ru = *(const v4u*)(Rb + (size_t)m * MIX + c), ku = *(const v4u*)(K2b + (size_t)m * MIX + c), vu = *(const v4u*)(Vb + (size_t)m * MIX + c), gu = *(const v4u*)(Gb + (size_t)m * MIX + c);
                const float rr[8] = {bf_lo(ru.x), bf_hi(ru.x), bf_lo(ru.y), bf_hi(ru.y), bf_lo(ru.z), bf_hi(ru.z), bf_lo(ru.w), bf_hi(ru.w)};
                const float kk[8] = {bf_lo(ku.x), bf_hi(ku.x), bf_lo(ku.y), bf_hi(ku.y), bf_lo(ku.z), bf_hi(ku.z), bf_lo(ku.w), bf_hi(ku.w)};
                const float vv[8] = {bf_lo(vu.x), bf_hi(vu.x), bf_lo(vu.y), bf_hi(vu.y), bf_lo(vu.z), bf_hi(vu.z), bf_lo(vu.w), bf_hi(vu.w)};
                const float gg[8] = {bf_lo(gu.x), bf_hi(gu.x), bf_lo(gu.y), bf_hi(gu.y), bf_lo(gu.z), bf_hi(gu.z), bf_lo(gu.w), bf_hi(gu.w)};
                const f32x4 rk0 = *(const f32x4*)(rk + c), rk1 = *(const f32x4*)(rk + c + 4), w0 = *(const f32x4*)(lnw + c), w1 = *(const f32x4*)(lnw + c + 4), b0 = *(const f32x4*)(lnb + c), b1 = *(const f32x4*)(lnb + c + 4);
                float bs = 0.f;
#pragma unroll
                for (int i = 0; i < 4; ++i) bs += rr[i] * kk[i] * rk0[i] + rr[4 + i] * kk[4 + i] * rk1[i];
                bs = row8_sum(bs);
                float o[8];
#pragma unroll
                for (int i = 0; i < 4; ++i) { o[i] = (y[i] * rstd * w0[i] + b0[i] + bs * vv[i]) * gg[i]; o[4 + i] = (y[4 + i] * rstd * w1[i] + b1[i] + bs * vv[4 + i]) * gg[4 + i]; }
                *(bf16x8*)(ORP + (size_t)m * D + c) = pack8(o);
            }
        }
        SEAM(ph); ++ph;
        if (IN(ph)) for (int rep_ = 0; rep_ < DUPN(5); ++rep_) { PH_PTRS();
            pg8::Gemm g{ORP, WBR_T, MP, D, D}; pg8::StaticOrder S; S.init(MP, D, G, (int)blockIdx.x);
            EpiMerge E{8, P, H};
            pg8::gemm_phase<EpiMerge, pg8::StaticOrder, true, true>(lds, g, S, E, wave_u);
            SAMPLE_TILES(ORP, WBR_T, D, D, E, (MP / 256) * (D / 256));
        }
        SEAM(ph); ++ph;
        if (IN(ph)) for (int rep_ = 0; rep_ < DUPN(6); ++rep_) { PH_PTRS();
            pg8::Gemm g{H, WOUT_T, MP, D, D}; pg8::StaticOrder S; S.init(MP, D, G, (int)blockIdx.x);
            EpiRes E{0, X, modmix + 2048};
            pg8::gemm_phase<EpiRes, pg8::StaticOrder, true, true>(lds, g, S, E, wave_u);
            SAMPLE_TILES(H, WOUT_T, D, D, E, (MP / 256) * (D / 256));
        }
        SEAM(ph); ++ph;
        if (IN(ph)) for (int rep_ = 0; rep_ < DUPN(7); ++rep_) { PH_PTRS(); PH_IDS();
            const float* nw = ARG(I_NORMMLP) + (size_t)l * D;
            for (int m = gw; m < M; m += NGW) {
                const float* xr = X + (size_t)m * D; const float* mo = modmlp + (size_t)row_seq(m) * MODW;
                f32x4 v[4]; float s = 0.f;
#pragma unroll
                for (int j = 0; j < 4; ++j) { v[j] = *(const f32x4*)(xr + 4 * lane + 256 * j); s += (v[j][0] * v[j][0] + v[j][1] * v[j][1]) + (v[j][2] * v[j][2] + v[j][3] * v[j][3]); }
                const float rstd = 1.0f / sqrtf(wave_sum(s) * (1.0f / D) + 1e-6f);
#pragma unroll
                for (int j = 0; j < 4; ++j) { const int c = 4 * lane + 256 * j; const f32x4 g = *(const f32x4*)(nw + c), sh = *(const f32x4*)(mo + c), sc = *(const f32x4*)(mo + 1024 + c);
                    f32x4 o;
#pragma unroll
                    for (int i = 0; i < 4; ++i) o[i] = v[j][i] * rstd * g[i] * (1.0f + sc[i]) + sh[i];
                    *(v2u*)(H + (size_t)m * D + c) = pack4(o[0], o[1], o[2], o[3]); }
            }
        }
        SEAM(ph); ++ph;
        if (IN(ph)) for (int rep_ = 0; rep_ < DUPN(8); ++rep_) { PH_PTRS();
            pg8::Gemm g{H, WFF1_T, MP, DFF, D}; pg8::StaticOrder S; S.init(MP, DFF, G, (int)blockIdx.x);
            EpiStoreBf16 E{0, P, DFF, 1};
            pg8::gemm_phase<EpiStoreBf16, pg8::StaticOrder, true, true>(lds, g, S, E, wave_u);
            SAMPLE_TILES(H, WFF1_T, DFF, D, E, (MP / 256) * (DFF / 256));
        }
        SEAM(ph); ++ph;
        if (IN(ph)) for (int rep_ = 0; rep_ < DUPN(9); ++rep_) { PH_PTRS();
            pg8::Gemm g{P, WFF2_T, MP, D, DFF}; pg8::StaticOrder S; S.init(MP, D, G, (int)blockIdx.x);
            EpiRes E{0, X, modmlp + 2048};
            pg8::gemm_phase<EpiRes, pg8::StaticOrder, true, true>(lds, g, S, E, wave_u);
            SAMPLE_TILES(P, WFF2_T, D, DFF, E, (MP / 256) * (D / 256));
        }
        SEAM(ph); ++ph;
    }
    if (IN(ph)) for (int rep_ = 0; rep_ < DUPN(12); ++rep_) { PH_PTRS(); PH_IDS();
        const float* nw = ARG(I_NORMF);
        for (int m = gw; m < M; m += NGW) {
            float* xr = X + (size_t)m * D;
            f32x4 v[4]; float s = 0.f;
#pragma unroll
            for (int j = 0; j < 4; ++j) { v[j] = *(const f32x4*)(xr + 4 * lane + 256 * j); s += (v[j][0] * v[j][0] + v[j][1] * v[j][1]) + (v[j][2] * v[j][2] + v[j][3] * v[j][3]); }
            const float rstd = 1.0f / sqrtf(wave_sum(s) * (1.0f / D) + 1e-6f);
#pragma unroll
            for (int j = 0; j < 4; ++j) { const int c = 4 * lane + 256 * j; const f32x4 g = *(const f32x4*)(nw + c); *(f32x4*)(xr + c) = v[j] * rstd * g; }
        }
    }
#undef IN
#undef SEAM
}

constexpr int N_PHASES = 2 + DEPTH * 11 + 1;

extern "C" void kernel_launch(void* const* d_in, const int* in_sizes, int n_in, void* d_out, int out_size, void* d_ws, size_t ws_size, hipStream_t stream) {
    static int grid = 0;
    if (grid == 0) {
        if (n_in != N_IN || (size_t)out_size != O_END || ws_size < WS_END) { fprintf(stderr, "kernel_launch: shape mismatch n_in %d out %d ws %zu\n", n_in, out_size, ws_size); grid = -1; return; }
        int dev = 0, cus = 0, per_cu = 0;
        if (hipGetDevice(&dev) != hipSuccess || hipDeviceGetAttribute(&cus, hipDeviceAttributeMultiprocessorCount, dev) != hipSuccess) { grid = -1; return; }
        if (hipFuncSetAttribute((const void*)mk_fwd, hipFuncAttributeMaxDynamicSharedMemorySize, LDS_BYTES) != hipSuccess) { fprintf(stderr, "kernel_launch: hipFuncSetAttribute failed\n"); grid = -1; return; }
        if (hipOccupancyMaxActiveBlocksPerMultiprocessor(&per_cu, (const void*)mk_fwd, NTHR, LDS_BYTES) != hipSuccess || per_cu < 1) { fprintf(stderr, "kernel_launch: occupancy query says %d\n", per_cu); per_cu = 1; }
        (void)hipGetLastError();
        grid = cus * (per_cu < 1 ? per_cu : 1);
    }
    if (grid < 0) return;
    (void)hipMemsetAsync((char*)d_ws + WS_CTL, 0, CTL_ZERO_BYTES, stream);
    Args a{};
    for (int i = 0; i < N_IN; ++i) a.in[i] = (const float*)d_in[i];
    a.out = (float*)d_out; a.ws = (unsigned char*)d_ws; a.dup = PROBE_DUP;
#if MK_ONE_LAUNCH
    a.ph_lo = 0; a.ph_hi = N_PHASES;
    void* kargs[] = {(void*)&a};
    hipError_t e = hipLaunchCooperativeKernel((const void*)mk_fwd, dim3(grid), dim3(NTHR), kargs, LDS_BYTES, stream);
    if (e != hipSuccess) fprintf(stderr, "kernel_launch: cooperative launch failed: %s (grid %d)\n", hipGetErrorString(e), grid);
#else
    for (int p = 0; p < N_PHASES; ++p) { a.ph_lo = p; a.ph_hi = p + 1; hipLaunchKernelGGL(mk_fwd, dim3(grid), dim3(NTHR), LDS_BYTES, stream, a); }
#endif
}
```

```cpp
#include <hip/hip_runtime.h>
#include <cstdio>
#include <cstdint>

#ifndef PROBE_DUP
#define PROBE_DUP -1
#endif
#define DUPN(k) ((args.dup == (k)) ? 2 : 1)
#ifndef MK_ONE_LAUNCH
#define MK_ONE_LAUNCH 1
#endif

#define GAS __attribute__((address_space(1)))
#define LAS __attribute__((address_space(3)))
typedef unsigned short bf16;
typedef unsigned v4u __attribute__((ext_vector_type(4)));
typedef unsigned v2u __attribute__((ext_vector_type(2)));
typedef float f32x4 __attribute__((ext_vector_type(4)));
typedef float f32x2 __attribute__((ext_vector_type(2)));
typedef short bf16x8 __attribute__((ext_vector_type(8)));

constexpr int D = 1024, DEPTH = 4, NSEQ_P = 8, T_P = 2048, NSEQ_S = 128, T_S = 8;
constexpr int MP = NSEQ_P * T_P, MS = NSEQ_S * T_S, M = MP + MS;
constexpr int NSEQ = NSEQ_P + NSEQ_S;
constexpr int MIX = 512, HS = 64, NH = 8, POOLW = 512, PGRP = 128, PBUF = 15, DFF = 4096;
constexpr int RWKV_COLS = 1792, IN_COLS = 4352;
constexpr int C_R = 0, C_K = 512, C_V = 1024, C_XW = 1536, C_XA = 1600, C_XG = 1664, C_PP = 1792, C_GR = 2304, C_GP = 3328;
constexpr int MODW = 8 * 3072;
constexpr int NWAVES = 8, NTHR = 512;

enum { I_XP = 0, I_XS, I_SSHIFT, I_SPOOL, I_SWKV, I_CP, I_CS, I_WADAMIX, I_BADAMIX, I_NORMMIX, I_WIN, I_MU, I_W0, I_W2, I_A0, I_A2, I_G2,
       I_V0, I_V1, I_V2, I_KK, I_KA, I_RK, I_LNW, I_LNB, I_POOLW, I_POOLS, I_WBRR, I_WBRP, I_WOUT, I_WADAMLP, I_BADAMLP, I_NORMMLP, I_WFF1, I_WFF2, I_NORMF, N_IN };
constexpr size_t O_Y = 0, O_SHP = (size_t)M * D, O_POP = O_SHP + 4 * 8 * 1792, O_WKP = O_POP + 4 * 8 * 15 * 512, O_SHS = O_WKP + 4 * 8 * 8 * 4096,
                 O_POS = O_SHS + 4 * 128 * 1792, O_WKS = O_POS + (size_t)4 * 128 * 15 * 512, O_END = O_WKS + (size_t)4 * 128 * 8 * 4096;

constexpr size_t MiB = 1u << 20;
constexpr size_t WS_CTL = 0, CTL_ZERO_BYTES = 1 * MiB;
constexpr size_t WS_MOD = 1 * MiB;
constexpr size_t WS_SC = 14 * MiB;
constexpr size_t WS_SH0 = 14 * MiB + 512 * 1024;
constexpr size_t WS_PH0 = 448 * MiB;
constexpr size_t WS_WIN = 16 * MiB;
constexpr size_t WS_WBR = 25 * MiB;
constexpr size_t WS_WOUT = 27 * MiB;
constexpr size_t WS_WFF1 = 29 * MiB;
constexpr size_t WS_WFF2 = 37 * MiB;
constexpr size_t WS_WSM = 45 * MiB;
constexpr size_t SM_LORA = 0, SM_POOL = 786432, SM_V12 = 1310720;
constexpr size_t WS_H = 48 * MiB;
constexpr size_t WS_P = 82 * MiB;
constexpr size_t WS_R = 227 * MiB, WS_K2 = 244 * MiB, WS_V = 261 * MiB, WS_KK = 278 * MiB, WS_B = 295 * MiB;
constexpr size_t WS_W = 312 * MiB;
constexpr size_t WS_ORP = 346 * MiB;
constexpr size_t WS_G = 380 * MiB;
constexpr size_t WS_VF = 397 * MiB;
constexpr size_t WS_Y = 414 * MiB;
constexpr size_t WS_POOLED = 414 * MiB, WS_XA = 431 * MiB;
constexpr size_t CHK_UNIT = 12544;
constexpr int CHK_NA = 2842, CHK_NB = 2674, CHK_NC = 2256;
constexpr size_t WS_CHKC = 451 * MiB;
constexpr size_t WS_END = 478 * MiB;

constexpr int CW_BAR = 4096;

constexpr int RING_BYTES = 155648, LDSCTL_OFF = RING_BYTES, MISC_OFF = LDSCTL_OFF + 320, LDS_BYTES = 157696;

typedef __bf16 bf16x2_t __attribute__((ext_vector_type(2)));
__device__ __forceinline__ unsigned cvt_pk_bf16(float lo, float hi) { f32x2 v = {lo, hi}; bf16x2_t b = __builtin_convertvector(v, bf16x2_t); return __builtin_bit_cast(unsigned, b); }
__device__ __forceinline__ float bf_lo(unsigned u) { return __builtin_bit_cast(float, u << 16); }
__device__ __forceinline__ float bf_hi(unsigned u) { return __builtin_bit_cast(float, u & 0xffff0000u); }
__device__ __forceinline__ float sigmoidf_(float x) { return 1.0f / (1.0f + __expf(-x)); }
__device__ __forceinline__ float tanhf_(float x) { return 1.0f - 2.0f / (1.0f + __expf(2.0f * x)); }
template <int CTRL> __device__ __forceinline__ float dpp_f(float x) { return __builtin_bit_cast(float, __builtin_amdgcn_update_dpp(0, __builtin_bit_cast(int, x), CTRL, 0xF, 0xF, true)); }
__device__ __forceinline__ float row16_sum(float x) { x += dpp_f<0xB1>(x); x += dpp_f<0x4E>(x); x += dpp_f<0x141>(x); x += dpp_f<0x140>(x); return x; }
__device__ __forceinline__ float row8_sum(float x) { x += dpp_f<0xB1>(x); x += dpp_f<0x4E>(x); x += dpp_f<0x141>(x); return x; }
__device__ __forceinline__ float wave_sum(float v) {
    v = row16_sum(v);
    const float a = __builtin_bit_cast(float, __builtin_amdgcn_readlane(__builtin_bit_cast(int, v), 0)), b = __builtin_bit_cast(float, __builtin_amdgcn_readlane(__builtin_bit_cast(int, v), 16)),
                c = __builtin_bit_cast(float, __builtin_amdgcn_readlane(__builtin_bit_cast(int, v), 32)), d = __builtin_bit_cast(float, __builtin_amdgcn_readlane(__builtin_bit_cast(int, v), 48));
    return (a + b) + (c + d);
}
__device__ __forceinline__ int lane_fresh() { int t; asm volatile("v_mbcnt_lo_u32_b32 %0, -1, 0\n\tv_mbcnt_hi_u32_b32 %0, -1, %0" : "=v"(t)); return t; }
__device__ __forceinline__ int launder_tid(int wave_u) { return wave_u * 64 + lane_fresh(); }
__device__ __forceinline__ int lane_id_() { return lane_fresh(); }
#define LDS_WAIT() asm volatile("s_waitcnt lgkmcnt(0)" ::: "memory")
#define VM_WAIT() asm volatile("s_waitcnt vmcnt(0)" ::: "memory")

namespace pg8 {
#define PG8_LAS __attribute__((address_space(3)))
typedef unsigned short bf16_t;
constexpr int BM = 256, BK = 64, HALF = 128, HTB = HALF * BK * 2, STAGE_BYTES = 8 * HTB, NXCD = 8, WGM = 8;

__host__ __device__ __forceinline__ int lds_byte(int r, int c) { const int st = (r >> 4) * 2 + (c >> 5), rr = r & 15, cc = c & 31, ob = rr * 64 + cc * 2; return st * 1024 + (ob ^ (((ob >> 9) & 1) << 5)); }
__host__ __device__ __forceinline__ void stage_rc(int b, int& R, int& C) { const int st = b / 1024, sb = b % 1024, swz = sb ^ (((sb >> 9) & 1) << 5); R = (st >> 1) * 16 + swz / 64; C = (st & 1) * 32 + (swz % 64) / 2; }
__host__ __device__ __forceinline__ int perm32(int rho) { const int n = rho >> 4, i = rho & 15; return 8 * (i >> 2) + 4 * n + (i & 3); }

struct Unit { int pm, pn; };
struct Gemm { const bf16_t* A; const bf16_t* Bt; int M, N, K; };

struct StaticOrder {
    int nM, nN, nwg, G, c;
    __host__ __device__ void init(int M_, int N_, int G_, int c_) { nM = M_ / BM; nN = N_ / BM; nwg = nM * nN; G = G_; c = c_; }
    __host__ __device__ bool next(int i, Unit& u) const {
        const long L = (long)i * G + c; if (L >= nwg) return false;
        int wgid = (int)L; { const int q = nwg / NXCD, r = nwg % NXCD, xcd = wgid % NXCD, off = wgid / NXCD; wgid = (xcd < r ? xcd * (q + 1) : r * (q + 1) + (xcd - r) * q) + off; }
        const int nig = WGM * nN, gid = wgid / nig, fm = gid * WGM, gsz = (nM - fm) < WGM ? (nM - fm) : WGM;
        u.pm = fm + ((wgid % nig) % gsz); u.pn = (wgid % nig) / gsz; return true;
    }
};

template <class Epi, class Sched, bool ALIGN_EPI = false, bool SP2 = false>
__device__ __forceinline__ void gemm_phase(PG8_LAS unsigned char* lds, const Gemm g, const Sched& S, const Epi& E, const int wave_u) {
    const int tid = launder_tid(wave_u), wid = __builtin_amdgcn_readfirstlane(tid >> 6), lane = tid & 63, wr = wid >> 2, wc = wid & 3, fr = lane & 15, fq = lane >> 4;
    const int K = g.K, nt = K / BK;
    unsigned voffA, voffB;
    { int R, C; stage_rc(tid * 16, R, C); const int Rb = (R & ~31) + perm32(R & 31); voffA = (unsigned)(R * K + C) * 2u; voffB = (unsigned)(Rb * K + C) * 2u; }
    const size_t r64step = (size_t)64 * K * 2;
    const size_t kstep = (size_t)(BK * 2);
    const size_t hstep = (size_t)HALF * K * 2;
    const size_t tstep = 2 * hstep;
    const unsigned ldsw = (unsigned)wid * 1024u;
    const int aoff = lds_byte(wr * 64 + fr, fq * 8), boff = lds_byte(wc * 32 + fr, fq * 8);
#define PG8_SA(b, h) (((b) * 2 + (h)) * HTB)
#define PG8_SB(b, h) ((4 + (b) * 2 + (h)) * HTB)
#define PG8_STAGE(bufoff, gbase, voff) do { _Pragma("unroll") for (int _i = 0; _i < 2; ++_i) \
        __builtin_amdgcn_global_load_lds((const unsigned*)((const char*)(gbase) + _i * r64step + (voff)), (PG8_LAS unsigned*)(lds + (bufoff) + ldsw + _i * 8192), 16, 0, 0); } while (0)
#define PG8_LDA(dst, b, h) do { _Pragma("unroll") for (int m = 0; m < 4; ++m) _Pragma("unroll") for (int k = 0; k < 2; ++k) dst[m][k] = *(const PG8_LAS bf16x8*)(lds + PG8_SA(b, h) + aoff + m * 2048 + k * 1024); } while (0)
#define PG8_LDB(dst, b, h) do { _Pragma("unroll") for (int n = 0; n < 2; ++n) _Pragma("unroll") for (int k = 0; k < 2; ++k) dst[n][k] = *(const PG8_LAS bf16x8*)(lds + PG8_SB(b, h) + boff + n * 2048 + k * 1024); } while (0)
#define PG8_MMA(ai, bj, At, Bt) do { __builtin_amdgcn_s_setprio(1); _Pragma("unroll") for (int m = 0; m < 4; ++m) _Pragma("unroll") for (int n = 0; n < 2; ++n) _Pragma("unroll") for (int k = 0; k < 2; ++k) \
        acc[ai][bj][m][n] = __builtin_amdgcn_mfma_f32_16x16x32_bf16(Bt[n][k], At[m][k], acc[ai][bj][m][n], 0, 0, 0); __builtin_amdgcn_s_setprio(0); } while (0)
#define PG8_WAIT_V(n) asm volatile("s_waitcnt vmcnt(" #n ")" ::: "memory")
#define PG8_WAIT_L(n) asm volatile("s_waitcnt lgkmcnt(" #n ")" ::: "memory")
#define PG8_BAR __builtin_amdgcn_s_barrier()
#define PG8_SCHED __builtin_amdgcn_sched_barrier(0)
    Unit cur, nxt; int ui = 0;
    if (!S.next(0, cur)) return;
    f32x4 acc[2][2][4][2];
#pragma unroll
    for (int a = 0; a < 2; ++a)
#pragma unroll
        for (int b = 0; b < 2; ++b)
#pragma unroll
            for (int m = 0; m < 4; ++m)
#pragma unroll
                for (int n = 0; n < 2; ++n) acc[a][b][m][n] = (f32x4){0.f, 0.f, 0.f, 0.f};
    bf16x8 At[4][2], B0[2][2], B1[2][2];
    const char* cA = (const char*)g.A + (size_t)cur.pm * tstep; const char* cB = (const char*)g.Bt + (size_t)cur.pn * tstep;
    if constexpr (SP2) {
        PG8_STAGE(PG8_SB(0, 0), cB, voffB); PG8_STAGE(PG8_SB(0, 1), cB + hstep, voffB); PG8_STAGE(PG8_SA(0, 0), cA, voffA); PG8_STAGE(PG8_SA(0, 1), cA + hstep, voffA);
        if (wr == 1) PG8_BAR;
        PG8_WAIT_V(2); PG8_BAR;
        PG8_STAGE(PG8_SB(1, 0), cB + kstep, voffB); PG8_STAGE(PG8_SA(1, 0), cA + kstep, voffA); PG8_STAGE(PG8_SB(1, 1), cB + hstep + kstep, voffB);
        PG8_WAIT_V(6); PG8_BAR;
    } else {
        PG8_STAGE(PG8_SB(0, 0), cB, voffB); PG8_STAGE(PG8_SA(0, 0), cA, voffA); PG8_STAGE(PG8_SB(0, 1), cB + hstep, voffB); PG8_STAGE(PG8_SA(0, 1), cA + hstep, voffA);
        if (wr == 1) PG8_BAR;
        PG8_WAIT_V(4); PG8_BAR;
        PG8_STAGE(PG8_SB(1, 0), cB + kstep, voffB); PG8_STAGE(PG8_SA(1, 0), cA + kstep, voffA); PG8_STAGE(PG8_SB(1, 1), cB + hstep + kstep, voffB);
        PG8_WAIT_V(6); PG8_BAR;
    }
    for (;;) {
        const bool has_next = S.next(ui + 1, nxt);
        const char* nA = has_next ? (const char*)g.A + (size_t)nxt.pm * tstep : cA; const char* nB = has_next ? (const char*)g.Bt + (size_t)nxt.pn * tstep : cB;
        for (int t = 0; t < nt; t += 2) {
            const bool last = (t == nt - 2);
            const char* a1 = cA + (size_t)(t + 1) * kstep;
            const char* a2 = last ? nA : cA + (size_t)(t + 2) * kstep; const char* b2 = last ? nB : cB + (size_t)(t + 2) * kstep;
            const char* a3 = a2 + kstep; const char* b3 = b2 + kstep;
            if constexpr (Epi::HOOK) { if (t == E.hook_t) E.hook(acc, cur, wr, wc, fr, fq); }
            if constexpr (SP2) {
            PG8_LDB(B0, 0, 0); PG8_LDB(B1, 0, 1); PG8_SCHED; PG8_LDA(At, 0, 0); PG8_STAGE(PG8_SA(1, 1), a1 + hstep, voffA);
            PG8_WAIT_V(8); PG8_WAIT_L(0); PG8_BAR; PG8_MMA(0, 0, At, B0); PG8_MMA(0, 1, At, B1); PG8_BAR; PG8_SCHED;
            PG8_LDA(At, 0, 1); PG8_STAGE(PG8_SB(0, 0), b2, voffB); PG8_STAGE(PG8_SB(0, 1), b2 + hstep, voffB); PG8_STAGE(PG8_SA(0, 0), a2, voffA);
            PG8_WAIT_V(8); PG8_WAIT_L(0); PG8_BAR; PG8_MMA(1, 0, At, B0); PG8_MMA(1, 1, At, B1); PG8_BAR; PG8_SCHED;
            PG8_LDB(B0, 1, 0); PG8_LDB(B1, 1, 1); PG8_SCHED; PG8_LDA(At, 1, 0); PG8_STAGE(PG8_SA(0, 1), a2 + hstep, voffA);
            PG8_WAIT_V(8); PG8_WAIT_L(0); PG8_BAR; PG8_MMA(0, 0, At, B0); PG8_MMA(0, 1, At, B1); PG8_BAR; PG8_SCHED;
            PG8_LDA(At, 1, 1); PG8_STAGE(PG8_SB(1, 0), b3, voffB); PG8_STAGE(PG8_SB(1, 1), b3 + hstep, voffB); PG8_STAGE(PG8_SA(1, 0), a3, voffA);
            PG8_WAIT_V(8); PG8_WAIT_L(0); PG8_BAR; PG8_MMA(1, 0, At, B0); PG8_MMA(1, 1, At, B1); PG8_BAR; PG8_SCHED;
            } else {
            PG8_LDB(B0, 0, 0); PG8_SCHED; PG8_LDA(At, 0, 0); PG8_STAGE(PG8_SA(1, 1), a1 + hstep, voffA);
            PG8_WAIT_L(8); PG8_BAR; PG8_WAIT_L(0); PG8_MMA(0, 0, At, B0); PG8_BAR; PG8_SCHED;
            PG8_LDB(B1, 0, 1); PG8_STAGE(PG8_SB(0, 0), b2, voffB);
            PG8_BAR; PG8_WAIT_L(0); PG8_MMA(0, 1, At, B1); PG8_BAR;
            PG8_LDA(At, 0, 1); PG8_STAGE(PG8_SA(0, 0), a2, voffA);
            PG8_BAR; PG8_WAIT_L(0); PG8_MMA(1, 0, At, B0); PG8_BAR; PG8_SCHED;
            PG8_STAGE(PG8_SB(0, 1), b2 + hstep, voffB);
            PG8_WAIT_V(6); PG8_BAR; PG8_MMA(1, 1, At, B1); PG8_BAR;
            PG8_LDB(B0, 1, 0); PG8_SCHED; PG8_LDA(At, 1, 0); PG8_STAGE(PG8_SA(0, 1), a2 + hstep, voffA);
            PG8_WAIT_L(8); PG8_BAR; PG8_WAIT_L(0); PG8_MMA(0, 0, At, B0); PG8_BAR; PG8_SCHED;
            PG8_LDB(B1, 1, 1); PG8_STAGE(PG8_SB(1, 0), b3, voffB);
            PG8_BAR; PG8_WAIT_L(0); PG8_MMA(0, 1, At, B1); PG8_BAR;
            PG8_LDA(At, 1, 1); PG8_STAGE(PG8_SA(1, 0), a3, voffA);
            PG8_BAR; PG8_WAIT_L(0); PG8_MMA(1, 0, At, B0); PG8_BAR; PG8_SCHED;
            PG8_STAGE(PG8_SB(1, 1), b3 + hstep, voffB);
            PG8_WAIT_V(6); PG8_BAR; PG8_MMA(1, 1, At, B1); PG8_BAR;
            }
        }
        if constexpr (ALIGN_EPI) { if (wr == 0) PG8_BAR; }
        E(acc, cur, wr, wc, fr, fq);
        if (!has_next) break;
#pragma unroll
        for (int a = 0; a < 2; ++a)
#pragma unroll
            for (int b = 0; b < 2; ++b)
#pragma unroll
                for (int m = 0; m < 4; ++m)
#pragma unroll
                    for (int n = 0; n < 2; ++n) acc[a][b][m][n] = (f32x4){0.f, 0.f, 0.f, 0.f};
        cur = nxt; cA = nA; cB = nB; ++ui;
        if constexpr (ALIGN_EPI) { if (wr == 1) PG8_BAR; }
    }
    PG8_WAIT_V(0);
    if constexpr (!ALIGN_EPI) { if (wr == 0) PG8_BAR; }
    PG8_BAR;
#undef PG8_SA
#undef PG8_SB
#undef PG8_STAGE
#undef PG8_LDA
#undef PG8_LDB
#undef PG8_MMA
#undef PG8_WAIT_V
#undef PG8_WAIT_L
#undef PG8_BAR
#undef PG8_SCHED
}
}

__device__ __forceinline__ int row_seq(int m) { return m < MP ? (m >> 11) : NSEQ_P + ((m - MP) >> 3); }
__device__ __forceinline__ int row_t(int m) { return m < MP ? (m & (T_P - 1)) : ((m - MP) & (T_S - 1)); }

struct EpiBase { static constexpr bool HOOK = false; int hook_t; };

struct EpiStoreBf16 {
    static constexpr bool HOOK = false; int hook_t;
    bf16* O; int ldc; int act;
    __device__ __forceinline__ void hook_apply(int, int, f32x4&, f32x4&) const {}
    __device__ __forceinline__ void apply(int row, int col, f32x4 v0, f32x4 v1) const {
        if (act == 1) {
#pragma unroll
            for (int j = 0; j < 4; ++j) { float a = fmaxf(v0[j], 0.f), b = fmaxf(v1[j], 0.f); v0[j] = a * a; v1[j] = b * b; } }
        v4u w; w.x = cvt_pk_bf16(v0[0], v0[1]); w.y = cvt_pk_bf16(v0[2], v0[3]); w.z = cvt_pk_bf16(v1[0], v1[1]); w.w = cvt_pk_bf16(v1[2], v1[3]);
        *(v4u*)(O + (size_t)row * ldc + col) = w;
    }
    __device__ __forceinline__ void hook(f32x4 (&)[2][2][4][2], const pg8::Unit&, int, int, int, int) const {}
    __device__ __forceinline__ void operator()(const f32x4 (&acc)[2][2][4][2], const pg8::Unit& u, int wr, int wc, int fr, int fq) const {
        { const int ln__ = lane_fresh(); fr = ln__ & 15; fq = ln__ >> 4; }
        const int row0 = u.pm * 256 + wr * 64 + fr, col0 = u.pn * 256 + wc * 32 + 8 * fq;
#pragma unroll
        for (int ai = 0; ai < 2; ++ai)
#pragma unroll
            for (int m = 0; m < 4; ++m) { bf16* rowp = O + (size_t)(row0 + ai * 128 + m * 16) * ldc + col0;
#pragma unroll
                for (int bj = 0; bj < 2; ++bj) { f32x4 v0 = acc[ai][bj][m][0], v1 = acc[ai][bj][m][1];
                    if (act == 1) {
#pragma unroll
                        for (int j = 0; j < 4; ++j) { float a = fmaxf(v0[j], 0.f), b = fmaxf(v1[j], 0.f); v0[j] = a * a; v1[j] = b * b; } }
                    v4u w; w.x = cvt_pk_bf16(v0[0], v0[1]); w.y = cvt_pk_bf16(v0[2], v0[3]); w.z = cvt_pk_bf16(v1[0], v1[1]); w.w = cvt_pk_bf16(v1[2], v1[3]);
                    *(v4u*)(rowp + bj * 128) = w; } }
    }
};

struct EpiMod {
    static constexpr bool HOOK = false; int hook_t;
    float* O; const float* bmix; const float* bmlp;
    __device__ __forceinline__ void hook(f32x4 (&)[2][2][4][2], const pg8::Unit&, int, int, int, int) const {}
    __device__ __forceinline__ void operator()(const f32x4 (&acc)[2][2][4][2], const pg8::Unit& u, int wr, int wc, int fr, int fq) const {
        { const int ln__ = lane_fresh(); fr = ln__ & 15; fq = ln__ >> 4; }
        const int row0 = u.pm * 256 + wr * 64 + fr, col0 = u.pn * 256 + wc * 32 + 8 * fq;
        const int mat = (u.pn * 256) / 3072, l = mat >> 1, which = mat & 1;
        const float* bias = (which ? bmlp : bmix) + l * 3072 - mat * 3072;
#pragma unroll
        for (int ai = 0; ai < 2; ++ai)
#pragma unroll
            for (int m = 0; m < 4; ++m) { const int row = row0 + ai * 128 + m * 16; if (row >= NSEQ) continue;
#pragma unroll
                for (int bj = 0; bj < 2; ++bj) { const int col = col0 + bj * 128;
                    const f32x4 b0 = *(const f32x4*)(bias + col), b1 = *(const f32x4*)(bias + col + 4);
                    *(f32x4*)(O + (size_t)row * MODW + col) = acc[ai][bj][m][0] + b0; *(f32x4*)(O + (size_t)row * MODW + col + 4) = acc[ai][bj][m][1] + b1; } }
    }
};

struct EpiRes {
    static constexpr bool HOOK = false; int hook_t;
    float* X; const float* gate;
    __device__ __forceinline__ void hook_apply(int, int, f32x4&, f32x4&) const {}
    __device__ __forceinline__ void apply(int row, int col, f32x4 v0, f32x4 v1) const {
        const float* gr = gate + (size_t)row_seq(row) * MODW + col; float* xr = X + (size_t)row * D + col;
        const f32x4 g0 = *(const f32x4*)gr, g1 = *(const f32x4*)(gr + 4);
        f32x4 x0 = *(const f32x4*)xr, x1 = *(const f32x4*)(xr + 4);
        x0 += g0 * v0; x1 += g1 * v1;
        *(f32x4*)xr = x0; *(f32x4*)(xr + 4) = x1;
    }
    __device__ __forceinline__ void hook(f32x4 (&)[2][2][4][2], const pg8::Unit&, int, int, int, int) const {}
    __device__ __forceinline__ void operator()(const f32x4 (&acc)[2][2][4][2], const pg8::Unit& u, int wr, int wc, int fr, int fq) const {
        { const int ln__ = lane_fresh(); fr = ln__ & 15; fq = ln__ >> 4; }
        const int row0 = u.pm * 256 + wr * 64 + fr, col0 = u.pn * 256 + wc * 32 + 8 * fq;
#pragma unroll
        for (int ai = 0; ai < 2; ++ai)
#pragma unroll
            for (int m = 0; m < 4; ++m) { const int row = row0 + ai * 128 + m * 16; const float* gr = gate + (size_t)row_seq(row) * MODW; float* xr = X + (size_t)row * D;
#pragma unroll
                for (int bj = 0; bj < 2; ++bj) { const int col = col0 + bj * 128;
                    const f32x4 g0 = *(const f32x4*)(gr + col), g1 = *(const f32x4*)(gr + col + 4);
                    f32x4 x0 = *(const f32x4*)(xr + col), x1 = *(const f32x4*)(xr + col + 4);
                    x0 += g0 * acc[ai][bj][m][0]; x1 += g1 * acc[ai][bj][m][1];
                    *(f32x4*)(xr + col) = x0; *(f32x4*)(xr + col + 4) = x1; } }
    }
};

struct EpiMerge {
    static constexpr bool HOOK = true; int hook_t;
    const bf16* P; bf16* O;
    __device__ __forceinline__ void hook_apply(int row, int col, f32x4& v0, f32x4& v1) const {
        const bf16* pr = P + (size_t)row * IN_COLS + col; const v4u a = *(const v4u*)(pr + C_GR), b = *(const v4u*)(pr + C_GP);
        const float ga[8] = {bf_lo(a.x), bf_hi(a.x), bf_lo(a.y), bf_hi(a.y), bf_lo(a.z), bf_hi(a.z), bf_lo(a.w), bf_hi(a.w)};
        const float gb[8] = {bf_lo(b.x), bf_hi(b.x), bf_lo(b.y), bf_hi(b.y), bf_lo(b.z), bf_hi(b.z), bf_lo(b.w), bf_hi(b.w)};
#pragma unroll
        for (int j = 0; j < 4; ++j) { v0[j] *= (1.0f + __expf(-gb[j])) / (1.0f + __expf(-ga[j])); v1[j] *= (1.0f + __expf(-gb[4 + j])) / (1.0f + __expf(-ga[4 + j])); }
    }
    __device__ __forceinline__ void apply(int row, int col, f32x4 v0, f32x4 v1) const {
        const v4u b = *(const v4u*)(P + (size_t)row * IN_COLS + C_GP + col);
        const float gb[8] = {bf_lo(b.x), bf_hi(b.x), bf_lo(b.y), bf_hi(b.y), bf_lo(b.z), bf_hi(b.z), bf_lo(b.w), bf_hi(b.w)};
#pragma unroll
        for (int j = 0; j < 4; ++j) { v0[j] *= sigmoidf_(gb[j]); v1[j] *= sigmoidf_(gb[4 + j]); }
        v4u w; w.x = cvt_pk_bf16(v0[0], v0[1]); w.y = cvt_pk_bf16(v0[2], v0[3]); w.z = cvt_pk_bf16(v1[0], v1[1]); w.w = cvt_pk_bf16(v1[2], v1[3]);
        *(v4u*)(O + (size_t)row * D + col) = w;
    }
    __device__ __forceinline__ void hook(f32x4 (&acc)[2][2][4][2], const pg8::Unit& u, int wr, int wc, int fr, int fq) const {
        { const int ln__ = lane_fresh(); fr = ln__ & 15; fq = ln__ >> 4; }
        const int row0 = u.pm * 256 + wr * 64 + fr, col0 = u.pn * 256 + wc * 32 + 8 * fq;
#pragma unroll
        for (int ai = 0; ai < 2; ++ai)
#pragma unroll
            for (int m = 0; m < 4; ++m) { const bf16* pr = P + (size_t)(row0 + ai * 128 + m * 16) * IN_COLS + col0;
#pragma unroll
                for (int bj = 0; bj < 2; ++bj) { const v4u a = *(const v4u*)(pr + C_GR + bj * 128), b = *(const v4u*)(pr + C_GP + bj * 128);
                    float ga[8] = {bf_lo(a.x), bf_hi(a.x), bf_lo(a.y), bf_hi(a.y), bf_lo(a.z), bf_hi(a.z), bf_lo(a.w), bf_hi(a.w)};
                    float gb[8] = {bf_lo(b.x), bf_hi(b.x), bf_lo(b.y), bf_hi(b.y), bf_lo(b.z), bf_hi(b.z), bf_lo(b.w), bf_hi(b.w)};
#pragma unroll
                    for (int j = 0; j < 4; ++j) { acc[ai][bj][m][0][j] *= (1.0f + __expf(-gb[j])) / (1.0f + __expf(-ga[j]));
                                                  acc[ai][bj][m][1][j] *= (1.0f + __expf(-gb[4 + j])) / (1.0f + __expf(-ga[4 + j])); } } }
    }
    __device__ __forceinline__ void operator()(const f32x4 (&acc)[2][2][4][2], const pg8::Unit& u, int wr, int wc, int fr, int fq) const {
        { const int ln__ = lane_fresh(); fr = ln__ & 15; fq = ln__ >> 4; }
        const int row0 = u.pm * 256 + wr * 64 + fr, col0 = u.pn * 256 + wc * 32 + 8 * fq;
#pragma unroll
        for (int ai = 0; ai < 2; ++ai)
#pragma unroll
            for (int m = 0; m < 4; ++m) { const size_t row = (size_t)(row0 + ai * 128 + m * 16); const bf16* pr = P + row * IN_COLS + col0;
#pragma unroll
                for (int bj = 0; bj < 2; ++bj) { const v4u b = *(const v4u*)(pr + C_GP + bj * 128);
                    float gb[8] = {bf_lo(b.x), bf_hi(b.x), bf_lo(b.y), bf_hi(b.y), bf_lo(b.z), bf_hi(b.z), bf_lo(b.w), bf_hi(b.w)};
                    f32x4 v0 = acc[ai][bj][m][0], v1 = acc[ai][bj][m][1];
#pragma unroll
                    for (int j = 0; j < 4; ++j) { v0[j] *= sigmoidf_(gb[j]); v1[j] *= sigmoidf_(gb[4 + j]); }
                    v4u w; w.x = cvt_pk_bf16(v0[0], v0[1]); w.y = cvt_pk_bf16(v0[2], v0[3]); w.z = cvt_pk_bf16(v1[0], v1[1]); w.w = cvt_pk_bf16(v1[2], v1[3]);
                    *(v4u*)(O + row * D + col0 + bj * 128) = w; } }
    }
};

#define EPI_BIG_OPERATOR() \
    __device__ __forceinline__ void hook(f32x4 (&)[2][2][4][2], const pg8::Unit&, int, int, int, int) const {} \
    __device__ __forceinline__ void operator()(const f32x4 (&acc)[2][2][4][2], const pg8::Unit& u, int wr, int wc, int fr, int fq) const { \
        { const int ln__ = lane_fresh(); fr = ln__ & 15; fq = ln__ >> 4; } \
        const int row0 = u.pm * 256 + wr * 64 + fr, col0 = u.pn * 256 + wc * 32 + 8 * fq; \
        _Pragma("unroll") for (int ai = 0; ai < 2; ++ai) _Pragma("unroll") for (int m = 0; m < 4; ++m) _Pragma("unroll") for (int bj = 0; bj < 2; ++bj) \
            apply(row0 + ai * 128 + m * 16, col0 + bj * 128, acc[ai][bj][m][0], acc[ai][bj][m][1]); }

__device__ __forceinline__ void unpack8(const v4u u, float (&f)[8]) { f[0] = bf_lo(u.x); f[1] = bf_hi(u.x); f[2] = bf_lo(u.y); f[3] = bf_hi(u.y); f[4] = bf_lo(u.z); f[5] = bf_hi(u.z); f[6] = bf_lo(u.w); f[7] = bf_hi(u.w); }
__device__ __forceinline__ v4u pack8u(const float (&f)[8]) { v4u u; u.x = cvt_pk_bf16(f[0], f[1]); u.y = cvt_pk_bf16(f[2], f[3]); u.z = cvt_pk_bf16(f[4], f[5]); u.w = cvt_pk_bf16(f[6], f[7]); return u; }

struct EpiLora {
    static constexpr bool HOOK = false; int hook_t;
    float* Wd; const bf16* KX; bf16* K2; const bf16* KK; bf16* Bb; bf16* Gb; const float* w0; const float* a0; const float* ka;
    __device__ __forceinline__ void apply(int row, int col, f32x4 v0, f32x4 v1) const {
        const int ty = col >> 9, c = col & 511; const size_t o = (size_t)row * MIX + c;
        const float acc[8] = {v0[0], v0[1], v0[2], v0[3], v1[0], v1[1], v1[2], v1[3]};
        if (ty == 0) { const f32x4 b0 = *(const f32x4*)(w0 + c), b1 = *(const f32x4*)(w0 + c + 4); f32x4 o0, o1;
#pragma unroll
            for (int j = 0; j < 4; ++j) { o0[j] = __expf(-0.6065306597126334f * sigmoidf_(b0[j] + acc[j])); o1[j] = __expf(-0.6065306597126334f * sigmoidf_(b1[j] + acc[4 + j])); }
            *(f32x4*)(Wd + o) = o0; *(f32x4*)(Wd + o + 4) = o1;
        } else if (ty == 1) { const f32x4 b0 = *(const f32x4*)(a0 + c), b1 = *(const f32x4*)(a0 + c + 4), k0 = *(const f32x4*)(ka + c), k1 = *(const f32x4*)(ka + c + 4);
            float k[8], kk[8], k2[8], bb[8]; unpack8(*(const v4u*)(KX + o), k); unpack8(*(const v4u*)(KK + o), kk);
#pragma unroll
            for (int j = 0; j < 8; ++j) { const float a = sigmoidf_((j < 4 ? b0[j & 3] : b1[j & 3]) + acc[j]); k2[j] = k[j] * (1.0f + (a - 1.0f) * (j < 4 ? k0[j & 3] : k1[j & 3])); bb[j] = kk[j] * a; }
            *(v4u*)(K2 + o) = pack8u(k2); *(v4u*)(Bb + o) = pack8u(bb);
        } else { *(v4u*)(Gb + o) = pack8u(acc); }
    }
    EPI_BIG_OPERATOR()
};
struct EpiPool {
    static constexpr bool HOOK = false; int hook_t;
    bf16* ORP; const float* scale;
    __device__ __forceinline__ void apply(int row, int col, f32x4 v0, f32x4 v1) const {
        const f32x4 s0 = *(const f32x4*)(scale + col), s1 = *(const f32x4*)(scale + col + 4); v0 *= s0; v1 *= s1;
        v4u w; w.x = cvt_pk_bf16(v0[0], v0[1]); w.y = cvt_pk_bf16(v0[2], v0[3]); w.z = cvt_pk_bf16(v1[0], v1[1]); w.w = cvt_pk_bf16(v1[2], v1[3]);
        *(v4u*)(ORP + (size_t)row * D + MIX + col) = w;
    }
    EPI_BIG_OPERATOR()
};
struct EpiVmix {
    static constexpr bool HOOK = false; int hook_t;
    const bf16* VX; bf16* V; const bf16* VF; const float* v0p;
    __device__ __forceinline__ void apply(int row, int col, f32x4 a0_, f32x4 a1_) const {
        const size_t o = (size_t)row * MIX + col; const f32x4 b0 = *(const f32x4*)(v0p + col), b1 = *(const f32x4*)(v0p + col + 4);
        const float acc[8] = {a0_[0], a0_[1], a0_[2], a0_[3], a1_[0], a1_[1], a1_[2], a1_[3]};
        float v[8], vf[8], r[8]; unpack8(*(const v4u*)(VX + o), v); unpack8(*(const v4u*)(VF + o), vf);
#pragma unroll
        for (int j = 0; j < 8; ++j) r[j] = v[j] + (vf[j] - v[j]) * sigmoidf_((j < 4 ? b0[j & 3] : b1[j & 3]) + acc[j]);
        *(v4u*)(V + o) = pack8u(r);
    }
    EPI_BIG_OPERATOR()
};

#define MFMA16(a, b, c) __builtin_amdgcn_mfma_f32_16x16x32_bf16((a), (b), (c), 0, 0, 0)
template <class Epi>
__device__ __forceinline__ void sgemm_tiles(LAS unsigned char* lds, const bf16* A, const bf16* Bt, int N, int K, const Epi& E, int t0, int tstep, int tend, const int wave_u) {
    const int tid = launder_tid(wave_u), wid = __builtin_amdgcn_readfirstlane(tid >> 6), lane = tid & 63, fr = lane & 15, fq = lane >> 4, wm = wid & 3, wn = wid >> 2;
    int R, C; pg8::stage_rc(tid * 16, R, C);
    const int Rb = (R & ~31) + pg8::perm32(R & 31);
    const unsigned ldsw = (unsigned)wid * 1024u;
    const int aoff = pg8::lds_byte(wm * 16 + fr, fq * 8), boff = 8192 + pg8::lds_byte(wn * 32 + fr, fq * 8);
    const int nk = K / 64;
#define SG_STAGE(slot, kt) do { __builtin_amdgcn_global_load_lds((const unsigned*)(ag + (size_t)(kt) * 64), (LAS unsigned*)(lds + (slot) * 16384 + ldsw), 16, 0, 0); \
                                __builtin_amdgcn_global_load_lds((const unsigned*)(bg + (size_t)(kt) * 64), (LAS unsigned*)(lds + (slot) * 16384 + 8192 + ldsw), 16, 0, 0); } while (0)
    for (int t = t0; t < tend; t += tstep) {
        const int rt = t & 15, ct = t >> 4, r0 = MP + 64 * rt, c0 = 64 * ct;
        const bf16* ag = A + (size_t)(r0 + R) * K + C; const bf16* bg = Bt + (size_t)(c0 + Rb) * K + C;
        f32x4 acc0 = (f32x4){0.f, 0.f, 0.f, 0.f}, acc1 = acc0;
        SG_STAGE(0, 0); SG_STAGE(1, 1); SG_STAGE(2, 2);
        for (int kt = 0; kt < nk; ++kt) {
            if (kt + 2 < nk) asm volatile("s_waitcnt vmcnt(4)" ::: "memory"); else if (kt + 1 < nk) asm volatile("s_waitcnt vmcnt(2)" ::: "memory"); else asm volatile("s_waitcnt vmcnt(0)" ::: "memory");
            __builtin_amdgcn_s_barrier();
            if (kt + 3 < nk) SG_STAGE((kt + 3) & 3, kt + 3);
            if constexpr (Epi::HOOK) { if (kt == E.hook_t) E.hook_apply(r0 + wm * 16 + fr, c0 + wn * 32 + 8 * fq, acc0, acc1); }
            const LAS unsigned char* sl = lds + (kt & 3) * 16384;
            const bf16x8 a0 = *(const LAS bf16x8*)(sl + aoff), a1 = *(const LAS bf16x8*)(sl + aoff + 1024);
            const bf16x8 b00 = *(const LAS bf16x8*)(sl + boff), b01 = *(const LAS bf16x8*)(sl + boff + 1024), b10 = *(const LAS bf16x8*)(sl + boff + 2048), b11 = *(const LAS bf16x8*)(sl + boff + 3072);
            acc0 = MFMA16(b00, a0, acc0); acc1 = MFMA16(b10, a0, acc1);
            acc0 = MFMA16(b01, a1, acc0); acc1 = MFMA16(b11, a1, acc1);
        }
        E.apply(r0 + wm * 16 + fr, c0 + wn * 32 + 8 * fq, acc0, acc1);
        __builtin_amdgcn_s_barrier();
    }
#undef SG_STAGE
}

#define XB_TMO      128
#define XB_XCNT(j)  (256  + 64 * (j))
#define XB_XSUB(j)  (1280 + 64 * (j))
#define XB_XGEN(j)  (2304 + 64 * (j))
#define XB_TOP      3328
#define XB_TOPGEN   3392
#define XCD_BAR_WORDS 3456
#define XB_SPIN_CAP (1u << 22)

__device__ __forceinline__ unsigned xb_ld(unsigned* p)              { return __hip_atomic_load(p, __ATOMIC_RELAXED, __HIP_MEMORY_SCOPE_AGENT); }
__device__ __forceinline__ unsigned xb_add(unsigned* p, unsigned v) { return __hip_atomic_fetch_add(p, v, __ATOMIC_RELAXED, __HIP_MEMORY_SCOPE_AGENT); }
__device__ __forceinline__ unsigned xb_xcc_id() { return (unsigned)__builtin_amdgcn_s_getreg((3 << 11) | 20) & 0xFu; }
#define XB_SPIN(cond, bar) do { unsigned _sp = 0; while (cond) { __builtin_amdgcn_s_sleep(1); \
    if ((++_sp & 255u) == 0u) { if (xb_ld(&(bar)[XB_TMO])) break; if (_sp > XB_SPIN_CAP) { atomicAdd(&(bar)[XB_TMO], 1u); break; } } } } while (0)

struct XcdBarrier { unsigned* bar; unsigned x; volatile LAS unsigned* st; };

__device__ __forceinline__ XcdBarrier xcd_barrier_post(unsigned* bar, volatile LAS unsigned* st, const int wave_u) {
    XcdBarrier b; b.bar = bar; b.x = xb_xcc_id(); b.st = st;
    if (wave_u == 0 && lane_id_() == 0) (void)xb_add(&bar[XB_XCNT(b.x)], 1u);
    return b;
}
__device__ __forceinline__ void xcd_barrier_complete(unsigned* bar, unsigned x, unsigned& nloc, unsigned& nx) {
    const unsigned G = gridDim.x * gridDim.y * gridDim.z;
    unsigned sum, cnt, mine, sp = 0u;
    for (;;) {
        sum = 0u; cnt = 0u; mine = 0u;
#pragma unroll
        for (unsigned j = 0; j < 16; ++j) { const unsigned c = xb_ld(&bar[XB_XCNT(j)]); sum += c; cnt += (c > 0u) ? 1u : 0u; mine = (j == x) ? c : mine; }
        if (sum == G) break;
        __builtin_amdgcn_s_sleep(1);
        if ((++sp & 255u) == 0u) { if (xb_ld(&bar[XB_TMO])) break; if (sp > XB_SPIN_CAP) { atomicAdd(&bar[XB_TMO], 1u); break; } }
    }
    nloc = mine > 0u ? mine : 1u; nx = cnt > 0u ? cnt : 1u;
}
__device__ __forceinline__ void xcd_barrier(const XcdBarrier& b, const int wave_u) {
    asm volatile("s_waitcnt vmcnt(0)" ::: "memory");
    __syncthreads();
    if (wave_u == 0 && lane_id_() == 0) {
        unsigned* bar = b.bar;
        __builtin_amdgcn_s_waitcnt(0);
        unsigned nloc = b.st[0], nx = b.st[1];
        if (nloc == 0u) { xcd_barrier_complete(bar, b.x, nloc, nx); b.st[0] = nloc; b.st[1] = nx; }
        const unsigned old = xb_add(&bar[XB_XSUB(b.x)], 1u);
        const unsigned gen = old / nloc;
        if (old + 1u == (gen + 1u) * nloc) {
            __builtin_amdgcn_fence(__ATOMIC_RELEASE, "agent");
            asm volatile("s_waitcnt vmcnt(0)" ::: "memory");
            const unsigned og = xb_add(&bar[XB_TOP], 1u);
            const unsigned tg = og / nx;
            if (og + 1u == (tg + 1u) * nx) xb_add(&bar[XB_TOPGEN], 1u);
            else XB_SPIN(xb_ld(&bar[XB_TOPGEN]) == tg, bar);
            __builtin_amdgcn_fence(__ATOMIC_ACQUIRE, "agent");
            xb_add(&bar[XB_XGEN(b.x)], 1u);
            asm volatile("s_waitcnt vmcnt(0)" ::: "memory");
        } else {
            XB_SPIN(xb_ld(&bar[XB_XGEN(b.x)]) == gen, bar);
            __builtin_amdgcn_fence(__ATOMIC_ACQUIRE, "agent");
            asm volatile("s_waitcnt vmcnt(0)" ::: "memory");
        }
    }
    __syncthreads();
}

__device__ __forceinline__ bf16x8 cl_frag(const f32x4 c) { v4u u; u.x = cvt_pk_bf16(c[0], c[1]); u.y = cvt_pk_bf16(c[2], c[3]); u.z = 0u; u.w = 0u; return __builtin_bit_cast(bf16x8, u); }
__device__ __forceinline__ bf16x8 cl2_frag(const f32x4 a, const f32x4 b) { v4u u; u.x = cvt_pk_bf16(a[0], a[1]); u.y = cvt_pk_bf16(a[2], a[3]); u.z = cvt_pk_bf16(b[0], b[1]); u.w = cvt_pk_bf16(b[2], b[3]); return __builtin_bit_cast(bf16x8, u); }
__device__ __forceinline__ bf16x8 sel_frag(int c, int ks, int n, int q) {
    const int js = 16 * c + n - 32 * ks - 8 * q, d = js >> 1; const unsigned val = 0x3F80u << (16 * (js & 1));
    v4u u; u.x = d == 0 ? val : 0u; u.y = d == 1 ? val : 0u; u.z = d == 2 ? val : 0u; u.w = d == 3 ? val : 0u; return __builtin_bit_cast(bf16x8, u);
}
__device__ __forceinline__ unsigned char* chk_unit_ptr(unsigned char* ws, int u) {
    if (u < CHK_NA) return ws + WS_H + (size_t)u * CHK_UNIT;
    u -= CHK_NA; if (u < CHK_NB) return ws + WS_Y + (size_t)u * CHK_UNIT;
    u -= CHK_NB; if (u < CHK_NC) return ws + WS_CHKC + (size_t)u * CHK_UNIT;
    u -= CHK_NC; return ws + WS_WIN + (size_t)u * CHK_UNIT;
}
#define F4Z ((f32x4){0.f, 0.f, 0.f, 0.f})

struct Args { const float* in[N_IN]; float* out; unsigned char* ws; int ph_lo, ph_hi, dup, pad; };

__device__ __forceinline__ void transpose_item(const float* W, int N, bf16* WT, int ldt, int item, LAS float* scr, int lane) {
    const int nblk = N / 32, kb = item / nblk, nb = item % nblk, k0 = 64 * kb, n0 = 32 * nb;
#pragma unroll 8
    for (int i = 0; i < 32; ++i) { const int kk = 2 * i + (lane >> 5); scr[kk * 33 + (lane & 31)] = W[(size_t)(k0 + kk) * N + n0 + (lane & 31)]; }
    LDS_WAIT(); asm volatile("" ::: "memory");
    const int c = lane & 7;
#pragma unroll
    for (int j = 0; j < 4; ++j) { const int n = (lane >> 3) + 8 * j; const LAS float* s = scr + (8 * c) * 33 + n;
        v4u o; o.x = cvt_pk_bf16(s[0 * 33], s[1 * 33]); o.y = cvt_pk_bf16(s[2 * 33], s[3 * 33]); o.z = cvt_pk_bf16(s[4 * 33], s[5 * 33]); o.w = cvt_pk_bf16(s[6 * 33], s[7 * 33]);
        *(v4u*)(WT + (size_t)(n0 + n) * ldt + k0 + 8 * c) = o; }
    LDS_WAIT(); asm volatile("" ::: "memory");
}

__device__ __forceinline__ void load_xl8(const bf16* prow, const bf16* pprev, const float* mu, float (&o)[8]) {
    const v4u cu = *(const v4u*)prow, pu = *(const v4u*)pprev;
    const f32x4 m0 = *(const f32x4*)mu, m1 = *(const f32x4*)(mu + 4);
    const float cur[8] = {bf_lo(cu.x), bf_hi(cu.x), bf_lo(cu.y), bf_hi(cu.y), bf_lo(cu.z), bf_hi(cu.z), bf_lo(cu.w), bf_hi(cu.w)};
    const float pv[8] = {bf_lo(pu.x), bf_hi(pu.x), bf_lo(pu.y), bf_hi(pu.y), bf_lo(pu.z), bf_hi(pu.z), bf_lo(pu.w), bf_hi(pu.w)};
#pragma unroll
    for (int i = 0; i < 4; ++i) { o[i] = cur[i] + (pv[i] - cur[i]) * m0[i]; o[4 + i] = cur[4 + i] + (pv[4 + i] - cur[4 + i]) * m1[i]; }
}
__device__ __forceinline__ void load_xl4(const bf16* prow, const bf16* pprev, const float* mu, float (&o)[4]) {
    const v2u cu = *(const v2u*)prow, pu = *(const v2u*)pprev; const f32x4 m0 = *(const f32x4*)mu;
    const float cur[4] = {bf_lo(cu.x), bf_hi(cu.x), bf_lo(cu.y), bf_hi(cu.y)}, pv[4] = {bf_lo(pu.x), bf_hi(pu.x), bf_lo(pu.y), bf_hi(pu.y)};
#pragma unroll
    for (int i = 0; i < 4; ++i) o[i] = cur[i] + (pv[i] - cur[i]) * m0[i];
}
__device__ __forceinline__ bf16x8 pack8(const float (&f)[8]) {
    v4u u; u.x = cvt_pk_bf16(f[0], f[1]); u.y = cvt_pk_bf16(f[2], f[3]); u.z = cvt_pk_bf16(f[4], f[5]); u.w = cvt_pk_bf16(f[6], f[7]);
    return __builtin_bit_cast(bf16x8, u);
}
__device__ __forceinline__ v2u pack4(float a, float b, float c, float d) { v2u u; u.x = cvt_pk_bf16(a, b); u.y = cvt_pk_bf16(c, d); return u; }

__device__ __forceinline__ const float* arg_in(const Args& a, int i) { asm volatile("" : "+s"(i)); return a.in[i]; }
__global__ void __launch_bounds__(NTHR, 2) mk_fwd(Args args) {
    extern __shared__ __attribute__((aligned(16))) unsigned char lds_raw[];
    LAS unsigned char* lds = (LAS unsigned char*)lds_raw;
    const int G = gridDim.x, NGW = G * NWAVES;
#define PH_IDS() const int tid = launder_tid(wave_u), lane = tid & 63, wave = __builtin_amdgcn_readfirstlane(tid >> 6), gw = blockIdx.x * NWAVES + wave; LAS float* scr = (LAS float*)(lds + wave * 16384); (void)lane; (void)gw; (void)scr
    unsigned* ctl = (unsigned*)(args.ws + WS_CTL);
    volatile LAS unsigned* MISC = (volatile LAS unsigned*)(lds + MISC_OFF);
    const int wave_u = __builtin_amdgcn_readfirstlane((int)threadIdx.x >> 6);
    for (int u = wave_u * 64 + lane_id_(); u < (LDS_BYTES - LDSCTL_OFF) / 4; u += NTHR) ((LAS unsigned*)(lds + LDSCTL_OFF))[u] = 0u;
    __syncthreads();
    const int lo = args.ph_lo, hi = args.ph_hi;
    XcdBarrier bar; bar.bar = ctl + CW_BAR; bar.x = 0; bar.st = nullptr;
    if (hi - lo > 1) bar = xcd_barrier_post(ctl + CW_BAR, MISC + 8, wave_u);
#define IN(k) (lo <= (k) && (k) < hi)
#define SEAM(k) do { if (IN(k) && IN((k) + 1)) xcd_barrier(bar, wave_u); } while (0)
#define SAMPLE_TILES(Abuf, Btp, N_, K_, E_, nbig) do { const int nt_ = 16 * ((N_) / 64), rem_ = (nbig) % G; int first_ = 0, cnt_ = G; if (rem_ > 0 && rem_ <= G / 2) { first_ = rem_; cnt_ = G - rem_; } \
        if ((int)blockIdx.x >= first_) sgemm_tiles(lds, Abuf, Btp, N_, K_, E_, (int)blockIdx.x - first_, cnt_, nt_, wave_u); } while (0)

#define PH_PTRS() unsigned char* ws = args.ws; float* out = args.out; int l = L_; asm volatile("" : "+s"(ws), "+s"(out), "+s"(l)); (void)l; \
    float* X = out + O_Y; \
    float* MOD = (float*)(ws + WS_MOD); \
    bf16* SC = (bf16*)(ws + WS_SC); \
    bf16* H = (bf16*)(ws + WS_H); \
    bf16* P = (bf16*)(ws + WS_P); \
    bf16* Rb = (bf16*)(ws + WS_R); bf16* K2b = (bf16*)(ws + WS_K2); bf16* Vb = (bf16*)(ws + WS_V); bf16* KKb = (bf16*)(ws + WS_KK); bf16* Bb = (bf16*)(ws + WS_B); \
    float* Wd = (float*)(ws + WS_W); \
    bf16* ORP = (bf16*)(ws + WS_ORP); bf16* Gb = (bf16*)(ws + WS_G); bf16* VF = (bf16*)(ws + WS_VF); \
    float* Y = (float*)(ws + WS_Y); \
    bf16* WIN_T = (bf16*)(ws + WS_WIN); bf16* WBR_T = (bf16*)(ws + WS_WBR); bf16* WOUT_T = (bf16*)(ws + WS_WOUT); bf16* WFF1_T = (bf16*)(ws + WS_WFF1); bf16* WFF2_T = (bf16*)(ws + WS_WFF2); \
    bf16* WLORA_T = (bf16*)(ws + WS_WSM + SM_LORA); bf16* WPOOL_T = (bf16*)(ws + WS_WSM + SM_POOL); bf16* V12_T = (bf16*)(ws + WS_WSM + SM_V12); \
    bf16* POOLED = (bf16*)(ws + WS_POOLED); bf16* XA = (bf16*)(ws + WS_XA); \
    bf16* ADA_T = P; \
    (void)X; (void)MOD; (void)SC; (void)H; (void)P; (void)Rb; (void)K2b; (void)Vb; (void)KKb; (void)Bb; (void)Wd; (void)ORP; (void)Gb; (void)VF; (void)Y; (void)WIN_T; (void)WBR_T; (void)WOUT_T; (void)WFF1_T; (void)WFF2_T; (void)WLORA_T; (void)WPOOL_T; (void)V12_T; (void)POOLED; (void)XA; (void)ADA_T
#define ARG(i) arg_in(args, (i))
    int ph = 0, L_ = 0;
    if (IN(ph)) for (int rep_ = 0; rep_ < DUPN(10); ++rep_) { PH_PTRS(); PH_IDS();
        constexpr int I_ADA = (D / 64) * (3072 / 32);
        for (int it = gw; it < 8 * I_ADA; it += NGW) { const int mat = it / I_ADA, r = it % I_ADA, l = mat >> 1, which = mat & 1;
            const float* W = (which ? ARG(I_WADAMLP) : ARG(I_WADAMIX)) + (size_t)l * D * 3072;
            transpose_item(W, 3072, ADA_T + (size_t)mat * 3072 * D, D, r, scr, lane); }
        for (int r = gw; r < 256; r += NGW) {
            const float* c = r < NSEQ_P ? ARG(I_CP) + (size_t)r * D : ARG(I_CS) + (size_t)(r - NSEQ_P) * D;
#pragma unroll
            for (int j = 0; j < 4; ++j) { f32x4 v = (f32x4){0.f, 0.f, 0.f, 0.f}; if (r < NSEQ) v = *(const f32x4*)(c + 4 * lane + 256 * j);
#pragma unroll
                for (int i = 0; i < 4; ++i) v[i] = v[i] * sigmoidf_(v[i]);
                *(v2u*)(SC + (size_t)r * D + 4 * lane + 256 * j) = pack4(v[0], v[1], v[2], v[3]); } }
        for (int m = gw; m < M; m += NGW) {
            const float* src = m < MP ? ARG(I_XP) + (size_t)m * D : ARG(I_XS) + (size_t)(m - MP) * D;
#pragma unroll
            for (int j = 0; j < 4; ++j) *(f32x4*)(X + (size_t)m * D + 4 * lane + 256 * j) = *(const f32x4*)(src + 4 * lane + 256 * j); }
    }
    SEAM(ph); ++ph;
    if (IN(ph)) for (int rep_ = 0; rep_ < DUPN(11); ++rep_) { PH_PTRS();
        pg8::Gemm g{SC, ADA_T, 256, MODW, D}; pg8::StaticOrder S; S.init(256, MODW, G, (int)blockIdx.x);
        EpiMod E{0, MOD, ARG(I_BADAMIX), ARG(I_BADAMLP)};
        pg8::gemm_phase<EpiMod, pg8::StaticOrder, true, true>(lds, g, S, E, wave_u);
    }
    SEAM(ph); ++ph;

    for (L_ = 0; L_ < DEPTH; ++L_) {
#define modmix (MOD + (size_t)(2 * l) * 3072)
#define modmlp (MOD + (size_t)(2 * l + 1) * 3072)
        if (IN(ph)) for (int rep_ = 0; rep_ < DUPN(0); ++rep_) { PH_PTRS(); PH_IDS();
            constexpr int N_IN_ = (D / 64) * (IN_COLS / 32), N_BR = (MIX / 64) * (D / 32), N_OUT = (D / 64) * (D / 32), N_F1 = (D / 64) * (DFF / 32), N_F2 = (DFF / 64) * (D / 32);
            constexpr int TOT = N_IN_ + 2 * N_BR + N_OUT + N_F1 + N_F2;
            for (int it = gw; it < TOT; it += NGW) { int r = it;
                if (r < N_IN_) { transpose_item(ARG(I_WIN) + (size_t)l * D * IN_COLS, IN_COLS, WIN_T, D, r, scr, lane); continue; } r -= N_IN_;
                if (r < N_BR) { transpose_item(ARG(I_WBRR) + (size_t)l * MIX * D, D, WBR_T, D, r, scr, lane); continue; } r -= N_BR;
                if (r < N_BR) { transpose_item(ARG(I_WBRP) + (size_t)l * POOLW * D, D, WBR_T + MIX, D, r, scr, lane); continue; } r -= N_BR;
                if (r < N_OUT) { transpose_item(ARG(I_WOUT) + (size_t)l * D * D, D, WOUT_T, D, r, scr, lane); continue; } r -= N_OUT;
                if (r < N_F1) { transpose_item(ARG(I_WFF1) + (size_t)l * D * DFF, DFF, WFF1_T, D, r, scr, lane); continue; } r -= N_F1;
                transpose_item(ARG(I_WFF2) + (size_t)l * DFF * D, D, WFF2_T, DFF, r, scr, lane);
            }
            {
                const float* w2 = ARG(I_W2) + (size_t)l * 64 * MIX; const float* a2 = ARG(I_A2) + (size_t)l * 64 * MIX; const float* g2 = ARG(I_G2) + (size_t)l * 128 * MIX;
                const float* pw = ARG(I_POOLW) + (size_t)l * 4 * PGRP * PGRP;
                const int gt = blockIdx.x * NTHR + tid, GT = G * NTHR;
                for (int e = gt; e < 1536 * 256; e += GT) { const int n = e >> 8, k = e & 255, ty = n >> 9, nn = n & 511; float v = 0.f;
                    if (ty == 0) { if (k < 64) v = w2[(size_t)k * MIX + nn]; } else if (ty == 1) { if (k >= 64 && k < 128) v = a2[(size_t)(k - 64) * MIX + nn]; } else { if (k >= 128) v = g2[(size_t)(k - 128) * MIX + nn]; }
                    WLORA_T[e] = (bf16)(cvt_pk_bf16(v, 0.f) & 0xffffu); }
                for (int e = gt; e < 512 * 512; e += GT) { const int d = e >> 9, k = e & 511, g = d >> 7; float v = 0.f;
                    if ((k >> 7) == g) v = pw[((size_t)g * PGRP + (k & 127)) * PGRP + (d & 127)];
                    WPOOL_T[e] = (bf16)(cvt_pk_bf16(v, 0.f) & 0xffffu); }
                if (l > 0) { const float* v1 = ARG(I_V1) + (size_t)(l - 1) * MIX * 32; const float* v2 = ARG(I_V2) + (size_t)(l - 1) * 32 * MIX;
                    for (int e = gt; e < 512 * 512; e += GT) { const int n = e >> 9, k = e & 511; float acc = 0.f;
#pragma unroll 8
                        for (int j = 0; j < 32; ++j) acc += v1[(size_t)k * 32 + j] * v2[(size_t)j * MIX + n];
                        V12_T[e] = (bf16)(cvt_pk_bf16(acc, 0.f) & 0xffffu); } }
            }
            {
                bf16* SH0 = (bf16*)(ws + WS_SH0); bf16* PH0 = (bf16*)(ws + WS_PH0);
                const float* ss = ARG(I_SSHIFT) + (size_t)l * NSEQ_S * RWKV_COLS; const float* sp = ARG(I_SPOOL) + (size_t)l * NSEQ_S * PBUF * POOLW;
                for (int e = blockIdx.x * NTHR + tid; e < NSEQ * RWKV_COLS / 2; e += G * NTHR) { const int e2 = 2 * e - NSEQ_P * RWKV_COLS;
                    *(unsigned*)(SH0 + 2 * e) = e2 >= 0 ? cvt_pk_bf16(ss[e2], ss[e2 + 1]) : 0u; }
                for (int e = blockIdx.x * NTHR + tid; e < NSEQ * PBUF * POOLW / 2; e += G * NTHR) { const int e2 = 2 * e - NSEQ_P * PBUF * POOLW;
                    *(unsigned*)(PH0 + 2 * e) = e2 >= 0 ? cvt_pk_bf16(sp[e2], sp[e2 + 1]) : 0u; }
            }
            const float* nw = ARG(I_NORMMIX) + (size_t)l * D;
            for (int m = gw; m < M; m += NGW) {
                const float* xr = X + (size_t)m * D; const float* mo = modmix + (size_t)row_seq(m) * MODW;
                f32x4 v[4]; float s = 0.f;
#pragma unroll
                for (int j = 0; j < 4; ++j) { v[j] = *(const f32x4*)(xr + 4 * lane + 256 * j); s += (v[j][0] * v[j][0] + v[j][1] * v[j][1]) + (v[j][2] * v[j][2] + v[j][3] * v[j][3]); }
                const float rstd = 1.0f / sqrtf(wave_sum(s) * (1.0f / D) + 1e-6f);
#pragma unroll
                for (int j = 0; j < 4; ++j) { const int c = 4 * lane + 256 * j; const f32x4 g = *(const f32x4*)(nw + c), sh = *(const f32x4*)(mo + c), sc = *(const f32x4*)(mo + 1024 + c);
                    f32x4 o;
#pragma unroll
                    for (int i = 0; i < 4; ++i) o[i] = v[j][i] * rstd * g[i] * (1.0f + sc[i]) + sh[i];
                    *(v2u*)(H + (size_t)m * D + c) = pack4(o[0], o[1], o[2], o[3]); }
            }
        }
        SEAM(ph); ++ph;
        if (IN(ph)) for (int rep_ = 0; rep_ < DUPN(1); ++rep_) { PH_PTRS();
            pg8::Gemm g{H, WIN_T, MP, IN_COLS, D}; pg8::StaticOrder S; S.init(MP, IN_COLS, G, (int)blockIdx.x);
            EpiStoreBf16 E{0, P, IN_COLS, 0};
            pg8::gemm_phase<EpiStoreBf16, pg8::StaticOrder, true, true>(lds, g, S, E, wave_u);
            SAMPLE_TILES(H, WIN_T, IN_COLS, D, E, (MP / 256) * (IN_COLS / 256));
        }
        SEAM(ph); ++ph;
        if (IN(ph)) for (int rep_ = 0; rep_ < DUPN(2); ++rep_) { PH_PTRS(); PH_IDS();
            const float* spool = ARG(I_SPOOL) + (size_t)l * NSEQ_S * PBUF * POOLW; const float* mu = ARG(I_MU) + (size_t)l * RWKV_COLS; const float* kkw = ARG(I_KK) + (size_t)l * MIX;
            const bf16* SH0 = (const bf16*)(ws + WS_SH0); const bf16* PH0 = (const bf16*)(ws + WS_PH0);
            for (int idx = blockIdx.x * NTHR + tid; idx < NSEQ * (RWKV_COLS / 4 + PBUF * POOLW / 4); idx += G * NTHR) {
                if (idx < NSEQ * (RWKV_COLS / 4)) {
                    const int seq = idx / (RWKV_COLS / 4), c = 4 * (idx % (RWKV_COLS / 4));
                    const int mlast = seq < NSEQ_P ? seq * T_P + T_P - 1 : MP + (seq - NSEQ_P) * T_S + T_S - 1;
                    const v2u u = *(const v2u*)(P + (size_t)mlast * IN_COLS + c);
                    float* so = seq < NSEQ_P ? out + O_SHP + ((size_t)l * NSEQ_P + seq) * RWKV_COLS + c : out + O_SHS + ((size_t)l * NSEQ_S + (seq - NSEQ_P)) * RWKV_COLS + c;
                    *(f32x4*)so = (f32x4){bf_lo(u.x), bf_hi(u.x), bf_lo(u.y), bf_hi(u.y)};
                } else {
                    const int r = idx - NSEQ * (RWKV_COLS / 4), seq = r / (PBUF * POOLW / 4), rem = r % (PBUF * POOLW / 4), i = rem / (POOLW / 4), c = 4 * (rem % (POOLW / 4));
                    f32x4 v;
                    if (seq >= NSEQ_P && i < 7) v = *(const f32x4*)(spool + ((size_t)(seq - NSEQ_P) * PBUF + 8 + i) * POOLW + c);
                    else { const int row = seq < NSEQ_P ? seq * T_P + T_P - 15 + i : MP + (seq - NSEQ_P) * T_S + i - 7;
                        const v2u u = *(const v2u*)(P + (size_t)row * IN_COLS + C_PP + c); v = (f32x4){bf_lo(u.x), bf_hi(u.x), bf_lo(u.y), bf_hi(u.y)}; }
                    float* po = seq < NSEQ_P ? out + O_POP + (((size_t)l * NSEQ_P + seq) * PBUF + i) * POOLW + c : out + O_POS + (((size_t)l * NSEQ_S + (seq - NSEQ_P)) * PBUF + i) * POOLW + c;
                    *(f32x4*)po = v;
                }
            }
            for (int m = gw; m < M; m += NGW) {
                const int seq = row_seq(m), t = row_t(m);
                const bf16* prow = P + (size_t)m * IN_COLS; const bf16* pprev = t > 0 ? prow - IN_COLS : SH0 + (size_t)seq * RWKV_COLS;
                const int c8 = 8 * lane; const size_t o = (size_t)m * MIX + c8;
                float xr[8], xk[8], xv[8];
                load_xl8(prow + C_R + c8, pprev + C_R + c8, mu + C_R + c8, xr);
                load_xl8(prow + C_K + c8, pprev + C_K + c8, mu + C_K + c8, xk);
                load_xl8(prow + C_V + c8, pprev + C_V + c8, mu + C_V + c8, xv);
                *(v4u*)(Rb + o) = pack8u(xr); *(v4u*)(H + (size_t)M * MIX + o) = pack8u(xk);
                { const v4u pv = pack8u(xv); if (l == 0) { *(v4u*)(Vb + o) = pv; *(v4u*)(VF + o) = pv; } else *(v4u*)(H + o) = pv; }
                { const f32x4 w0_ = *(const f32x4*)(kkw + c8), w1_ = *(const f32x4*)(kkw + c8 + 4); float kk[8]; float ss = 0.f;
#pragma unroll
                  for (int j = 0; j < 8; ++j) { kk[j] = xk[j] * (j < 4 ? w0_[j & 3] : w1_[j & 3]); ss += kk[j] * kk[j]; }
                  ss = row8_sum(ss);
                  const float rn = 1.0f / sqrtf(ss + 1e-12f);
#pragma unroll
                  for (int j = 0; j < 8; ++j) kk[j] *= rn;
                  *(v4u*)(KKb + o) = pack8u(kk); }
                if (lane < 32) { float xx[8]; load_xl8(prow + C_XW + c8, pprev + C_XW + c8, mu + C_XW + c8, xx);
#pragma unroll
                    for (int j = 0; j < 8; ++j) xx[j] = lane < 8 ? tanhf_(xx[j]) : (lane < 16 ? xx[j] : sigmoidf_(xx[j]));
                    *(v4u*)(XA + (size_t)m * 256 + c8) = pack8u(xx); }
                { const int win = 2 << (lane >> 4); float sum[8], cur[8];
                  unpack8(*(const v4u*)(prow + C_PP + c8), cur);
#pragma unroll
                  for (int j = 0; j < 8; ++j) sum[j] = cur[j];
#pragma unroll 5
                  for (int i = 1; i < 16; ++i) { if (i < win) { const int tt = t - i;
                      const bf16* src = tt >= 0 ? prow - (size_t)i * IN_COLS + C_PP + c8 : PH0 + ((size_t)seq * PBUF + (PBUF + tt)) * POOLW + c8;
                      float x[8]; unpack8(*(const v4u*)src, x);
#pragma unroll
                      for (int j = 0; j < 8; ++j) sum[j] += x[j]; } }
                  const float inv = 1.0f / (float)((seq < NSEQ_P && t + 1 < win) ? t + 1 : win);
#pragma unroll
                  for (int j = 0; j < 8; ++j) sum[j] = sum[j] * inv - cur[j];
                  *(v4u*)(POOLED + o) = pack8u(sum); }
            }
        }
        SEAM(ph); ++ph;
        if (IN(ph)) for (int rep_ = 0; rep_ < DUPN(13); ++rep_) { PH_PTRS();
            { pg8::Gemm g{XA, WLORA_T, M, 1536, 256}; pg8::StaticOrder S; S.init(M, 1536, G, (int)blockIdx.x);
              EpiLora E{0, Wd, H + (size_t)M * MIX, K2b, KKb, Bb, Gb, ARG(I_W0) + (size_t)l * MIX, ARG(I_A0) + (size_t)l * MIX, ARG(I_KA) + (size_t)l * MIX};
              pg8::gemm_phase<EpiLora, pg8::StaticOrder, true, true>(lds, g, S, E, wave_u); }
            { pg8::Gemm g{POOLED, WPOOL_T, M, 512, 512}; pg8::StaticOrder S; S.init(M, 512, G, (int)((blockIdx.x + 104) % G));
              EpiPool E{0, ORP, ARG(I_POOLS) + (size_t)l * POOLW};
              pg8::gemm_phase<EpiPool, pg8::StaticOrder, true, true>(lds, g, S, E, wave_u); }
            if (l > 0) { pg8::Gemm g{H, V12_T, M, 512, 512}; pg8::StaticOrder S; S.init(M, 512, G, (int)((blockIdx.x + 224) % G));
              EpiVmix E{0, H, Vb, VF, ARG(I_V0) + (size_t)(l - 1) * MIX};
              pg8::gemm_phase<EpiVmix, pg8::StaticOrder, true, true>(lds, g, S, E, wave_u); }
        }
        SEAM(ph); ++ph;
        if (IN(ph)) for (int rep_ = 0; rep_ < DUPN(14); ++rep_) { PH_PTRS(); PH_IDS();
            for (int u = gw; u < NSEQ_P * NH * (T_P / 16); u += NGW) {
                const int ln = lane_fresh(), n = ln & 15, q = ln >> 4;
                const int seq = u >> 10, hd = (u >> 7) & 7, chn = u & 127;
                const size_t o0 = (size_t)(seq * T_P + chn * 16 + n) * MIX + 64 * hd + 8 * q;
                unsigned char* ub = chk_unit_ptr(ws, u);
                bf16x8 At[2], Rt[2], Bt[2], Kt[2], Bh[2], Kh[2], Vf[2];
#pragma unroll
                for (int ks = 0; ks < 2; ++ks) { const size_t o = o0 + 32 * ks;
                    const f32x4 w0_ = *(const f32x4*)(Wd + o), w1_ = *(const f32x4*)(Wd + o + 4);
                    float kk[8], bb[8], kx[8], rr[8]; unpack8(*(const v4u*)(KKb + o), kk); unpack8(*(const v4u*)(Bb + o), bb); unpack8(*(const v4u*)(K2b + o), kx); unpack8(*(const v4u*)(Rb + o), rr);
                    Vf[ks] = *(const bf16x8*)(Vb + o);
                    float a_[8], r_[8], b_[8], k_[8], bh_[8], kh_[8], gm[8];
#pragma unroll
                    for (int j = 0; j < 8; ++j) { const float lw = __logf(j < 4 ? w0_[j & 3] : w1_[j & 3]);
                        float L = lw; L += dpp_f<0x111>(L); L += dpp_f<0x112>(L); L += dpp_f<0x114>(L); L += dpp_f<0x118>(L);
                        const float Lp = dpp_f<0x111>(L), Le = row16_sum(lw);
                        const float eP = __expf(Lp), eC = __expf(L), eI = __expf(-L), eE = __expf(Le - L);
                        a_[j] = -kk[j] * eP; r_[j] = rr[j] * eC; b_[j] = bb[j] * eI; k_[j] = kx[j] * eI; bh_[j] = bb[j] * eE; kh_[j] = kx[j] * eE; gm[j] = __expf(Le); }
                    At[ks] = pack8(a_); Rt[ks] = pack8(r_); Bt[ks] = pack8(b_); Kt[ks] = pack8(k_); Bh[ks] = pack8(bh_); Kh[ks] = pack8(kh_);
                    if (n == 0) { *(f32x4*)(ub + 12288 + (32 * ks + 8 * q) * 4) = (f32x4){gm[0], gm[1], gm[2], gm[3]}; *(f32x4*)(ub + 12288 + (32 * ks + 8 * q + 4) * 4) = (f32x4){gm[4], gm[5], gm[6], gm[7]}; } }
                __builtin_amdgcn_sched_barrier(0);
                f32x4 Aab_cl = F4Z, Aab_op = F4Z, Aak_op = F4Z, Arb_op = F4Z, Ark_op = F4Z;
#pragma unroll
                for (int ks = 0; ks < 2; ++ks) { Aab_cl = MFMA16(At[ks], Bt[ks], Aab_cl); Aab_op = MFMA16(Bt[ks], At[ks], Aab_op); Aak_op = MFMA16(Kt[ks], At[ks], Aak_op);
                    Arb_op = MFMA16(Bt[ks], Rt[ks], Arb_op); Ark_op = MFMA16(Kt[ks], Rt[ks], Ark_op); }
#pragma unroll
                for (int r = 0; r < 4; ++r) { const int e = 4 * q + r;
                    if (!(n < e)) Aab_cl[r] = 0.f;
                    if (!(e < n)) { Aab_op[r] = 0.f; Aak_op[r] = 0.f; }
                    if (!(e <= n)) { Arb_op[r] = 0.f; Ark_op[r] = 0.f; } }
                f32x4 Zw[4], Zu[4], Vc[4];
#pragma unroll
                for (int c = 0; c < 4; ++c) { const bf16x8 s0 = sel_frag(c, 0, n, q), s1 = sel_frag(c, 1, n, q);
                    Zw[c] = MFMA16(At[1], s1, MFMA16(At[0], s0, F4Z)); Vc[c] = MFMA16(Vf[1], s1, MFMA16(Vf[0], s0, F4Z)); }
#pragma unroll
                for (int p = 0; p < 2; ++p) { f32x4 t0, t1;
                    { const bf16x8 s0 = sel_frag(2 * p, 0, n, q), s1 = sel_frag(2 * p, 1, n, q), s2 = sel_frag(2 * p + 1, 0, n, q), s3 = sel_frag(2 * p + 1, 1, n, q);
                      t0 = MFMA16(Bh[1], s1, MFMA16(Bh[0], s0, F4Z)); t1 = MFMA16(Bh[1], s3, MFMA16(Bh[0], s2, F4Z)); *(bf16x8*)(ub + (2 + p) * 1024 + ln * 16) = cl2_frag(t0, t1);
                      t0 = MFMA16(Kh[1], s1, MFMA16(Kh[0], s0, F4Z)); t1 = MFMA16(Kh[1], s3, MFMA16(Kh[0], s2, F4Z)); *(bf16x8*)(ub + (4 + p) * 1024 + ln * 16) = cl2_frag(t0, t1); } }
                { const bf16x8 ak = cl_frag(Aak_op);
#pragma unroll
                  for (int vt = 0; vt < 4; ++vt) Zu[vt] = MFMA16(ak, cl_frag(Vc[vt]), F4Z); }
                { f32x4 P1o = Aab_op, P1c = Aab_cl;
                  const f32x4 P2o = MFMA16(cl_frag(P1c), cl_frag(P1o), F4Z), P2c = MFMA16(cl_frag(P1o), cl_frag(P1c), F4Z);
                  const f32x4 P4o = MFMA16(cl_frag(P2c), cl_frag(P2o), F4Z), P4c = MFMA16(cl_frag(P2o), cl_frag(P2c), F4Z);
                  const f32x4 P8o = MFMA16(cl_frag(P4c), cl_frag(P4o), F4Z);
                  const bf16x8 f8 = cl_frag(P8o), f4 = cl_frag(P4o), f2 = cl_frag(P2o), f1 = cl_frag(P1o);
#pragma unroll
                  for (int c = 0; c < 4; ++c) { Zw[c] = MFMA16(f8, cl_frag(Zw[c]), Zw[c]); Zu[c] = MFMA16(f8, cl_frag(Zu[c]), Zu[c]); }
#pragma unroll
                  for (int c = 0; c < 4; ++c) { Zw[c] = MFMA16(f4, cl_frag(Zw[c]), Zw[c]); Zu[c] = MFMA16(f4, cl_frag(Zu[c]), Zu[c]); }
#pragma unroll
                  for (int c = 0; c < 4; ++c) { Zw[c] = MFMA16(f2, cl_frag(Zw[c]), Zw[c]); Zu[c] = MFMA16(f2, cl_frag(Zu[c]), Zu[c]); }
#pragma unroll
                  for (int c = 0; c < 4; ++c) { Zw[c] = MFMA16(f1, cl_frag(Zw[c]), Zw[c]); Zu[c] = MFMA16(f1, cl_frag(Zu[c]), Zu[c]); } }
                *(bf16x8*)(ub + 0 * 1024 + ln * 16) = cl2_frag(Zw[0], Zw[1]); *(bf16x8*)(ub + 1 * 1024 + ln * 16) = cl2_frag(Zw[2], Zw[3]);
                *(bf16x8*)(ub + 6 * 1024 + ln * 16) = cl2_frag(Zu[0], Zu[1]); *(bf16x8*)(ub + 7 * 1024 + ln * 16) = cl2_frag(Zu[2], Zu[3]);
                { const bf16x8 rb = cl_frag(Arb_op); f32x4 qT[4];
#pragma unroll
                  for (int c = 0; c < 4; ++c) qT[c] = MFMA16(cl_frag(Zw[c]), rb, MFMA16(sel_frag(c, 1, n, q), Rt[1], MFMA16(sel_frag(c, 0, n, q), Rt[0], F4Z)));
                  *(bf16x8*)(ub + 8 * 1024 + ln * 16) = cl2_frag(qT[0], qT[1]); *(bf16x8*)(ub + 9 * 1024 + ln * 16) = cl2_frag(qT[2], qT[3]); }
                { const bf16x8 rbk = cl2_frag(Arb_op, Ark_op); f32x4 y0[4];
#pragma unroll
                  for (int vt = 0; vt < 4; ++vt) y0[vt] = MFMA16(rbk, cl2_frag(Zu[vt], Vc[vt]), F4Z);
                  *(bf16x8*)(ub + 10 * 1024 + ln * 16) = cl2_frag(y0[0], y0[1]); *(bf16x8*)(ub + 11 * 1024 + ln * 16) = cl2_frag(y0[2], y0[3]); }
            }
        }
        SEAM(ph); ++ph;
#define S2_PROMPT_HEAD() do { \
            const int seq = (int)blockIdx.x >> 3, hd = (int)blockIdx.x & 7, ln = lane_fresh(), n = ln & 15, q = ln >> 4; \
            constexpr int RD = 9, RAW = 14592, READY_OFF = RD * RAW, READY = 8192, NCH = T_P / 16; \
            const int ubase = (seq * NH + hd) * NCH; const int mb = seq * T_P; \
            if (wave >= 4) { const int hh = wave - 4; \
                _Pragma("unroll") for (int c_ = 0; c_ < RD - 1; ++c_) S2_ISSUE(c_); \
                if (hh < 3) asm volatile("s_waitcnt vmcnt(24)" ::: "memory"); else asm volatile("s_waitcnt vmcnt(18)" ::: "memory");        \
                __builtin_amdgcn_s_barrier(); \
                S2_BUILD(0); asm volatile("s_waitcnt lgkmcnt(0)" ::: "memory"); __builtin_amdgcn_s_barrier(); \
                for (int c = 0; c < NCH; ++c) { \
                    if (c + RD - 1 < NCH) S2_ISSUE(c + RD - 1); \
                    if (c + 1 < NCH) S2_BUILD(c + 1); \
                      \
                    if (c + RD - 1 < NCH) { if (hh < 3) asm volatile("s_waitcnt vmcnt(24) lgkmcnt(0)" ::: "memory"); else asm volatile("s_waitcnt vmcnt(18) lgkmcnt(0)" ::: "memory"); } \
                    else asm volatile("s_waitcnt vmcnt(0) lgkmcnt(0)" ::: "memory"); \
                    __builtin_amdgcn_s_barrier(); } \
            } else { const int vq = wave; \
                f32x4 S0 = F4Z, S1 = F4Z, S2_ = F4Z, S3 = F4Z; \
                __builtin_amdgcn_s_barrier(); __builtin_amdgcn_s_barrier(); \
                float* yg = Wd + (size_t)mb * MIX + 64 * hd + 16 * vq + n;                       \
                const bf16x8 sl0 = sel_frag(vq, 0, n, q), sl1 = sel_frag(vq, 1, n, q); \
                for (int c = 0; c < NCH; ++c) { \
                    const LAS unsigned char* raw = lds + (c % RD) * RAW; const LAS unsigned char* rdy = lds + READY_OFF + (c & 1) * READY; \
                    const bf16x8 sf0 = cl2_frag(S0, S1), sf1 = cl2_frag(S2_, S3); \
                      \
                    const f32x4 vc_ = MFMA16(*(const LAS bf16x8*)(raw + 13 * 1024 + ln * 16), sl1, MFMA16(*(const LAS bf16x8*)(raw + 12 * 1024 + ln * 16), sl0, F4Z)); \
                    const v2u u0h = *(const LAS v2u*)(raw + (6 + (vq >> 1)) * 1024 + ln * 16 + 8 * (vq & 1)); \
                    v4u uv; uv.x = u0h.x; uv.y = u0h.y; uv.z = cvt_pk_bf16(vc_[0], vc_[1]); uv.w = cvt_pk_bf16(vc_[2], vc_[3]); const bf16x8 uvf = __builtin_bit_cast(bf16x8, uv); \
                    const v4u b01 = *(const LAS v4u*)(raw + 2 * 1024 + ln * 16), b23 = *(const LAS v4u*)(raw + 3 * 1024 + ln * 16), k01 = *(const LAS v4u*)(raw + 4 * 1024 + ln * 16), k23 = *(const LAS v4u*)(raw + 5 * 1024 + ln * 16); \
                    v4u bk; bk.x = b01.x; bk.y = b01.y; bk.z = k01.x; bk.w = k01.y; const f32x4 n0_ = MFMA16(__builtin_bit_cast(bf16x8, bk), uvf, F4Z); \
                    bk.x = b01.z; bk.y = b01.w; bk.z = k01.z; bk.w = k01.w; const f32x4 n1_ = MFMA16(__builtin_bit_cast(bf16x8, bk), uvf, F4Z); \
                    bk.x = b23.x; bk.y = b23.y; bk.z = k23.x; bk.w = k23.y; const f32x4 n2_ = MFMA16(__builtin_bit_cast(bf16x8, bk), uvf, F4Z); \
                    bk.x = b23.z; bk.y = b23.w; bk.z = k23.z; bk.w = k23.w; const f32x4 n3_ = MFMA16(__builtin_bit_cast(bf16x8, bk), uvf, F4Z); \
                    { const v2u yu = *(const LAS v2u*)(raw + (10 + (vq >> 1)) * 1024 + ln * 16 + 8 * (vq & 1)); f32x4 ya = (f32x4){bf_lo(yu.x), bf_hi(yu.x), bf_lo(yu.y), bf_hi(yu.y)}; \
                      ya = MFMA16(*(const LAS bf16x8*)(raw + 8 * 1024 + ln * 16), sf0, ya); ya = MFMA16(*(const LAS bf16x8*)(raw + 9 * 1024 + ln * 16), sf1, ya); \
                      _Pragma("unroll") for (int r = 0; r < 4; ++r) yg[(size_t)(c * 16 + 4 * q + r) * MIX] = ya[r]; } \
                    const LAS float* gm = (const LAS float*)(raw + 14336); \
                    S2_UPD(S0, 0, n0_); S2_UPD(S1, 1, n1_); S2_UPD(S2_, 2, n2_); S2_UPD(S3, 3, n3_); \
                    asm volatile("s_waitcnt lgkmcnt(0)" ::: "memory"); __builtin_amdgcn_s_barrier(); } \
                float* so = out + O_WKP + ((((size_t)l * NSEQ_P + seq) * NH + hd) * HS + 16 * vq + n) * HS + 4 * q; \
                *(f32x4*)so = S0; *(f32x4*)(so + 16) = S1; *(f32x4*)(so + 32) = S2_; *(f32x4*)(so + 48) = S3; \
            } \
            __syncthreads(); } while (0)
#define S2_ISSUE(c) do { const unsigned char* ub_ = chk_unit_ptr(ws, ubase + (c)); LAS unsigned char* slot_ = lds + ((c) % RD) * RAW; \
            _Pragma("unroll") for (int p_ = 0; p_ < 3; ++p_) __builtin_amdgcn_global_load_lds((const unsigned*)(ub_ + (hh + 4 * p_) * 1024 + ln * 16), (LAS unsigned*)(slot_ + (hh + 4 * p_) * 1024), 16, 0, 0); \
            if (hh < 2) __builtin_amdgcn_global_load_lds((const unsigned*)(Vb + (size_t)(mb + (c) * 16 + n) * MIX + 64 * hd + 32 * hh + 8 * q), (LAS unsigned*)(slot_ + (12 + hh) * 1024), 16, 0, 0); \
            if (hh == 2) __builtin_amdgcn_global_load_lds((const unsigned*)(ub_ + 12288 + ln * 4), (LAS unsigned*)(slot_ + 14336), 4, 0, 0); } while (0)
#define S2_BUILD(c) do { const LAS unsigned char* raw_ = lds + ((c) % RD) * RAW; LAS unsigned char* rdy_ = lds + READY_OFF + ((c) & 1) * READY; \
            const v4u w01 = *(const LAS v4u*)(raw_ + 0 * 1024 + ln * 16), w23 = *(const LAS v4u*)(raw_ + 1 * 1024 + ln * 16); \
            const v2u bhh = *(const LAS v2u*)(raw_ + (2 + (hh >> 1)) * 1024 + ln * 16 + 8 * (hh & 1)); \
            v4u bhf; bhf.x = bhh.x; bhf.y = bhh.y; bhf.z = 0u; bhf.w = 0u; const bf16x8 bh_ = __builtin_bit_cast(bf16x8, bhf); \
            v4u t_; t_.z = 0u; t_.w = 0u; \
            t_.x = w01.x; t_.y = w01.y; const f32x4 m0_ = MFMA16(__builtin_bit_cast(bf16x8, t_), bh_, F4Z); t_.x = w01.z; t_.y = w01.w; const f32x4 m1_ = MFMA16(__builtin_bit_cast(bf16x8, t_), bh_, F4Z); \
            t_.x = w23.x; t_.y = w23.y; const f32x4 m2_ = MFMA16(__builtin_bit_cast(bf16x8, t_), bh_, F4Z); t_.x = w23.z; t_.y = w23.w; const f32x4 m3_ = MFMA16(__builtin_bit_cast(bf16x8, t_), bh_, F4Z); \
            *(LAS bf16x8*)(rdy_ + (hh * 2 + 0) * 1024 + ln * 16) = cl2_frag(m0_, m1_); *(LAS bf16x8*)(rdy_ + (hh * 2 + 1) * 1024 + ln * 16) = cl2_frag(m2_, m3_); } while (0)
#define S2_UPD(SV, tile, NT) do { const f32x4 g4_ = *(const LAS f32x4*)(gm + 16 * (tile) + 4 * q); f32x4 c0_ = g4_ * SV + NT; \
            c0_ = MFMA16(*(const LAS bf16x8*)(rdy + ((tile) * 2 + 0) * 1024 + ln * 16), sf0, c0_); c0_ = MFMA16(*(const LAS bf16x8*)(rdy + ((tile) * 2 + 1) * 1024 + ln * 16), sf1, c0_); SV = c0_; } while (0)
        if (IN(ph)) for (int rep_ = 0; rep_ < DUPN(3); ++rep_) { PH_PTRS(); PH_IDS();
            if ((int)blockIdx.x < NSEQ_P * NH) { S2_PROMPT_HEAD(); }
            else {
            constexpr int SB_F = 5 * 512 + 128 + 2048;
            constexpr int O_KK = 512, O_NB = 1024, O_K = 1536, O_R = 2048, O_V = 2560, O_Y = 2688;
            LAS float* lbase = (LAS float*)lds;
            const int first = (int)blockIdx.x - NSEQ_P * NH, stride = G - NSEQ_P * NH, NIT = NSEQ_S * NH * 4;
            const int nit = first < NIT ? (NIT - first + stride - 1) / stride : 0;
            const bool is_ld = wave >= 4;
            const int rl = lane >> 4, kq = lane & 15, lrow = (wave & 3) * 4 + rl;
            const int j = tid - 256, js = j >> 4, jk = (j & 15) * 4, jr = j & 15;
            const bool sact = is_ld && js < T_S;
            f32x4 pw = F4Z; v2u pkk = (v2u){0u, 0u}, pb = pkk, pk = pkk, pr = pkk; unsigned short pv = 0;
#define IT_B(k) ((first + (k) * stride) >> 5)
#define IT_H(k) (((first + (k) * stride) >> 2) & 7)
#define IT_Q(k) ((first + (k) * stride) & 3)
#define SM_LOAD(k) do { if (sact) { const size_t mm = (size_t)(MP + IT_B(k) * T_S + js) * MIX + 64 * IT_H(k); pw = *(const f32x4*)(Wd + mm + jk); pkk = *(const v2u*)(KKb + mm + jk); pb = *(const v2u*)(Bb + mm + jk); \
                pk = *(const v2u*)(K2b + mm + jk); pr = *(const v2u*)(Rb + mm + jk); pv = Vb[mm + 16 * IT_Q(k) + jr]; } } while (0)
#define SM_STORE(bf) do { if (sact) { LAS float* b_ = lbase + (bf) * SB_F; *(LAS f32x4*)(b_ + js * 64 + jk) = pw; *(LAS f32x4*)(b_ + O_KK + js * 64 + jk) = (f32x4){bf_lo(pkk.x), bf_hi(pkk.x), bf_lo(pkk.y), bf_hi(pkk.y)}; \
                *(LAS f32x4*)(b_ + O_NB + js * 64 + jk) = (f32x4){-bf_lo(pb.x), -bf_hi(pb.x), -bf_lo(pb.y), -bf_hi(pb.y)}; *(LAS f32x4*)(b_ + O_K + js * 64 + jk) = (f32x4){bf_lo(pk.x), bf_hi(pk.x), bf_lo(pk.y), bf_hi(pk.y)}; \
                *(LAS f32x4*)(b_ + O_R + js * 64 + jk) = (f32x4){bf_lo(pr.x), bf_hi(pr.x), bf_lo(pr.y), bf_hi(pr.y)}; b_[O_V + js * 16 + jr] = bf_lo((unsigned)pv); } } while (0)
#define SM_YOUT(bf, k) do { if (sact) { const LAS float* y_ = lbase + (bf) * SB_F + O_Y + js * 256 + jr * 16; const f32x4 a_ = *(const LAS f32x4*)y_, b2_ = *(const LAS f32x4*)(y_ + 4), c_ = *(const LAS f32x4*)(y_ + 8), d_ = *(const LAS f32x4*)(y_ + 12); \
                const f32x4 t_ = (a_ + b2_) + (c_ + d_); Y[(size_t)(MP + IT_B(k) * T_S + js) * MIX + 64 * IT_H(k) + 16 * IT_Q(k) + jr] = (t_[0] + t_[1]) + (t_[2] + t_[3]); } } while (0)
#define SM_STATE(k) (ARG(I_SWKV) + ((((size_t)l * NSEQ_S + IT_B(k)) * NH + IT_H(k)) * HS + 16 * IT_Q(k) + lrow) * HS + 4 * kq)
            f32x4 Snext = F4Z;
            if (nit > 0) { SM_LOAD(0); SM_STORE(0); if (nit > 1) SM_LOAD(1); if (!is_ld) Snext = *(const f32x4*)SM_STATE(0); }
            __syncthreads();
            for (int k = 0; k < nit; ++k) {
                const int bf = k & 1;
                if (is_ld) {
                    if (k + 1 < nit) SM_STORE(bf ^ 1);
                    if (k + 2 < nit) SM_LOAD(k + 2);
                    if (k > 0) SM_YOUT(bf ^ 1, k - 1);
                } else {
                    f32x4 S = Snext;
                    if (k + 1 < nit) Snext = *(const f32x4*)SM_STATE(k + 1);
                    const LAS float* b_ = lbase + bf * SB_F;
                    LAS float* yp_ = lbase + bf * SB_F + O_Y + lrow * 16 + kq;
                    f32x2 Slo = __builtin_shufflevector(S, S, 0, 1), Shi = __builtin_shufflevector(S, S, 2, 3);
#define SCAN_CP(X, s2) { const f32x2 vv2 = (f32x2){vv##X, vv##X}; \
                                f32x2 dp = Slo * __builtin_shufflevector(kk4##X, kk4##X, 0, 1); dp = Shi * __builtin_shufflevector(kk4##X, kk4##X, 2, 3) + dp; \
                                const float sa = row16_sum(dp[0] + dp[1]); \
                                const f32x2 sa2 = (f32x2){sa, sa}; \
                                f32x2 tlo = Slo * __builtin_shufflevector(w4##X, w4##X, 0, 1), thi = Shi * __builtin_shufflevector(w4##X, w4##X, 2, 3); \
                                tlo = vv2 * __builtin_shufflevector(k4##X, k4##X, 0, 1) + tlo; thi = vv2 * __builtin_shufflevector(k4##X, k4##X, 2, 3) + thi; \
                                Slo = sa2 * __builtin_shufflevector(nb4##X, nb4##X, 0, 1) + tlo; Shi = sa2 * __builtin_shufflevector(nb4##X, nb4##X, 2, 3) + thi; \
                                f32x2 yp = Slo * __builtin_shufflevector(r4##X, r4##X, 0, 1); yp = Shi * __builtin_shufflevector(r4##X, r4##X, 2, 3) + yp; \
                                yv[s2] = yp[0] + yp[1]; }
#define SCAN_ALD(X, s) asm volatile("ds_read_b128 %0, %6 offset:%8\n\tds_read_b128 %1, %6 offset:%9\n\tds_read_b128 %2, %6 offset:%10\n\tds_read_b128 %3, %6 offset:%11\n\tds_read_b128 %4, %6 offset:%12\n\tds_read_b32 %5, %7 offset:%13" \
                                : "=&v"(w4##X), "=&v"(kk4##X), "=&v"(nb4##X), "=&v"(k4##X), "=&v"(r4##X), "=&v"(vv##X) : "v"(a4_), "v"(av_), "n"((s) * 256), "n"(O_KK * 4 + (s) * 256), "n"(O_NB * 4 + (s) * 256), "n"(O_K * 4 + (s) * 256), "n"(O_R * 4 + (s) * 256), "n"(O_V * 4 + (s) * 64)); \
                                __builtin_amdgcn_sched_barrier(0);
#define SCAN_AW(X) __builtin_amdgcn_sched_barrier(0); asm volatile("s_waitcnt lgkmcnt(0)" : "+v"(w4##X), "+v"(kk4##X), "+v"(nb4##X), "+v"(k4##X), "+v"(r4##X), "+v"(vv##X)); __builtin_amdgcn_sched_barrier(0);
#define SCAN_PAIR(s) SCAN_ALD(B, (s) + 1) SCAN_CP(A, s) SCAN_AW(B) SCAN_ALD(A, (s) + 2) SCAN_CP(B, (s) + 1) SCAN_AW(A)
                    float yv[8];
                    { const unsigned a4_ = (unsigned)(unsigned long long)(b_ + 4 * kq), av_ = (unsigned)(unsigned long long)(b_ + lrow);
                      f32x4 w4A, kk4A, nb4A, k4A, r4A, w4B, kk4B, nb4B, k4B, r4B; float vvA, vvB;
                      SCAN_ALD(A, 0) SCAN_AW(A)
                      SCAN_PAIR(0) SCAN_PAIR(2) SCAN_PAIR(4)
                      SCAN_ALD(B, 7) SCAN_CP(A, 6) SCAN_AW(B) SCAN_CP(B, 7) }
#pragma unroll
                    for (int s2 = 0; s2 < 8; ++s2) yp_[s2 * 256] = yv[s2];
#undef SCAN_ALD
#undef SCAN_AW
#undef SCAN_CP
#undef SCAN_PAIR
                    S = (f32x4){Slo[0], Slo[1], Shi[0], Shi[1]};
                    *(f32x4*)(out + O_WKS + ((((size_t)l * NSEQ_S + IT_B(k)) * NH + IT_H(k)) * HS + 16 * IT_Q(k) + lrow) * HS + 4 * kq) = S;
                }
                __syncthreads();
            }
            if (is_ld && nit > 0) SM_YOUT((nit - 1) & 1, nit - 1);
            __syncthreads();
#undef SM_LOAD
#undef SM_STORE
#undef SM_YOUT
#undef SM_STATE
#undef IT_B
#undef IT_H
#undef IT_Q
            }
        }
        SEAM(ph); ++ph;
        if (IN(ph)) for (int rep_ = 0; rep_ < DUPN(4); ++rep_) { PH_PTRS(); PH_IDS();
            const float* lnw = ARG(I_LNW) + (size_t)l * MIX; const float* lnb = ARG(I_LNB) + (size_t)l * MIX; const float* rk = ARG(I_RK) + (size_t)l * MIX;
            const int c = 8 * lane;
            for (int m = gw; m < M; m += NGW) {
                const float* ysrc = m < MP ? Wd : Y;
                const f32x4 y0 = *(const f32x4*)(ysrc + (size_t)m * MIX + c), y1 = *(const f32x4*)(ysrc + (size_t)m * MIX + c + 4);
                float y[8] = {y0[0], y0[1], y0[2], y0[3], y1[0], y1[1], y1[2], y1[3]};
                float s = 0.f;
#pragma unroll
                for (int i = 0; i < 8; ++i) s += y[i];
                s = row8_sum(s);
                const float mean = s * (1.0f / 64.0f); float q2 = 0.f;
#pragma unroll
                for (int i = 0; i < 8; ++i) { y[i] -= mean; q2 += y[i] * y[i]; }
                q2 = row8_sum(q2);
                const float rstd = 1.0f / sqrtf(q2 * (1.0f / 64.0f) + 64e-5f);
                const v4u ru = *(const v4u*)(Rb + (size_t)m * MIX + c), ku = *(const v4u*)(K2b + (size_t)m * MIX + c), vu = *(const v4u*)(Vb + (size_t)m * MIX + c), gu = *(const v4u*)(Gb + (size_t)m * MIX + c);
                const float rr[8] = {bf_lo(ru.x), bf_hi(ru.x), bf_lo(ru.y), bf_hi(ru.y), bf_lo(ru.z), bf_hi(ru.z), bf_lo(ru.w), bf_hi(ru.w)};
                const float kk[8] = {bf_lo(ku.x), bf_hi(ku.x), bf_lo(ku.y), bf_hi(ku.y), bf_lo(ku.z), bf_hi(ku.z), bf_lo(ku.w), bf_hi(ku.w)};
                const float vv[8] = {bf_lo(vu.x), bf_hi(vu.x), bf_lo(vu.y), bf_hi(vu.y), bf_lo(vu.z), bf_hi(vu.z), bf_lo(vu.w), bf_hi(vu.w)};
                const float gg[8] = {bf_lo(gu.x), bf_hi(gu.x), bf_lo(gu.y), bf_hi(gu.y), bf_lo(gu.z), bf_hi(gu.z), bf_lo(gu.w), bf_hi(gu.w)};
                const f32x4 rk0 = *(const f32x4*)(rk + c), rk1 = *(const f32x4*)(rk + c + 4), w0 = *(const f32x4*)(lnw + c), w1 = *(const f32x4*)(lnw + c + 4), b0 = *(const f32x4*)(lnb + c), b1 = *(const f32x4*)(lnb + c + 4);
                float bs = 0.f;
#pragma unroll
                for (int i = 0; i < 4; ++i) bs += rr[i] * kk[i] * rk0[i] + rr[4 + i] * kk[4 + i] * rk1[i];
                bs = row8_sum(bs);
                float o[8];
#pragma unroll
                for (int i = 0; i < 4; ++i) { o[i] = (y[i] * rstd * w0[i] + b0[i] + bs * vv[i]) * gg[i]; o[4 + i] = (y[4 + i] * rstd * w1[i] + b1[i] + bs * vv[4 + i]) * gg[4 + i]; }
                *(bf16x8*)(ORP + (size_t)m * D + c) = pack8(o);
            }
        }
        SEAM(ph); ++ph;
        if (IN(ph)) for (int rep_ = 0; rep_ < DUPN(5); ++rep_) { PH_PTRS();
            pg8::Gemm g{ORP, WBR_T, MP, D, D}; pg8::StaticOrder S; S.init(MP, D, G, (int)blockIdx.x);
            EpiMerge E{8, P, H};
            pg8::gemm_phase<EpiMerge, pg8::StaticOrder, true, true>(lds, g, S, E, wave_u);
            SAMPLE_TILES(ORP, WBR_T, D, D, E, (MP / 256) * (D / 256));
        }
        SEAM(ph); ++ph;
        if (IN(ph)) for (int rep_ = 0; rep_ < DUPN(6); ++rep_) { PH_PTRS();
            pg8::Gemm g{H, WOUT_T, MP, D, D}; pg8::StaticOrder S; S.init(MP, D, G, (int)blockIdx.x);
            EpiRes E{0, X, modmix + 2048};
            pg8::gemm_phase<EpiRes, pg8::StaticOrder, true, true>(lds, g, S, E, wave_u);
            SAMPLE_TILES(H, WOUT_T, D, D, E, (MP / 256) * (D / 256));
        }
        SEAM(ph); ++ph;
        if (IN(ph)) for (int rep_ = 0; rep_ < DUPN(7); ++rep_) { PH_PTRS(); PH_IDS();
            const float* nw = ARG(I_NORMMLP) + (size_t)l * D;
            for (int m = gw; m < M; m += NGW) {
                const float* xr = X + (size_t)m * D; const float* mo = modmlp + (size_t)row_seq(m) * MODW;
                f32x4 v[4]; float s = 0.f;
#pragma unroll
                for (int j = 0; j < 4; ++j) { v[j] = *(const f32x4*)(xr + 4 * lane + 256 * j); s += (v[j][0] * v[j][0] + v[j][1] * v[j][1]) + (v[j][2] * v[j][2] + v[j][3] * v[j][3]); }
                const float rstd = 1.0f / sqrtf(wave_sum(s) * (1.0f / D) + 1e-6f);
#pragma unroll
                for (int j = 0; j < 4; ++j) { const int c = 4 * lane + 256 * j; const f32x4 g = *(const f32x4*)(nw + c), sh = *(const f32x4*)(mo + c), sc = *(const f32x4*)(mo + 1024 + c);
                    f32x4 o;
#pragma unroll
                    for (int i = 0; i < 4; ++i) o[i] = v[j][i] * rstd * g[i] * (1.0f + sc[i]) + sh[i];
                    *(v2u*)(H + (size_t)m * D + c) = pack4(o[0], o[1], o[2], o[3]); }
            }
        }
        SEAM(ph); ++ph;
        if (IN(ph)) for (int rep_ = 0; rep_ < DUPN(8); ++rep_) { PH_PTRS();
            pg8::Gemm g{H, WFF1_T, MP, DFF, D}; pg8::StaticOrder S; S.init(MP, DFF, G, (int)blockIdx.x);
            EpiStoreBf16 E{0, P, DFF, 1};
            pg8::gemm_phase<EpiStoreBf16, pg8::StaticOrder, true, true>(lds, g, S, E, wave_u);
            SAMPLE_TILES(H, WFF1_T, DFF, D, E, (MP / 256) * (DFF / 256));
        }
        SEAM(ph); ++ph;
        if (IN(ph)) for (int rep_ = 0; rep_ < DUPN(9); ++rep_) { PH_PTRS();
            pg8::Gemm g{P, WFF2_T, MP, D, DFF}; pg8::StaticOrder S; S.init(MP, D, G, (int)blockIdx.x);
            EpiRes E{0, X, modmlp + 2048};
            pg8::gemm_phase<EpiRes, pg8::StaticOrder, true, true>(lds, g, S, E, wave_u);
            SAMPLE_TILES(P, WFF2_T, D, DFF, E, (MP / 256) * (D / 256));
        }
        SEAM(ph); ++ph;
    }
    if (IN(ph)) for (int rep_ = 0; rep_ < DUPN(12); ++rep_) { PH_PTRS(); PH_IDS();
        const float* nw = ARG(I_NORMF);
        for (int m = gw; m < M; m += NGW) {
            float* xr = X + (size_t)m * D;
            f32x4 v[4]; float s = 0.f;
#pragma unroll
            for (int j = 0; j < 4; ++j) { v[j] = *(const f32x4*)(xr + 4 * lane + 256 * j); s += (v[j][0] * v[j][0] + v[j][1] * v[j][1]) + (v[j][2] * v[j][2] + v[j][3] * v[j][3]); }
            const float rstd = 1.0f / sqrtf(wave_sum(s) * (1.0f / D) + 1e-6f);
#pragma unroll
            for (int j = 0; j < 4; ++j) { const int c = 4 * lane + 256 * j; const f32x4 g = *(const f32x4*)(nw + c); *(f32x4*)(xr + c) = v[j] * rstd * g; }
        }
    }
#undef IN
#undef SEAM
}

constexpr int N_PHASES = 2 + DEPTH * 12 + 1;

extern "C" void kernel_launch(void* const* d_in, const int* in_sizes, int n_in, void* d_out, int out_size, void* d_ws, size_t ws_size, hipStream_t stream) {
    static int grid = 0;
    if (grid == 0) {
        if (n_in != N_IN || (size_t)out_size != O_END || ws_size < WS_END) { fprintf(stderr, "kernel_launch: shape mismatch n_in %d out %d ws %zu\n", n_in, out_size, ws_size); grid = -1; return; }
        int dev = 0, cus = 0, per_cu = 0;
        if (hipGetDevice(&dev) != hipSuccess || hipDeviceGetAttribute(&cus, hipDeviceAttributeMultiprocessorCount, dev) != hipSuccess) { grid = -1; return; }
        if (hipFuncSetAttribute((const void*)mk_fwd, hipFuncAttributeMaxDynamicSharedMemorySize, LDS_BYTES) != hipSuccess) { fprintf(stderr, "kernel_launch: hipFuncSetAttribute failed\n"); grid = -1; return; }
        if (hipOccupancyMaxActiveBlocksPerMultiprocessor(&per_cu, (const void*)mk_fwd, NTHR, LDS_BYTES) != hipSuccess || per_cu < 1) { fprintf(stderr, "kernel_launch: occupancy query says %d\n", per_cu); per_cu = 1; }
        (void)hipGetLastError();
        grid = cus * (per_cu < 1 ? per_cu : 1);
    }
    if (grid < 0) return;
    (void)hipMemsetAsync((char*)d_ws + WS_CTL, 0, CTL_ZERO_BYTES, stream);
    Args a{};
    for (int i = 0; i < N_IN; ++i) a.in[i] = (const float*)d_in[i];
    a.out = (float*)d_out; a.ws = (unsigned char*)d_ws; a.dup = PROBE_DUP;
#if MK_ONE_LAUNCH
    a.ph_lo = 0; a.ph_hi = N_PHASES;
    void* kargs[] = {(void*)&a};
    hipError_t e = hipLaunchCooperativeKernel((const void*)mk_fwd, dim3(grid), dim3(NTHR), kargs, LDS_BYTES, stream);
    if (e != hipSuccess) fprintf(stderr, "kernel_launch: cooperative launch failed: %s (grid %d)\n", hipGetErrorString(e), grid);
#else
    for (int p = 0; p < N_PHASES; ++p) { a.ph_lo = p; a.ph_hi = p + 1; hipLaunchKernelGGL(mk_fwd, dim3(grid), dim3(NTHR), LDS_BYTES, stream, a); }
#endif
}
```

```cpp
#include <hip/hip_runtime.h>
#include <cstdio>
#include <cstdint>

#ifndef PROBE_DUP
#define PROBE_DUP -1
#endif
#define DUPN(k) ((args.dup == (k)) ? 2 : 1)
#ifndef MK_ONE_LAUNCH
#define MK_ONE_LAUNCH 1
#endif

#define GAS __attribute__((address_space(1)))
#define LAS __attribute__((address_space(3)))
typedef unsigned short bf16;
typedef unsigned v4u __attribute__((ext_vector_type(4)));
typedef unsigned v2u __attribute__((ext_vector_type(2)));
typedef float f32x4 __attribute__((ext_vector_type(4)));
typedef float f32x2 __attribute__((ext_vector_type(2)));
typedef short bf16x8 __attribute__((ext_vector_type(8)));

constexpr int D = 1024, DEPTH = 4, NSEQ_P = 8, T_P = 2048, NSEQ_S = 128, T_S = 8;
constexpr int MP = NSEQ_P * T_P, MS = NSEQ_S * T_S, M = MP + MS;
constexpr int NSEQ = NSEQ_P + NSEQ_S;
constexpr int MIX = 512, HS = 64, NH = 8, POOLW = 512, PGRP = 128, PBUF = 15, DFF = 4096;
constexpr int RWKV_COLS = 1792, IN_COLS = 4352;
constexpr int C_R = 0, C_K = 512, C_V = 1024, C_XW = 1536, C_XA = 1600, C_XG = 1664, C_PP = 1792, C_GR = 2304, C_GP = 3328;
constexpr int MODW = 8 * 3072;
constexpr int NWAVES = 8, NTHR = 512;

enum { I_XP = 0, I_XS, I_SSHIFT, I_SPOOL, I_SWKV, I_CP, I_CS, I_WADAMIX, I_BADAMIX, I_NORMMIX, I_WIN, I_MU, I_W0, I_W2, I_A0, I_A2, I_G2,
       I_V0, I_V1, I_V2, I_KK, I_KA, I_RK, I_LNW, I_LNB, I_POOLW, I_POOLS, I_WBRR, I_WBRP, I_WOUT, I_WADAMLP, I_BADAMLP, I_NORMMLP, I_WFF1, I_WFF2, I_NORMF, N_IN };
constexpr size_t O_Y = 0, O_SHP = (size_t)M * D, O_POP = O_SHP + 4 * 8 * 1792, O_WKP = O_POP + 4 * 8 * 15 * 512, O_SHS = O_WKP + 4 * 8 * 8 * 4096,
                 O_POS = O_SHS + 4 * 128 * 1792, O_WKS = O_POS + (size_t)4 * 128 * 15 * 512, O_END = O_WKS + (size_t)4 * 128 * 8 * 4096;

constexpr size_t MiB = 1u << 20;
constexpr size_t WS_CTL = 0, CTL_ZERO_BYTES = 1 * MiB;
constexpr size_t WS_MOD = 1 * MiB;
constexpr size_t WS_SC = 14 * MiB;
constexpr size_t WS_SH0 = 14 * MiB + 512 * 1024;
constexpr size_t WS_PH0 = 448 * MiB;
constexpr size_t WS_WIN = 16 * MiB;
constexpr size_t WS_WBR = 25 * MiB;
constexpr size_t WS_WOUT = 27 * MiB;
constexpr size_t WS_WFF1 = 29 * MiB;
constexpr size_t WS_WFF2 = 37 * MiB;
constexpr size_t WS_WSM = 45 * MiB;
constexpr size_t SM_LORA = 0, SM_POOL = 786432, SM_V12 = 1310720;
constexpr size_t WS_H = 48 * MiB;
constexpr size_t WS_P = 82 * MiB;
constexpr size_t WS_R = 227 * MiB, WS_K2 = 244 * MiB, WS_V = 261 * MiB, WS_KK = 278 * MiB, WS_B = 295 * MiB;
constexpr size_t WS_W = 312 * MiB;
constexpr size_t WS_ORP = 346 * MiB;
constexpr size_t WS_G = 380 * MiB;
constexpr size_t WS_VF = 397 * MiB;
constexpr size_t WS_Y = 414 * MiB;
constexpr size_t WS_POOLED = 451 * MiB, WS_XA = 468 * MiB;
constexpr size_t WS_WL2 = 414 * MiB;
constexpr size_t CHK_UNIT = 12544;
constexpr int CHK_NA = 2842, CHK_NB = 2674, CHK_NC = 2256;
constexpr size_t WS_CHKC = 451 * MiB;
constexpr size_t WS_END = 478 * MiB;

constexpr int CW_BAR = 4096;

constexpr int RING_BYTES = 155648, LDSCTL_OFF = RING_BYTES, MISC_OFF = LDSCTL_OFF + 320, LDS_BYTES = 157696;

typedef __bf16 bf16x2_t __attribute__((ext_vector_type(2)));
__device__ __forceinline__ unsigned cvt_pk_bf16(float lo, float hi) { f32x2 v = {lo, hi}; bf16x2_t b = __builtin_convertvector(v, bf16x2_t); return __builtin_bit_cast(unsigned, b); }
__device__ __forceinline__ float bf_lo(unsigned u) { return __builtin_bit_cast(float, u << 16); }
__device__ __forceinline__ float bf_hi(unsigned u) { return __builtin_bit_cast(float, u & 0xffff0000u); }
__device__ __forceinline__ float sigmoidf_(float x) { return 1.0f / (1.0f + __expf(-x)); }
__device__ __forceinline__ float tanhf_(float x) { return 1.0f - 2.0f / (1.0f + __expf(2.0f * x)); }
template <int CTRL> __device__ __forceinline__ float dpp_f(float x) { return __builtin_bit_cast(float, __builtin_amdgcn_update_dpp(0, __builtin_bit_cast(int, x), CTRL, 0xF, 0xF, true)); }
__device__ __forceinline__ float row16_sum(float x) { x += dpp_f<0xB1>(x); x += dpp_f<0x4E>(x); x += dpp_f<0x141>(x); x += dpp_f<0x140>(x); return x; }
__device__ __forceinline__ float row8_sum(float x) { x += dpp_f<0xB1>(x); x += dpp_f<0x4E>(x); x += dpp_f<0x141>(x); return x; }
__device__ __forceinline__ float wave_sum(float v) {
    v = row16_sum(v);
    const float a = __builtin_bit_cast(float, __builtin_amdgcn_readlane(__builtin_bit_cast(int, v), 0)), b = __builtin_bit_cast(float, __builtin_amdgcn_readlane(__builtin_bit_cast(int, v), 16)),
                c = __builtin_bit_cast(float, __builtin_amdgcn_readlane(__builtin_bit_cast(int, v), 32)), d = __builtin_bit_cast(float, __builtin_amdgcn_readlane(__builtin_bit_cast(int, v), 48));
    return (a + b) + (c + d);
}
__device__ __forceinline__ int lane_fresh() { int t; asm volatile("v_mbcnt_lo_u32_b32 %0, -1, 0\n\tv_mbcnt_hi_u32_b32 %0, -1, %0" : "=v"(t)); return t; }
__device__ __forceinline__ int launder_tid(int wave_u) { return wave_u * 64 + lane_fresh(); }
__device__ __forceinline__ int lane_id_() { return lane_fresh(); }
#define LDS_WAIT() asm volatile("s_waitcnt lgkmcnt(0)" ::: "memory")
#define VM_WAIT() asm volatile("s_waitcnt vmcnt(0)" ::: "memory")

namespace pg8 {
#define PG8_LAS __attribute__((address_space(3)))
typedef unsigned short bf16_t;
constexpr int BM = 256, BK = 64, HALF = 128, HTB = HALF * BK * 2, STAGE_BYTES = 8 * HTB, NXCD = 8, WGM = 8;

__host__ __device__ __forceinline__ int lds_byte(int r, int c) { const int st = (r >> 4) * 2 + (c >> 5), rr = r & 15, cc = c & 31, ob = rr * 64 + cc * 2; return st * 1024 + (ob ^ (((ob >> 9) & 1) << 5)); }
__host__ __device__ __forceinline__ void stage_rc(int b, int& R, int& C) { const int st = b / 1024, sb = b % 1024, swz = sb ^ (((sb >> 9) & 1) << 5); R = (st >> 1) * 16 + swz / 64; C = (st & 1) * 32 + (swz % 64) / 2; }
__host__ __device__ __forceinline__ int perm32(int rho) { const int n = rho >> 4, i = rho & 15; return 8 * (i >> 2) + 4 * n + (i & 3); }

struct Unit { int pm, pn; };
struct Gemm { const bf16_t* A; const bf16_t* Bt; int M, N, K; };

struct StaticOrder {
    int nM, nN, nwg, G, c;
    __host__ __device__ void init(int M_, int N_, int G_, int c_) { nM = M_ / BM; nN = N_ / BM; nwg = nM * nN; G = G_; c = c_; }
    __host__ __device__ bool next(int i, Unit& u) const {
        const long L = (long)i * G + c; if (L >= nwg) return false;
        int wgid = (int)L; { const int q = nwg / NXCD, r = nwg % NXCD, xcd = wgid % NXCD, off = wgid / NXCD; wgid = (xcd < r ? xcd * (q + 1) : r * (q + 1) + (xcd - r) * q) + off; }
        const int nig = WGM * nN, gid = wgid / nig, fm = gid * WGM, gsz = (nM - fm) < WGM ? (nM - fm) : WGM;
        u.pm = fm + ((wgid % nig) % gsz); u.pn = (wgid % nig) / gsz; return true;
    }
};

template <class Epi, class Sched, bool ALIGN_EPI = false, bool SP2 = false>
__device__ __forceinline__ void gemm_phase(PG8_LAS unsigned char* lds, const Gemm g, const Sched& S, const Epi& E, const int wave_u) {
    const int tid = launder_tid(wave_u), wid = __builtin_amdgcn_readfirstlane(tid >> 6), lane = tid & 63, wr = wid >> 2, wc = wid & 3, fr = lane & 15, fq = lane >> 4;
    const int K = g.K, nt = K / BK;
    unsigned voffA, voffB;
    { int R, C; stage_rc(tid * 16, R, C); const int Rb = (R & ~31) + perm32(R & 31); voffA = (unsigned)(R * K + C) * 2u; voffB = (unsigned)(Rb * K + C) * 2u; }
    const size_t r64step = (size_t)64 * K * 2;
    const size_t kstep = (size_t)(BK * 2);
    const size_t hstep = (size_t)HALF * K * 2;
    const size_t tstep = 2 * hstep;
    const unsigned ldsw = (unsigned)wid * 1024u;
    const int aoff = lds_byte(wr * 64 + fr, fq * 8), boff = lds_byte(wc * 32 + fr, fq * 8);
#define PG8_SA(b, h) (((b) * 2 + (h)) * HTB)
#define PG8_SB(b, h) ((4 + (b) * 2 + (h)) * HTB)
#define PG8_STAGE(bufoff, gbase, voff) do { _Pragma("unroll") for (int _i = 0; _i < 2; ++_i) \
        __builtin_amdgcn_global_load_lds((const unsigned*)((const char*)(gbase) + _i * r64step + (voff)), (PG8_LAS unsigned*)(lds + (bufoff) + ldsw + _i * 8192), 16, 0, 0); } while (0)
#define PG8_LDA(dst, b, h) do { _Pragma("unroll") for (int m = 0; m < 4; ++m) _Pragma("unroll") for (int k = 0; k < 2; ++k) dst[m][k] = *(const PG8_LAS bf16x8*)(lds + PG8_SA(b, h) + aoff + m * 2048 + k * 1024); } while (0)
#define PG8_LDB(dst, b, h) do { _Pragma("unroll") for (int n = 0; n < 2; ++n) _Pragma("unroll") for (int k = 0; k < 2; ++k) dst[n][k] = *(const PG8_LAS bf16x8*)(lds + PG8_SB(b, h) + boff + n * 2048 + k * 1024); } while (0)
#define PG8_MMA(ai, bj, At, Bt) do { __builtin_amdgcn_s_setprio(1); _Pragma("unroll") for (int m = 0; m < 4; ++m) _Pragma("unroll") for (int n = 0; n < 2; ++n) _Pragma("unroll") for (int k = 0; k < 2; ++k) \
        acc[ai][bj][m][n] = __builtin_amdgcn_mfma_f32_16x16x32_bf16(Bt[n][k], At[m][k], acc[ai][bj][m][n], 0, 0, 0); __builtin_amdgcn_s_setprio(0); } while (0)
#define PG8_WAIT_V(n) asm volatile("s_waitcnt vmcnt(" #n ")" ::: "memory")
#define PG8_WAIT_L(n) asm volatile("s_waitcnt lgkmcnt(" #n ")" ::: "memory")
#define PG8_BAR __builtin_amdgcn_s_barrier()
#define PG8_SCHED __builtin_amdgcn_sched_barrier(0)
    Unit cur, nxt; int ui = 0;
    if (!S.next(0, cur)) return;
    f32x4 acc[2][2][4][2];
#pragma unroll
    for (int a = 0; a < 2; ++a)
#pragma unroll
        for (int b = 0; b < 2; ++b)
#pragma unroll
            for (int m = 0; m < 4; ++m)
#pragma unroll
                for (int n = 0; n < 2; ++n) acc[a][b][m][n] = (f32x4){0.f, 0.f, 0.f, 0.f};
    bf16x8 At[4][2], B0[2][2], B1[2][2];
    const char* cA = (const char*)g.A + (size_t)cur.pm * tstep; const char* cB = (const char*)g.Bt + (size_t)cur.pn * tstep;
    if constexpr (SP2) {
        PG8_STAGE(PG8_SB(0, 0), cB, voffB); PG8_STAGE(PG8_SB(0, 1), cB + hstep, voffB); PG8_STAGE(PG8_SA(0, 0), cA, voffA); PG8_STAGE(PG8_SA(0, 1), cA + hstep, voffA);
        if (wr == 1) PG8_BAR;
        PG8_WAIT_V(2); PG8_BAR;
        PG8_STAGE(PG8_SB(1, 0), cB + kstep, voffB); PG8_STAGE(PG8_SA(1, 0), cA + kstep, voffA); PG8_STAGE(PG8_SB(1, 1), cB + hstep + kstep, voffB);
        PG8_WAIT_V(6); PG8_BAR;
    } else {
        PG8_STAGE(PG8_SB(0, 0), cB, voffB); PG8_STAGE(PG8_SA(0, 0), cA, voffA); PG8_STAGE(PG8_SB(0, 1), cB + hstep, voffB); PG8_STAGE(PG8_SA(0, 1), cA + hstep, voffA);
        if (wr == 1) PG8_BAR;
        PG8_WAIT_V(4); PG8_BAR;
        PG8_STAGE(PG8_SB(1, 0), cB + kstep, voffB); PG8_STAGE(PG8_SA(1, 0), cA + kstep, voffA); PG8_STAGE(PG8_SB(1, 1), cB + hstep + kstep, voffB);
        PG8_WAIT_V(6); PG8_BAR;
    }
    for (;;) {
        const bool has_next = S.next(ui + 1, nxt);
        const char* nA = has_next ? (const char*)g.A + (size_t)nxt.pm * tstep : cA; const char* nB = has_next ? (const char*)g.Bt + (size_t)nxt.pn * tstep : cB;
        for (int t = 0; t < nt; t += 2) {
            const bool last = (t == nt - 2);
            const char* a1 = cA + (size_t)(t + 1) * kstep;
            const char* a2 = last ? nA : cA + (size_t)(t + 2) * kstep; const char* b2 = last ? nB : cB + (size_t)(t + 2) * kstep;
            const char* a3 = a2 + kstep; const char* b3 = b2 + kstep;
            if constexpr (Epi::HOOK) { if (t == E.hook_t) E.hook(acc, cur, wr, wc, fr, fq); }
            if constexpr (SP2) {
            PG8_LDB(B0, 0, 0); PG8_LDB(B1, 0, 1); PG8_SCHED; PG8_LDA(At, 0, 0); PG8_STAGE(PG8_SA(1, 1), a1 + hstep, voffA);
            PG8_WAIT_V(8); PG8_WAIT_L(0); PG8_BAR; PG8_MMA(0, 0, At, B0); PG8_MMA(0, 1, At, B1); PG8_BAR; PG8_SCHED;
            PG8_LDA(At, 0, 1); PG8_STAGE(PG8_SB(0, 0), b2, voffB); PG8_STAGE(PG8_SB(0, 1), b2 + hstep, voffB); PG8_STAGE(PG8_SA(0, 0), a2, voffA);
            PG8_WAIT_V(8); PG8_WAIT_L(0); PG8_BAR; PG8_MMA(1, 0, At, B0); PG8_MMA(1, 1, At, B1); PG8_BAR; PG8_SCHED;
            PG8_LDB(B0, 1, 0); PG8_LDB(B1, 1, 1); PG8_SCHED; PG8_LDA(At, 1, 0); PG8_STAGE(PG8_SA(0, 1), a2 + hstep, voffA);
            PG8_WAIT_V(8); PG8_WAIT_L(0); PG8_BAR; PG8_MMA(0, 0, At, B0); PG8_MMA(0, 1, At, B1); PG8_BAR; PG8_SCHED;
            PG8_LDA(At, 1, 1); PG8_STAGE(PG8_SB(1, 0), b3, voffB); PG8_STAGE(PG8_SB(1, 1), b3 + hstep, voffB); PG8_STAGE(PG8_SA(1, 0), a3, voffA);
            PG8_WAIT_V(8); PG8_WAIT_L(0); PG8_BAR; PG8_MMA(1, 0, At, B0); PG8_MMA(1, 1, At, B1); PG8_BAR; PG8_SCHED;
            } else {
            PG8_LDB(B0, 0, 0); PG8_SCHED; PG8_LDA(At, 0, 0); PG8_STAGE(PG8_SA(1, 1), a1 + hstep, voffA);
            PG8_WAIT_L(8); PG8_BAR; PG8_WAIT_L(0); PG8_MMA(0, 0, At, B0); PG8_BAR; PG8_SCHED;
            PG8_LDB(B1, 0, 1); PG8_STAGE(PG8_SB(0, 0), b2, voffB);
            PG8_BAR; PG8_WAIT_L(0); PG8_MMA(0, 1, At, B1); PG8_BAR;
            PG8_LDA(At, 0, 1); PG8_STAGE(PG8_SA(0, 0), a2, voffA);
            PG8_BAR; PG8_WAIT_L(0); PG8_MMA(1, 0, At, B0); PG8_BAR; PG8_SCHED;
            PG8_STAGE(PG8_SB(0, 1), b2 + hstep, voffB);
            PG8_WAIT_V(6); PG8_BAR; PG8_MMA(1, 1, At, B1); PG8_BAR;
            PG8_LDB(B0, 1, 0); PG8_SCHED; PG8_LDA(At, 1, 0); PG8_STAGE(PG8_SA(0, 1), a2 + hstep, voffA);
            PG8_WAIT_L(8); PG8_BAR; PG8_WAIT_L(0); PG8_MMA(0, 0, At, B0); PG8_BAR; PG8_SCHED;
            PG8_LDB(B1, 1, 1); PG8_STAGE(PG8_SB(1, 0), b3, voffB);
            PG8_BAR; PG8_WAIT_L(0); PG8_MMA(0, 1, At, B1); PG8_BAR;
            PG8_LDA(At, 1, 1); PG8_STAGE(PG8_SA(1, 0), a3, voffA);
            PG8_BAR; PG8_WAIT_L(0); PG8_MMA(1, 0, At, B0); PG8_BAR; PG8_SCHED;
            PG8_STAGE(PG8_SB(1, 1), b3 + hstep, voffB);
            PG8_WAIT_V(6); PG8_BAR; PG8_MMA(1, 1, At, B1); PG8_BAR;
            }
        }
        if constexpr (ALIGN_EPI) { if (wr == 0) PG8_BAR; }
        E(acc, cur, wr, wc, fr, fq);
        if (!has_next) break;
#pragma unroll
        for (int a = 0; a < 2; ++a)
#pragma unroll
            for (int b = 0; b < 2; ++b)
#pragma unroll
                for (int m = 0; m < 4; ++m)
#pragma unroll
                    for (int n = 0; n < 2; ++n) acc[a][b][m][n] = (f32x4){0.f, 0.f, 0.f, 0.f};
        cur = nxt; cA = nA; cB = nB; ++ui;
        if constexpr (ALIGN_EPI) { if (wr == 1) PG8_BAR; }
    }
    PG8_WAIT_V(0);
    if constexpr (!ALIGN_EPI) { if (wr == 0) PG8_BAR; }
    PG8_BAR;
#undef PG8_SA
#undef PG8_SB
#undef PG8_STAGE
#undef PG8_LDA
#undef PG8_LDB
#undef PG8_MMA
#undef PG8_WAIT_V
#undef PG8_WAIT_L
#undef PG8_BAR
#undef PG8_SCHED
}
}

__device__ __forceinline__ int row_seq(int m) { return m < MP ? (m >> 11) : NSEQ_P + ((m - MP) >> 3); }
__device__ __forceinline__ int row_t(int m) { return m < MP ? (m & (T_P - 1)) : ((m - MP) & (T_S - 1)); }

struct EpiBase { static constexpr bool HOOK = false; int hook_t; };

struct EpiStoreBf16 {
    static constexpr bool HOOK = false; int hook_t;
    bf16* O; int ldc; int act;
    __device__ __forceinline__ void hook_apply(int, int, f32x4&, f32x4&) const {}
    __device__ __forceinline__ void apply(int row, int col, f32x4 v0, f32x4 v1) const {
        if (act == 1) {
#pragma unroll
            for (int j = 0; j < 4; ++j) { float a = fmaxf(v0[j], 0.f), b = fmaxf(v1[j], 0.f); v0[j] = a * a; v1[j] = b * b; } }
        v4u w; w.x = cvt_pk_bf16(v0[0], v0[1]); w.y = cvt_pk_bf16(v0[2], v0[3]); w.z = cvt_pk_bf16(v1[0], v1[1]); w.w = cvt_pk_bf16(v1[2], v1[3]);
        *(v4u*)(O + (size_t)row * ldc + col) = w;
    }
    __device__ __forceinline__ void hook(f32x4 (&)[2][2][4][2], const pg8::Unit&, int, int, int, int) const {}
    __device__ __forceinline__ void operator()(const f32x4 (&acc)[2][2][4][2], const pg8::Unit& u, int wr, int wc, int fr, int fq) const {
        { const int ln__ = lane_fresh(); fr = ln__ & 15; fq = ln__ >> 4; }
        const int row0 = u.pm * 256 + wr * 64 + fr, col0 = u.pn * 256 + wc * 32 + 8 * fq;
#pragma unroll
        for (int ai = 0; ai < 2; ++ai)
#pragma unroll
            for (int m = 0; m < 4; ++m) { bf16* rowp = O + (size_t)(row0 + ai * 128 + m * 16) * ldc + col0;
#pragma unroll
                for (int bj = 0; bj < 2; ++bj) { f32x4 v0 = acc[ai][bj][m][0], v1 = acc[ai][bj][m][1];
                    if (act == 1) {
#pragma unroll
                        for (int j = 0; j < 4; ++j) { float a = fmaxf(v0[j], 0.f), b = fmaxf(v1[j], 0.f); v0[j] = a * a; v1[j] = b * b; } }
                    v4u w; w.x = cvt_pk_bf16(v0[0], v0[1]); w.y = cvt_pk_bf16(v0[2], v0[3]); w.z = cvt_pk_bf16(v1[0], v1[1]); w.w = cvt_pk_bf16(v1[2], v1[3]);
                    *(v4u*)(rowp + bj * 128) = w; } }
    }
};

struct EpiMod {
    static constexpr bool HOOK = false; int hook_t;
    float* O; const float* bmix; const float* bmlp;
    __device__ __forceinline__ void hook(f32x4 (&)[2][2][4][2], const pg8::Unit&, int, int, int, int) const {}
    __device__ __forceinline__ void operator()(const f32x4 (&acc)[2][2][4][2], const pg8::Unit& u, int wr, int wc, int fr, int fq) const {
        { const int ln__ = lane_fresh(); fr = ln__ & 15; fq = ln__ >> 4; }
        const int row0 = u.pm * 256 + wr * 64 + fr, col0 = u.pn * 256 + wc * 32 + 8 * fq;
        const int mat = (u.pn * 256) / 3072, l = mat >> 1, which = mat & 1;
        const float* bias = (which ? bmlp : bmix) + l * 3072 - mat * 3072;
#pragma unroll
        for (int ai = 0; ai < 2; ++ai)
#pragma unroll
            for (int m = 0; m < 4; ++m) { const int row = row0 + ai * 128 + m * 16; if (row >= NSEQ) continue;
#pragma unroll
                for (int bj = 0; bj < 2; ++bj) { const int col = col0 + bj * 128;
                    const f32x4 b0 = *(const f32x4*)(bias + col), b1 = *(const f32x4*)(bias + col + 4);
                    *(f32x4*)(O + (size_t)row * MODW + col) = acc[ai][bj][m][0] + b0; *(f32x4*)(O + (size_t)row * MODW + col + 4) = acc[ai][bj][m][1] + b1; } }
    }
};

struct EpiRes {
    static constexpr bool HOOK = false; int hook_t;
    float* X; const float* gate;
    __device__ __forceinline__ void hook_apply(int, int, f32x4&, f32x4&) const {}
    __device__ __forceinline__ void apply(int row, int col, f32x4 v0, f32x4 v1) const {
        const float* gr = gate + (size_t)row_seq(row) * MODW + col; float* xr = X + (size_t)row * D + col;
        const f32x4 g0 = *(const f32x4*)gr, g1 = *(const f32x4*)(gr + 4);
        f32x4 x0 = *(const f32x4*)xr, x1 = *(const f32x4*)(xr + 4);
        x0 += g0 * v0; x1 += g1 * v1;
        *(f32x4*)xr = x0; *(f32x4*)(xr + 4) = x1;
    }
    __device__ __forceinline__ void hook(f32x4 (&)[2][2][4][2], const pg8::Unit&, int, int, int, int) const {}
    __device__ __forceinline__ void operator()(const f32x4 (&acc)[2][2][4][2], const pg8::Unit& u, int wr, int wc, int fr, int fq) const {
        { const int ln__ = lane_fresh(); fr = ln__ & 15; fq = ln__ >> 4; }
        const int row0 = u.pm * 256 + wr * 64 + fr, col0 = u.pn * 256 + wc * 32 + 8 * fq;
#pragma unroll
        for (int ai = 0; ai < 2; ++ai)
#pragma unroll
            for (int m = 0; m < 4; ++m) { const int row = row0 + ai * 128 + m * 16; const float* gr = gate + (size_t)row_seq(row) * MODW; float* xr = X + (size_t)row * D;
#pragma unroll
                for (int bj = 0; bj < 2; ++bj) { const int col = col0 + bj * 128;
                    const f32x4 g0 = *(const f32x4*)(gr + col), g1 = *(const f32x4*)(gr + col + 4);
                    f32x4 x0 = *(const f32x4*)(xr + col), x1 = *(const f32x4*)(xr + col + 4);
                    x0 += g0 * acc[ai][bj][m][0]; x1 += g1 * acc[ai][bj][m][1];
                    *(f32x4*)(xr + col) = x0; *(f32x4*)(xr + col + 4) = x1; } }
    }
};

struct EpiMerge {
    static constexpr bool HOOK = true; int hook_t;
    const bf16* P; bf16* O;
    __device__ __forceinline__ void hook_apply(int row, int col, f32x4& v0, f32x4& v1) const {
        const bf16* pr = P + (size_t)row * IN_COLS + col; const v4u a = *(const v4u*)(pr + C_GR), b = *(const v4u*)(pr + C_GP);
        const float ga[8] = {bf_lo(a.x), bf_hi(a.x), bf_lo(a.y), bf_hi(a.y), bf_lo(a.z), bf_hi(a.z), bf_lo(a.w), bf_hi(a.w)};
        const float gb[8] = {bf_lo(b.x), bf_hi(b.x), bf_lo(b.y), bf_hi(b.y), bf_lo(b.z), bf_hi(b.z), bf_lo(b.w), bf_hi(b.w)};
#pragma unroll
        for (int j = 0; j < 4; ++j) { v0[j] *= (1.0f + __expf(-gb[j])) / (1.0f + __expf(-ga[j])); v1[j] *= (1.0f + __expf(-gb[4 + j])) / (1.0f + __expf(-ga[4 + j])); }
    }
    __device__ __forceinline__ void apply(int row, int col, f32x4 v0, f32x4 v1) const {
        const v4u b = *(const v4u*)(P + (size_t)row * IN_COLS + C_GP + col);
        const float gb[8] = {bf_lo(b.x), bf_hi(b.x), bf_lo(b.y), bf_hi(b.y), bf_lo(b.z), bf_hi(b.z), bf_lo(b.w), bf_hi(b.w)};
#pragma unroll
        for (int j = 0; j < 4; ++j) { v0[j] *= sigmoidf_(gb[j]); v1[j] *= sigmoidf_(gb[4 + j]); }
        v4u w; w.x = cvt_pk_bf16(v0[0], v0[1]); w.y = cvt_pk_bf16(v0[2], v0[3]); w.z = cvt_pk_bf16(v1[0], v1[1]); w.w = cvt_pk_bf16(v1[2], v1[3]);
        *(v4u*)(O + (size_t)row * D + col) = w;
    }
    __device__ __forceinline__ void hook(f32x4 (&acc)[2][2][4][2], const pg8::Unit& u, int wr, int wc, int fr, int fq) const {
        { const int ln__ = lane_fresh(); fr = ln__ & 15; fq = ln__ >> 4; }
        const int row0 = u.pm * 256 + wr * 64 + fr, col0 = u.pn * 256 + wc * 32 + 8 * fq;
#pragma unroll
        for (int ai = 0; ai < 2; ++ai)
#pragma unroll
            for (int m = 0; m < 4; ++m) { const bf16* pr = P + (size_t)(row0 + ai * 128 + m * 16) * IN_COLS + col0;
#pragma unroll
                for (int bj = 0; bj < 2; ++bj) { const v4u a = *(const v4u*)(pr + C_GR + bj * 128), b = *(const v4u*)(pr + C_GP + bj * 128);
                    float ga[8] = {bf_lo(a.x), bf_hi(a.x), bf_lo(a.y), bf_hi(a.y), bf_lo(a.z), bf_hi(a.z), bf_lo(a.w), bf_hi(a.w)};
                    float gb[8] = {bf_lo(b.x), bf_hi(b.x), bf_lo(b.y), bf_hi(b.y), bf_lo(b.z), bf_hi(b.z), bf_lo(b.w), bf_hi(b.w)};
#pragma unroll
                    for (int j = 0; j < 4; ++j) { acc[ai][bj][m][0][j] *= (1.0f + __expf(-gb[j])) / (1.0f + __expf(-ga[j]));
                                                  acc[ai][bj][m][1][j] *= (1.0f + __expf(-gb[4 + j])) / (1.0f + __expf(-ga[4 + j])); } } }
    }
    __device__ __forceinline__ void operator()(const f32x4 (&acc)[2][2][4][2], const pg8::Unit& u, int wr, int wc, int fr, int fq) const {
        { const int ln__ = lane_fresh(); fr = ln__ & 15; fq = ln__ >> 4; }
        const int row0 = u.pm * 256 + wr * 64 + fr, col0 = u.pn * 256 + wc * 32 + 8 * fq;
#pragma unroll
        for (int ai = 0; ai < 2; ++ai)
#pragma unroll
            for (int m = 0; m < 4; ++m) { const size_t row = (size_t)(row0 + ai * 128 + m * 16); const bf16* pr = P + row * IN_COLS + col0;
#pragma unroll
                for (int bj = 0; bj < 2; ++bj) { const v4u b = *(const v4u*)(pr + C_GP + bj * 128);
                    float gb[8] = {bf_lo(b.x), bf_hi(b.x), bf_lo(b.y), bf_hi(b.y), bf_lo(b.z), bf_hi(b.z), bf_lo(b.w), bf_hi(b.w)};
                    f32x4 v0 = acc[ai][bj][m][0], v1 = acc[ai][bj][m][1];
#pragma unroll
                    for (int j = 0; j < 4; ++j) { v0[j] *= sigmoidf_(gb[j]); v1[j] *= sigmoidf_(gb[4 + j]); }
                    v4u w; w.x = cvt_pk_bf16(v0[0], v0[1]); w.y = cvt_pk_bf16(v0[2], v0[3]); w.z = cvt_pk_bf16(v1[0], v1[1]); w.w = cvt_pk_bf16(v1[2], v1[3]);
                    *(v4u*)(O + row * D + col0 + bj * 128) = w; } }
    }
};

#define EPI_BIG_OPERATOR() \
    __device__ __forceinline__ void hook(f32x4 (&)[2][2][4][2], const pg8::Unit&, int, int, int, int) const {} \
    __device__ __forceinline__ void operator()(const f32x4 (&acc)[2][2][4][2], const pg8::Unit& u, int wr, int wc, int fr, int fq) const { \
        { const int ln__ = lane_fresh(); fr = ln__ & 15; fq = ln__ >> 4; } \
        const int row0 = u.pm * 256 + wr * 64 + fr, col0 = u.pn * 256 + wc * 32 + 8 * fq; \
        _Pragma("unroll") for (int ai = 0; ai < 2; ++ai) _Pragma("unroll") for (int m = 0; m < 4; ++m) _Pragma("unroll") for (int bj = 0; bj < 2; ++bj) \
            apply(row0 + ai * 128 + m * 16, col0 + bj * 128, acc[ai][bj][m][0], acc[ai][bj][m][1]); }

__device__ __forceinline__ void unpack8(const v4u u, float (&f)[8]) { f[0] = bf_lo(u.x); f[1] = bf_hi(u.x); f[2] = bf_lo(u.y); f[3] = bf_hi(u.y); f[4] = bf_lo(u.z); f[5] = bf_hi(u.z); f[6] = bf_lo(u.w); f[7] = bf_hi(u.w); }
__device__ __forceinline__ v4u pack8u(const float (&f)[8]) { v4u u; u.x = cvt_pk_bf16(f[0], f[1]); u.y = cvt_pk_bf16(f[2], f[3]); u.z = cvt_pk_bf16(f[4], f[5]); u.w = cvt_pk_bf16(f[6], f[7]); return u; }

struct EpiLora {
    static constexpr bool HOOK = false; int hook_t;
    float* Wd; const bf16* KX; bf16* K2; const bf16* KK; bf16* Bb; bf16* Gb; const float* w0; const float* a0; const float* ka;
    __device__ __forceinline__ void apply(int row, int col, f32x4 v0, f32x4 v1) const {
        const int ty = col >> 9, c = col & 511; const size_t o = (size_t)row * MIX + c;
        const float acc[8] = {v0[0], v0[1], v0[2], v0[3], v1[0], v1[1], v1[2], v1[3]};
        if (ty == 0) { const f32x4 b0 = *(const f32x4*)(w0 + c), b1 = *(const f32x4*)(w0 + c + 4); f32x4 o0, o1;
#pragma unroll
            for (int j = 0; j < 4; ++j) { o0[j] = __expf(-0.6065306597126334f * sigmoidf_(b0[j] + acc[j])); o1[j] = __expf(-0.6065306597126334f * sigmoidf_(b1[j] + acc[4 + j])); }
            *(f32x4*)(Wd + o) = o0; *(f32x4*)(Wd + o + 4) = o1;
        } else if (ty == 1) { const f32x4 b0 = *(const f32x4*)(a0 + c), b1 = *(const f32x4*)(a0 + c + 4), k0 = *(const f32x4*)(ka + c), k1 = *(const f32x4*)(ka + c + 4);
            float k[8], kk[8], k2[8], bb[8]; unpack8(*(const v4u*)(KX + o), k); unpack8(*(const v4u*)(KK + o), kk);
#pragma unroll
            for (int j = 0; j < 8; ++j) { const float a = sigmoidf_((j < 4 ? b0[j & 3] : b1[j & 3]) + acc[j]); k2[j] = k[j] * (1.0f + (a - 1.0f) * (j < 4 ? k0[j & 3] : k1[j & 3])); bb[j] = kk[j] * a; }
            *(v4u*)(K2 + o) = pack8u(k2); *(v4u*)(Bb + o) = pack8u(bb);
        } else { *(v4u*)(Gb + o) = pack8u(acc); }
    }
    EPI_BIG_OPERATOR()
};
struct EpiPool {
    static constexpr bool HOOK = false; int hook_t;
    bf16* ORP; const float* scale;
    __device__ __forceinline__ void apply(int row, int col, f32x4 v0, f32x4 v1) const {
        const f32x4 s0 = *(const f32x4*)(scale + col), s1 = *(const f32x4*)(scale + col + 4); v0 *= s0; v1 *= s1;
        v4u w; w.x = cvt_pk_bf16(v0[0], v0[1]); w.y = cvt_pk_bf16(v0[2], v0[3]); w.z = cvt_pk_bf16(v1[0], v1[1]); w.w = cvt_pk_bf16(v1[2], v1[3]);
        *(v4u*)(ORP + (size_t)row * D + MIX + col) = w;
    }
    EPI_BIG_OPERATOR()
};
struct EpiVmix {
    static constexpr bool HOOK = false; int hook_t;
    const bf16* VX; bf16* V; const bf16* VF; const float* v0p;
    __device__ __forceinline__ void apply(int row, int col, f32x4 a0_, f32x4 a1_) const {
        const size_t o = (size_t)row * MIX + col; const f32x4 b0 = *(const f32x4*)(v0p + col), b1 = *(const f32x4*)(v0p + col + 4);
        const float acc[8] = {a0_[0], a0_[1], a0_[2], a0_[3], a1_[0], a1_[1], a1_[2], a1_[3]};
        float v[8], vf[8], r[8]; unpack8(*(const v4u*)(VX + o), v); unpack8(*(const v4u*)(VF + o), vf);
#pragma unroll
        for (int j = 0; j < 8; ++j) r[j] = v[j] + (vf[j] - v[j]) * sigmoidf_((j < 4 ? b0[j & 3] : b1[j & 3]) + acc[j]);
        *(v4u*)(V + o) = pack8u(r);
    }
    EPI_BIG_OPERATOR()
};

#define MFMA16(a, b, c) __builtin_amdgcn_mfma_f32_16x16x32_bf16((a), (b), (c), 0, 0, 0)
template <class Epi>
__device__ __forceinline__ void sgemm_tiles(LAS unsigned char* lds, const bf16* A, const bf16* Bt, int N, int K, const Epi& E, int t0, int tstep, int tend, const int wave_u) {
    const int tid = launder_tid(wave_u), wid = __builtin_amdgcn_readfirstlane(tid >> 6), lane = tid & 63, fr = lane & 15, fq = lane >> 4, wm = wid & 3, wn = wid >> 2;
    int R, C; pg8::stage_rc(tid * 16, R, C);
    const int Rb = (R & ~31) + pg8::perm32(R & 31);
    const unsigned ldsw = (unsigned)wid * 1024u;
    const int aoff = pg8::lds_byte(wm * 16 + fr, fq * 8), boff = 8192 + pg8::lds_byte(wn * 32 + fr, fq * 8);
    const int nk = K / 64;
#define SG_STAGE(slot, kt) do { __builtin_amdgcn_global_load_lds((const unsigned*)(ag + (size_t)(kt) * 64), (LAS unsigned*)(lds + (slot) * 16384 + ldsw), 16, 0, 0); \
                                __builtin_amdgcn_global_load_lds((const unsigned*)(bg + (size_t)(kt) * 64), (LAS unsigned*)(lds + (slot) * 16384 + 8192 + ldsw), 16, 0, 0); } while (0)
    for (int t = t0; t < tend; t += tstep) {
        const int rt = t & 15, ct = t >> 4, r0 = MP + 64 * rt, c0 = 64 * ct;
        const bf16* ag = A + (size_t)(r0 + R) * K + C; const bf16* bg = Bt + (size_t)(c0 + Rb) * K + C;
        f32x4 acc0 = (f32x4){0.f, 0.f, 0.f, 0.f}, acc1 = acc0;
        SG_STAGE(0, 0); SG_STAGE(1, 1); SG_STAGE(2, 2);
        for (int kt = 0; kt < nk; ++kt) {
            if (kt + 2 < nk) asm volatile("s_waitcnt vmcnt(4)" ::: "memory"); else if (kt + 1 < nk) asm volatile("s_waitcnt vmcnt(2)" ::: "memory"); else asm volatile("s_waitcnt vmcnt(0)" ::: "memory");
            __builtin_amdgcn_s_barrier();
            if (kt + 3 < nk) SG_STAGE((kt + 3) & 3, kt + 3);
            if constexpr (Epi::HOOK) { if (kt == E.hook_t) E.hook_apply(r0 + wm * 16 + fr, c0 + wn * 32 + 8 * fq, acc0, acc1); }
            const LAS unsigned char* sl = lds + (kt & 3) * 16384;
            const bf16x8 a0 = *(const LAS bf16x8*)(sl + aoff), a1 = *(const LAS bf16x8*)(sl + aoff + 1024);
            const bf16x8 b00 = *(const LAS bf16x8*)(sl + boff), b01 = *(const LAS bf16x8*)(sl + boff + 1024), b10 = *(const LAS bf16x8*)(sl + boff + 2048), b11 = *(const LAS bf16x8*)(sl + boff + 3072);
            acc0 = MFMA16(b00, a0, acc0); acc1 = MFMA16(b10, a0, acc1);
            acc0 = MFMA16(b01, a1, acc0); acc1 = MFMA16(b11, a1, acc1);
        }
        E.apply(r0 + wm * 16 + fr, c0 + wn * 32 + 8 * fq, acc0, acc1);
        __builtin_amdgcn_s_barrier();
    }
#undef SG_STAGE
}

#define XB_TMO      128
#define XB_XCNT(j)  (256  + 64 * (j))
#define XB_XSUB(j)  (1280 + 64 * (j))
#define XB_XGEN(j)  (2304 + 64 * (j))
#define XB_TOP      3328
#define XB_TOPGEN   3392
#define XCD_BAR_WORDS 3456
#define XB_SPIN_CAP (1u << 22)

__device__ __forceinline__ unsigned xb_ld(unsigned* p)              { return __hip_atomic_load(p, __ATOMIC_RELAXED, __HIP_MEMORY_SCOPE_AGENT); }
__device__ __forceinline__ unsigned xb_add(unsigned* p, unsigned v) { return __hip_atomic_fetch_add(p, v, __ATOMIC_RELAXED, __HIP_MEMORY_SCOPE_AGENT); }
__device__ __forceinline__ unsigned xb_xcc_id() { return (unsigned)__builtin_amdgcn_s_getreg((3 << 11) | 20) & 0xFu; }
#define XB_SPIN(cond, bar) do { unsigned _sp = 0; while (cond) { __builtin_amdgcn_s_sleep(1); \
    if ((++_sp & 255u) == 0u) { if (xb_ld(&(bar)[XB_TMO])) break; if (_sp > XB_SPIN_CAP) { atomicAdd(&(bar)[XB_TMO], 1u); break; } } } } while (0)

struct XcdBarrier { unsigned* bar; unsigned x; volatile LAS unsigned* st; };

__device__ __forceinline__ XcdBarrier xcd_barrier_post(unsigned* bar, volatile LAS unsigned* st, const int wave_u) {
    XcdBarrier b; b.bar = bar; b.x = xb_xcc_id(); b.st = st;
    if (wave_u == 0 && lane_id_() == 0) (void)xb_add(&bar[XB_XCNT(b.x)], 1u);
    return b;
}
__device__ __forceinline__ void xcd_barrier_complete(unsigned* bar, unsigned x, unsigned& nloc, unsigned& nx) {
    const unsigned G = gridDim.x * gridDim.y * gridDim.z;
    unsigned sum, cnt, mine, sp = 0u;
    for (;;) {
        sum = 0u; cnt = 0u; mine = 0u;
#pragma unroll
        for (unsigned j = 0; j < 16; ++j) { const unsigned c = xb_ld(&bar[XB_XCNT(j)]); sum += c; cnt += (c > 0u) ? 1u : 0u; mine = (j == x) ? c : mine; }
        if (sum == G) break;
        __builtin_amdgcn_s_sleep(1);
        if ((++sp & 255u) == 0u) { if (xb_ld(&bar[XB_TMO])) break; if (sp > XB_SPIN_CAP) { atomicAdd(&bar[XB_TMO], 1u); break; } }
    }
    nloc = mine > 0u ? mine : 1u; nx = cnt > 0u ? cnt : 1u;
}
__device__ __forceinline__ void xcd_barrier(const XcdBarrier& b, const int wave_u) {
    asm volatile("s_waitcnt vmcnt(0)" ::: "memory");
    __syncthreads();
    if (wave_u == 0 && lane_id_() == 0) {
        unsigned* bar = b.bar;
        __builtin_amdgcn_s_waitcnt(0);
        unsigned nloc = b.st[0], nx = b.st[1];
        if (nloc == 0u) { xcd_barrier_complete(bar, b.x, nloc, nx); b.st[0] = nloc; b.st[1] = nx; }
        const unsigned old = xb_add(&bar[XB_XSUB(b.x)], 1u);
        const unsigned gen = old / nloc;
        if (old + 1u == (gen + 1u) * nloc) {
            __builtin_amdgcn_fence(__ATOMIC_RELEASE, "agent");
            asm volatile("s_waitcnt vmcnt(0)" ::: "memory");
            const unsigned og = xb_add(&bar[XB_TOP], 1u);
            const unsigned tg = og / nx;
            if (og + 1u == (tg + 1u) * nx) xb_add(&bar[XB_TOPGEN], 1u);
            else XB_SPIN(xb_ld(&bar[XB_TOPGEN]) == tg, bar);
            __builtin_amdgcn_fence(__ATOMIC_ACQUIRE, "agent");
            xb_add(&bar[XB_XGEN(b.x)], 1u);
            asm volatile("s_waitcnt vmcnt(0)" ::: "memory");
        } else {
            XB_SPIN(xb_ld(&bar[XB_XGEN(b.x)]) == gen, bar);
            __builtin_amdgcn_fence(__ATOMIC_ACQUIRE, "agent");
            asm volatile("s_waitcnt vmcnt(0)" ::: "memory");
        }
    }
    __syncthreads();
}

__device__ __forceinline__ bf16x8 cl_frag(const f32x4 c) { v4u u; u.x = cvt_pk_bf16(c[0], c[1]); u.y = cvt_pk_bf16(c[2], c[3]); u.z = 0u; u.w = 0u; return __builtin_bit_cast(bf16x8, u); }
__device__ __forceinline__ bf16x8 cl2_frag(const f32x4 a, const f32x4 b) { v4u u; u.x = cvt_pk_bf16(a[0], a[1]); u.y = cvt_pk_bf16(a[2], a[3]); u.z = cvt_pk_bf16(b[0], b[1]); u.w = cvt_pk_bf16(b[2], b[3]); return __builtin_bit_cast(bf16x8, u); }
__device__ __forceinline__ bf16x8 sel_frag(int c, int ks, int n, int q) {
    const int js = 16 * c + n - 32 * ks - 8 * q, d = js >> 1; const unsigned val = 0x3F80u << (16 * (js & 1));
    v4u u; u.x = d == 0 ? val : 0u; u.y = d == 1 ? val : 0u; u.z = d == 2 ? val : 0u; u.w = d == 3 ? val : 0u; return __builtin_bit_cast(bf16x8, u);
}
__device__ __forceinline__ unsigned char* chk_unit_ptr(unsigned char* ws, int u) {
    if (u < CHK_NA) return ws + WS_H + (size_t)u * CHK_UNIT;
    u -= CHK_NA; if (u < CHK_NB) return ws + WS_Y + (size_t)u * CHK_UNIT;
    u -= CHK_NB; if (u < CHK_NC) return ws + WS_CHKC + (size_t)u * CHK_UNIT;
    u -= CHK_NC; return ws + WS_WIN + (size_t)u * CHK_UNIT;
}
#define F4Z ((f32x4){0.f, 0.f, 0.f, 0.f})

struct Args { const float* in[N_IN]; float* out; unsigned char* ws; int ph_lo, ph_hi, dup, pad; };

__device__ __forceinline__ void transpose_item(const float* W, int N, bf16* WT, int ldt, int item, LAS float* scr, int lane) {
    const int nblk = N / 32, kb = item / nblk, nb = item % nblk, k0 = 64 * kb, n0 = 32 * nb;
#pragma unroll 8
    for (int i = 0; i < 32; ++i) { const int kk = 2 * i + (lane >> 5); scr[kk * 33 + (lane & 31)] = W[(size_t)(k0 + kk) * N + n0 + (lane & 31)]; }
    LDS_WAIT(); asm volatile("" ::: "memory");
    const int c = lane & 7;
#pragma unroll
    for (int j = 0; j < 4; ++j) { const int n = (lane >> 3) + 8 * j; const LAS float* s = scr + (8 * c) * 33 + n;
        v4u o; o.x = cvt_pk_bf16(s[0 * 33], s[1 * 33]); o.y = cvt_pk_bf16(s[2 * 33], s[3 * 33]); o.z = cvt_pk_bf16(s[4 * 33], s[5 * 33]); o.w = cvt_pk_bf16(s[6 * 33], s[7 * 33]);
        *(v4u*)(WT + (size_t)(n0 + n) * ldt + k0 + 8 * c) = o; }
    LDS_WAIT(); asm volatile("" ::: "memory");
}

__device__ __forceinline__ void load_xl8(const bf16* prow, const bf16* pprev, const float* mu, float (&o)[8]) {
    const v4u cu = *(const v4u*)prow, pu = *(const v4u*)pprev;
    const f32x4 m0 = *(const f32x4*)mu, m1 = *(const f32x4*)(mu + 4);
    const float cur[8] = {bf_lo(cu.x), bf_hi(cu.x), bf_lo(cu.y), bf_hi(cu.y), bf_lo(cu.z), bf_hi(cu.z), bf_lo(cu.w), bf_hi(cu.w)};
    const float pv[8] = {bf_lo(pu.x), bf_hi(pu.x), bf_lo(pu.y), bf_hi(pu.y), bf_lo(pu.z), bf_hi(pu.z), bf_lo(pu.w), bf_hi(pu.w)};
#pragma unroll
    for (int i = 0; i < 4; ++i) { o[i] = cur[i] + (pv[i] - cur[i]) * m0[i]; o[4 + i] = cur[4 + i] + (pv[4 + i] - cur[4 + i]) * m1[i]; }
}
__device__ __forceinline__ void load_xl4(const bf16* prow, const bf16* pprev, const float* mu, float (&o)[4]) {
    const v2u cu = *(const v2u*)prow, pu = *(const v2u*)pprev; const f32x4 m0 = *(const f32x4*)mu;
    const float cur[4] = {bf_lo(cu.x), bf_hi(cu.x), bf_lo(cu.y), bf_hi(cu.y)}, pv[4] = {bf_lo(pu.x), bf_hi(pu.x), bf_lo(pu.y), bf_hi(pu.y)};
#pragma unroll
    for (int i = 0; i < 4; ++i) o[i] = cur[i] + (pv[i] - cur[i]) * m0[i];
}
__device__ __forceinline__ bf16x8 pack8(const float (&f)[8]) {
    v4u u; u.x = cvt_pk_bf16(f[0], f[1]); u.y = cvt_pk_bf16(f[2], f[3]); u.z = cvt_pk_bf16(f[4], f[5]); u.w = cvt_pk_bf16(f[6], f[7]);
    return __builtin_bit_cast(bf16x8, u);
}
__device__ __forceinline__ v2u pack4(float a, float b, float c, float d) { v2u u; u.x = cvt_pk_bf16(a, b); u.y = cvt_pk_bf16(c, d); return u; }

__device__ __forceinline__ const float* arg_in(const Args& a, int i) { asm volatile("" : "+s"(i)); return a.in[i]; }
__global__ void __launch_bounds__(NTHR, 2) mk_fwd(Args args) {
    extern __shared__ __attribute__((aligned(16))) unsigned char lds_raw[];
    LAS unsigned char* lds = (LAS unsigned char*)lds_raw;
    const int G = gridDim.x, NGW = G * NWAVES;
#define PH_IDS() const int tid = launder_tid(wave_u), lane = tid & 63, wave = __builtin_amdgcn_readfirstlane(tid >> 6), gw = blockIdx.x * NWAVES + wave; LAS float* scr = (LAS float*)(lds + wave * 16384); (void)lane; (void)gw; (void)scr
    unsigned* ctl = (unsigned*)(args.ws + WS_CTL);
    volatile LAS unsigned* MISC = (volatile LAS unsigned*)(lds + MISC_OFF);
    const int wave_u = __builtin_amdgcn_readfirstlane((int)threadIdx.x >> 6);
    for (int u = wave_u * 64 + lane_id_(); u < (LDS_BYTES - LDSCTL_OFF) / 4; u += NTHR) ((LAS unsigned*)(lds + LDSCTL_OFF))[u] = 0u;
    __syncthreads();
    const int lo = args.ph_lo, hi = args.ph_hi;
    XcdBarrier bar; bar.bar = ctl + CW_BAR; bar.x = 0; bar.st = nullptr;
    if (hi - lo > 1) bar = xcd_barrier_post(ctl + CW_BAR, MISC + 8, wave_u);
#define IN(k) (lo <= (k) && (k) < hi)
#define SEAM(k) do { if (IN(k) && IN((k) + 1)) { xcd_barrier(bar, wave_u); if (args.dup == 99) xcd_barrier(bar, wave_u); } } while (0)
#define SAMPLE_TILES(Abuf, Btp, N_, K_, E_, nbig) do { const int nt_ = 16 * ((N_) / 64), rem_ = (nbig) % G; int first_ = 0, cnt_ = G; if (rem_ > 0 && rem_ <= G / 2) { first_ = rem_; cnt_ = G - rem_; } \
        if ((int)blockIdx.x >= first_) sgemm_tiles(lds, Abuf, Btp, N_, K_, E_, (int)blockIdx.x - first_, cnt_, nt_, wave_u); } while (0)

#define PH_PTRS() unsigned char* ws = args.ws; float* out = args.out; int l = L_; asm volatile("" : "+s"(ws), "+s"(out), "+s"(l)); (void)l; \
    float* X = out + O_Y; \
    float* MOD = (float*)(ws + WS_MOD); \
    bf16* SC = (bf16*)(ws + WS_SC); \
    bf16* H = (bf16*)(ws + WS_H); \
    bf16* P = (bf16*)(ws + WS_P); \
    bf16* Rb = (bf16*)(ws + WS_R); bf16* K2b = (bf16*)(ws + WS_K2); bf16* Vb = (bf16*)(ws + WS_V); bf16* KKb = (bf16*)(ws + WS_KK); bf16* Bb = (bf16*)(ws + WS_B); \
    float* Wd = (float*)(ws + WS_W); \
    bf16* ORP = (bf16*)(ws + WS_ORP); bf16* Gb = (bf16*)(ws + WS_G); bf16* VF = (bf16*)(ws + WS_VF); \
    float* Y = (float*)(ws + WS_Y); \
    unsigned char* wl = ws + ((l & 1) ? (WS_WL2 - WS_WIN) : 0);                                       \
    bf16* WIN_T = (bf16*)(wl + WS_WIN); bf16* WBR_T = (bf16*)(wl + WS_WBR); bf16* WOUT_T = (bf16*)(wl + WS_WOUT); bf16* WFF1_T = (bf16*)(wl + WS_WFF1); bf16* WFF2_T = (bf16*)(wl + WS_WFF2); \
    bf16* WLORA_T = (bf16*)(wl + WS_WSM + SM_LORA); bf16* WPOOL_T = (bf16*)(wl + WS_WSM + SM_POOL); bf16* V12_T = (bf16*)(wl + WS_WSM + SM_V12); \
    bf16* POOLED = (bf16*)(ws + WS_POOLED); bf16* XA = (bf16*)(ws + WS_XA); \
    bf16* ADA_T = P; \
    (void)X; (void)MOD; (void)SC; (void)H; (void)P; (void)Rb; (void)K2b; (void)Vb; (void)KKb; (void)Bb; (void)Wd; (void)ORP; (void)Gb; (void)VF; (void)Y; (void)WIN_T; (void)WBR_T; (void)WOUT_T; (void)WFF1_T; (void)WFF2_T; (void)WLORA_T; (void)WPOOL_T; (void)V12_T; (void)POOLED; (void)XA; (void)ADA_T
#define ARG(i) arg_in(args, (i))
    int ph = 0, L_ = 0;
    if (IN(ph)) for (int rep_ = 0; rep_ < DUPN(10); ++rep_) { PH_PTRS(); PH_IDS();
        constexpr int I_ADA = (D / 64) * (3072 / 32);
        for (int it = gw; it < 8 * I_ADA; it += NGW) { const int mat = it / I_ADA, r = it % I_ADA, l = mat >> 1, which = mat & 1;
            const float* W = (which ? ARG(I_WADAMLP) : ARG(I_WADAMIX)) + (size_t)l * D * 3072;
            transpose_item(W, 3072, ADA_T + (size_t)mat * 3072 * D, D, r, scr, lane); }
        for (int r = gw; r < 256; r += NGW) {
            const float* c = r < NSEQ_P ? ARG(I_CP) + (size_t)r * D : ARG(I_CS) + (size_t)(r - NSEQ_P) * D;
#pragma unroll
            for (int j = 0; j < 4; ++j) { f32x4 v = (f32x4){0.f, 0.f, 0.f, 0.f}; if (r < NSEQ) v = *(const f32x4*)(c + 4 * lane + 256 * j);
#pragma unroll
                for (int i = 0; i < 4; ++i) v[i] = v[i] * sigmoidf_(v[i]);
                *(v2u*)(SC + (size_t)r * D + 4 * lane + 256 * j) = pack4(v[0], v[1], v[2], v[3]); } }
        for (int m = gw; m < M; m += NGW) {
            const float* src = m < MP ? ARG(I_XP) + (size_t)m * D : ARG(I_XS) + (size_t)(m - MP) * D;
#pragma unroll
            for (int j = 0; j < 4; ++j) *(f32x4*)(X + (size_t)m * D + 4 * lane + 256 * j) = *(const f32x4*)(src + 4 * lane + 256 * j); }
    }
    SEAM(ph); ++ph;
    if (IN(ph)) for (int rep_ = 0; rep_ < DUPN(11); ++rep_) { PH_PTRS();
        pg8::Gemm g{SC, ADA_T, 256, MODW, D}; pg8::StaticOrder S; S.init(256, MODW, G, (int)blockIdx.x);
        EpiMod E{0, MOD, ARG(I_BADAMIX), ARG(I_BADAMLP)};
        pg8::gemm_phase<EpiMod, pg8::StaticOrder, true, true>(lds, g, S, E, wave_u);
    }
    SEAM(ph); ++ph;

    for (L_ = 0; L_ < DEPTH; ++L_) {
#define modmix (MOD + (size_t)(2 * l) * 3072)
#define modmlp (MOD + (size_t)(2 * l + 1) * 3072)
        if (IN(ph)) for (int rep_ = 0; rep_ < DUPN(0); ++rep_) { PH_PTRS(); PH_IDS();
#define CONVERT_WEIGHTS(LL, VB, NVB) do { const int LL_ = (LL); unsigned char* wl_ = ws + ((LL_ & 1) ? (WS_WL2 - WS_WIN) : 0); \
            bf16* WIN_T = (bf16*)(wl_ + WS_WIN); bf16* WBR_T = (bf16*)(wl_ + WS_WBR); bf16* WOUT_T = (bf16*)(wl_ + WS_WOUT); bf16* WFF1_T = (bf16*)(wl_ + WS_WFF1); bf16* WFF2_T = (bf16*)(wl_ + WS_WFF2); \
            bf16* WLORA_T = (bf16*)(wl_ + WS_WSM + SM_LORA); bf16* WPOOL_T = (bf16*)(wl_ + WS_WSM + SM_POOL); bf16* V12_T = (bf16*)(wl_ + WS_WSM + SM_V12); \
            constexpr int N_IN_ = (D / 64) * (IN_COLS / 32), N_BR = (MIX / 64) * (D / 32), N_OUT = (D / 64) * (D / 32), N_F1 = (D / 64) * (DFF / 32), N_F2 = (DFF / 64) * (D / 32); \
            constexpr int TOT = N_IN_ + 2 * N_BR + N_OUT + N_F1 + N_F2; \
            for (int it = (VB) * NWAVES + wave; it < TOT; it += (NVB) * NWAVES) { int r = it; \
                if (r < N_IN_) { transpose_item(ARG(I_WIN) + (size_t)LL_ * D * IN_COLS, IN_COLS, WIN_T, D, r, scr, lane); continue; } r -= N_IN_; \
                if (r < N_BR) { transpose_item(ARG(I_WBRR) + (size_t)LL_ * MIX * D, D, WBR_T, D, r, scr, lane); continue; } r -= N_BR; \
                if (r < N_BR) { transpose_item(ARG(I_WBRP) + (size_t)LL_ * POOLW * D, D, WBR_T + MIX, D, r, scr, lane); continue; } r -= N_BR; \
                if (r < N_OUT) { transpose_item(ARG(I_WOUT) + (size_t)LL_ * D * D, D, WOUT_T, D, r, scr, lane); continue; } r -= N_OUT; \
                if (r < N_F1) { transpose_item(ARG(I_WFF1) + (size_t)LL_ * D * DFF, DFF, WFF1_T, D, r, scr, lane); continue; } r -= N_F1; \
                transpose_item(ARG(I_WFF2) + (size_t)LL_ * DFF * D, D, WFF2_T, DFF, r, scr, lane); } \
            { const float* w2 = ARG(I_W2) + (size_t)LL_ * 64 * MIX; const float* a2 = ARG(I_A2) + (size_t)LL_ * 64 * MIX; const float* g2 = ARG(I_G2) + (size_t)LL_ * 128 * MIX; \
              const float* pw = ARG(I_POOLW) + (size_t)LL_ * 4 * PGRP * PGRP; \
              const int gt = (VB) * NTHR + tid, GT = (NVB) * NTHR; \
              for (int e = gt; e < 1536 * 256; e += GT) { const int n = e >> 8, k = e & 255, ty = n >> 9, nn = n & 511; float v = 0.f; \
                  if (ty == 0) { if (k < 64) v = w2[(size_t)k * MIX + nn]; } else if (ty == 1) { if (k >= 64 && k < 128) v = a2[(size_t)(k - 64) * MIX + nn]; } else { if (k >= 128) v = g2[(size_t)(k - 128) * MIX + nn]; } \
                  WLORA_T[e] = (bf16)(cvt_pk_bf16(v, 0.f) & 0xffffu); } \
              for (int e = gt; e < 512 * 512; e += GT) { const int d = e >> 9, k = e & 511, g = d >> 7; float v = 0.f; \
                  if ((k >> 7) == g) v = pw[((size_t)g * PGRP + (k & 127)) * PGRP + (d & 127)]; \
                  WPOOL_T[e] = (bf16)(cvt_pk_bf16(v, 0.f) & 0xffffu); } \
              if (LL_ > 0) { const float* v1 = ARG(I_V1) + (size_t)(LL_ - 1) * MIX * 32; const float* v2 = ARG(I_V2) + (size_t)(LL_ - 1) * 32 * MIX; \
                  for (int e = gt; e < 512 * 512; e += GT) { const int n = e >> 9, k = e & 511; float acc = 0.f; \
                      _Pragma("unroll 8") for (int j = 0; j < 32; ++j) acc += v1[(size_t)k * 32 + j] * v2[(size_t)j * MIX + n]; \
                      V12_T[e] = (bf16)(cvt_pk_bf16(acc, 0.f) & 0xffffu); } } } } while (0)
            if (l == 0) CONVERT_WEIGHTS(0, (int)blockIdx.x, G);
            {
                bf16* SH0 = (bf16*)(ws + WS_SH0); bf16* PH0 = (bf16*)(ws + WS_PH0);
                const float* ss = ARG(I_SSHIFT) + (size_t)l * NSEQ_S * RWKV_COLS; const float* sp = ARG(I_SPOOL) + (size_t)l * NSEQ_S * PBUF * POOLW;
                for (int e = blockIdx.x * NTHR + tid; e < NSEQ * RWKV_COLS / 2; e += G * NTHR) { const int e2 = 2 * e - NSEQ_P * RWKV_COLS;
                    *(unsigned*)(SH0 + 2 * e) = e2 >= 0 ? cvt_pk_bf16(ss[e2], ss[e2 + 1]) : 0u; }
                for (int e = blockIdx.x * NTHR + tid; e < NSEQ * PBUF * POOLW / 2; e += G * NTHR) { const int e2 = 2 * e - NSEQ_P * PBUF * POOLW;
                    *(unsigned*)(PH0 + 2 * e) = e2 >= 0 ? cvt_pk_bf16(sp[e2], sp[e2 + 1]) : 0u; }
            }
            const float* nw = ARG(I_NORMMIX) + (size_t)l * D;
            for (int m = gw; m < M; m += NGW) {
                const float* xr = X + (size_t)m * D; const float* mo = modmix + (size_t)row_seq(m) * MODW;
                f32x4 v[4]; float s = 0.f;
#pragma unroll
                for (int j = 0; j < 4; ++j) { v[j] = *(const f32x4*)(xr + 4 * lane + 256 * j); s += (v[j][0] * v[j][0] + v[j][1] * v[j][1]) + (v[j][2] * v[j][2] + v[j][3] * v[j][3]); }
                const float rstd = 1.0f / sqrtf(wave_sum(s) * (1.0f / D) + 1e-6f);
#pragma unroll
                for (int j = 0; j < 4; ++j) { const int c = 4 * lane + 256 * j; const f32x4 g = *(const f32x4*)(nw + c), sh = *(const f32x4*)(mo + c), sc = *(const f32x4*)(mo + 1024 + c);
                    f32x4 o;
#pragma unroll
                    for (int i = 0; i < 4; ++i) o[i] = v[j][i] * rstd * g[i] * (1.0f + sc[i]) + sh[i];
                    *(v2u*)(H + (size_t)m * D + c) = pack4(o[0], o[1], o[2], o[3]); }
            }
        }
        SEAM(ph); ++ph;
        if (IN(ph)) for (int rep_ = 0; rep_ < DUPN(1); ++rep_) { PH_PTRS();
            pg8::Gemm g{H, WIN_T, MP, IN_COLS, D}; pg8::StaticOrder S; S.init(MP, IN_COLS, G, (int)blockIdx.x);
            EpiStoreBf16 E{0, P, IN_COLS, 0};
            pg8::gemm_phase<EpiStoreBf16, pg8::StaticOrder, true, true>(lds, g, S, E, wave_u);
            SAMPLE_TILES(H, WIN_T, IN_COLS, D, E, (MP / 256) * (IN_COLS / 256));
        }
        SEAM(ph); ++ph;
        if (IN(ph)) for (int rep_ = 0; rep_ < DUPN(2); ++rep_) { PH_PTRS(); PH_IDS();
            const float* spool = ARG(I_SPOOL) + (size_t)l * NSEQ_S * PBUF * POOLW; const float* mu = ARG(I_MU) + (size_t)l * RWKV_COLS; const float* kkw = ARG(I_KK) + (size_t)l * MIX;
            const bf16* SH0 = (const bf16*)(ws + WS_SH0); const bf16* PH0 = (const bf16*)(ws + WS_PH0);
            for (int idx = blockIdx.x * NTHR + tid; idx < NSEQ * (RWKV_COLS / 4 + PBUF * POOLW / 4); idx += G * NTHR) {
                if (idx < NSEQ * (RWKV_COLS / 4)) {
                    const int seq = idx / (RWKV_COLS / 4), c = 4 * (idx % (RWKV_COLS / 4));
                    const int mlast = seq < NSEQ_P ? seq * T_P + T_P - 1 : MP + (seq - NSEQ_P) * T_S + T_S - 1;
                    const v2u u = *(const v2u*)(P + (size_t)mlast * IN_COLS + c);
                    float* so = seq < NSEQ_P ? out + O_SHP + ((size_t)l * NSEQ_P + seq) * RWKV_COLS + c : out + O_SHS + ((size_t)l * NSEQ_S + (seq - NSEQ_P)) * RWKV_COLS + c;
                    *(f32x4*)so = (f32x4){bf_lo(u.x), bf_hi(u.x), bf_lo(u.y), bf_hi(u.y)};
                } else {
                    const int r = idx - NSEQ * (RWKV_COLS / 4), seq = r / (PBUF * POOLW / 4), rem = r % (PBUF * POOLW / 4), i = rem / (POOLW / 4), c = 4 * (rem % (POOLW / 4));
                    f32x4 v;
                    if (seq >= NSEQ_P && i < 7) v = *(const f32x4*)(spool + ((size_t)(seq - NSEQ_P) * PBUF + 8 + i) * POOLW + c);
                    else { const int row = seq < NSEQ_P ? seq * T_P + T_P - 15 + i : MP + (seq - NSEQ_P) * T_S + i - 7;
                        const v2u u = *(const v2u*)(P + (size_t)row * IN_COLS + C_PP + c); v = (f32x4){bf_lo(u.x), bf_hi(u.x), bf_lo(u.y), bf_hi(u.y)}; }
                    float* po = seq < NSEQ_P ? out + O_POP + (((size_t)l * NSEQ_P + seq) * PBUF + i) * POOLW + c : out + O_POS + (((size_t)l * NSEQ_S + (seq - NSEQ_P)) * PBUF + i) * POOLW + c;
                    *(f32x4*)po = v;
                }
            }
            for (int m = gw; m < M; m += NGW) {
                const int seq = row_seq(m), t = row_t(m);
                const bf16* prow = P + (size_t)m * IN_COLS; const bf16* pprev = t > 0 ? prow - IN_COLS : SH0 + (size_t)seq * RWKV_COLS;
                const int c8 = 8 * lane; const size_t o = (size_t)m * MIX + c8;
                float xr[8], xk[8], xv[8];
                load_xl8(prow + C_R + c8, pprev + C_R + c8, mu + C_R + c8, xr);
                load_xl8(prow + C_K + c8, pprev + C_K + c8, mu + C_K + c8, xk);
                load_xl8(prow + C_V + c8, pprev + C_V + c8, mu + C_V + c8, xv);
                *(v4u*)(Rb + o) = pack8u(xr); *(v4u*)(H + (size_t)M * MIX + o) = pack8u(xk);
                { const v4u pv = pack8u(xv); if (l == 0) { *(v4u*)(Vb + o) = pv; *(v4u*)(VF + o) = pv; } else *(v4u*)(H + o) = pv; }
                { const f32x4 w0_ = *(const f32x4*)(kkw + c8), w1_ = *(const f32x4*)(kkw + c8 + 4); float kk[8]; float ss = 0.f;
#pragma unroll
                  for (int j = 0; j < 8; ++j) { kk[j] = xk[j] * (j < 4 ? w0_[j & 3] : w1_[j & 3]); ss += kk[j] * kk[j]; }
                  ss = row8_sum(ss);
                  const float rn = 1.0f / sqrtf(ss + 1e-12f);
#pragma unroll
                  for (int j = 0; j < 8; ++j) kk[j] *= rn;
                  *(v4u*)(KKb + o) = pack8u(kk); }
                if (lane < 32) { float xx[8]; load_xl8(prow + C_XW + c8, pprev + C_XW + c8, mu + C_XW + c8, xx);
#pragma unroll
                    for (int j = 0; j < 8; ++j) xx[j] = lane < 8 ? tanhf_(xx[j]) : (lane < 16 ? xx[j] : sigmoidf_(xx[j]));
                    *(v4u*)(XA + (size_t)m * 256 + c8) = pack8u(xx); }
                { const int win = 2 << (lane >> 4); float sum[8], cur[8];
                  unpack8(*(const v4u*)(prow + C_PP + c8), cur);
#pragma unroll
                  for (int j = 0; j < 8; ++j) sum[j] = cur[j];
#pragma unroll 5
                  for (int i = 1; i < 16; ++i) { if (i < win) { const int tt = t - i;
                      const bf16* src = tt >= 0 ? prow - (size_t)i * IN_COLS + C_PP + c8 : PH0 + ((size_t)seq * PBUF + (PBUF + tt)) * POOLW + c8;
                      float x[8]; unpack8(*(const v4u*)src, x);
#pragma unroll
                      for (int j = 0; j < 8; ++j) sum[j] += x[j]; } }
                  const float inv = 1.0f / (float)((seq < NSEQ_P && t + 1 < win) ? t + 1 : win);
#pragma unroll
                  for (int j = 0; j < 8; ++j) sum[j] = sum[j] * inv - cur[j];
                  *(v4u*)(POOLED + o) = pack8u(sum); }
            }
        }
        SEAM(ph); ++ph;
        if (IN(ph)) for (int rep_ = 0; rep_ < DUPN(13); ++rep_) { PH_PTRS();
            { pg8::Gemm g{XA, WLORA_T, M, 1536, 256}; pg8::StaticOrder S; S.init(M, 1536, G, (int)blockIdx.x);
              EpiLora E{0, Wd, H + (size_t)M * MIX, K2b, KKb, Bb, Gb, ARG(I_W0) + (size_t)l * MIX, ARG(I_A0) + (size_t)l * MIX, ARG(I_KA) + (size_t)l * MIX};
              pg8::gemm_phase<EpiLora, pg8::StaticOrder, true, true>(lds, g, S, E, wave_u); }
            { pg8::Gemm g{POOLED, WPOOL_T, M, 512, 512}; pg8::StaticOrder S; S.init(M, 512, G, (int)((blockIdx.x + 104) % G));
              EpiPool E{0, ORP, ARG(I_POOLS) + (size_t)l * POOLW};
              pg8::gemm_phase<EpiPool, pg8::StaticOrder, true, true>(lds, g, S, E, wave_u); }
            if (l > 0) { pg8::Gemm g{H, V12_T, M, 512, 512}; pg8::StaticOrder S; S.init(M, 512, G, (int)((blockIdx.x + 224) % G));
              EpiVmix E{0, H, Vb, VF, ARG(I_V0) + (size_t)(l - 1) * MIX};
              pg8::gemm_phase<EpiVmix, pg8::StaticOrder, true, true>(lds, g, S, E, wave_u); }
        }
        SEAM(ph); ++ph;
#define S2F_PROMPT_HEAD() do { \
            const int seq = (int)blockIdx.x >> 3, hd = (int)blockIdx.x & 7, ln = lane_fresh(), n = ln & 15, q = ln >> 4; \
            constexpr int NPR = 6, NS = 7, SLOT = 20736, FLG = NS * SLOT, NCH = T_P / 16; \
            const int mb = seq * T_P; \
            volatile LAS unsigned* prodc = (volatile LAS unsigned*)(lds + FLG);                  \
            volatile LAS unsigned* consc = (volatile LAS unsigned*)(lds + FLG + 64);             \
            if (tid < 32) ((LAS unsigned*)(lds + FLG))[tid] = 0u; \
            __syncthreads(); \
            if (wave >= 2) { const int pp = wave - 2;                                            \
                f32x4 wv_[2][2]; v4u kk_[2], bb_[2], kx_[2], rr_[2]; bf16x8 Vf[2]; \
                bf16x8 SEL[4][2]; _Pragma("unroll") for (int cc = 0; cc < 4; ++cc) { SEL[cc][0] = sel_frag(cc, 0, n, q); SEL[cc][1] = sel_frag(cc, 1, n, q); } \
                S2F_LOADIN(pp); \
                for (int c = pp; c < NCH; c += NPR) { \
                    LAS unsigned char* sl = lds + (c % NS) * SLOT; \
                    bf16x8 At[2], Rt[2], Bt[2], Kt[2], Bh[2], Kh[2]; float gmv[2][8]; \
                    _Pragma("unroll") for (int ks = 0; ks < 2; ++ks) { \
                        float kk[8], bb[8], kx[8], rr[8]; unpack8(kk_[ks], kk); unpack8(bb_[ks], bb); unpack8(kx_[ks], kx); unpack8(rr_[ks], rr); \
                        float a_[8], r_[8], b_[8], k_[8], bh_[8], kh_[8]; \
                        _Pragma("unroll") for (int j = 0; j < 8; ++j) { const float lw = __builtin_amdgcn_logf(wv_[ks][j >> 2][j & 3]);                   \
                            float L = lw; L += dpp_f<0x111>(L); L += dpp_f<0x112>(L); L += dpp_f<0x114>(L); L += dpp_f<0x118>(L); \
                            const float Le = row16_sum(lw), eC = __builtin_amdgcn_exp2f(L), gmj = __builtin_amdgcn_exp2f(Le); \
                            const float eP = __builtin_bit_cast(float, __builtin_amdgcn_update_dpp(0x3F800000, __builtin_bit_cast(int, eC), 0x111, 0xF, 0xF, false));     \
                            const float eI = __builtin_amdgcn_rcpf(eC), eE = gmj * eI; \
                            a_[j] = -kk[j] * eP; r_[j] = rr[j] * eC; b_[j] = bb[j] * eI; k_[j] = kx[j] * eI; bh_[j] = bb[j] * eE; kh_[j] = kx[j] * eE; gmv[ks][j] = gmj; } \
                        At[ks] = pack8(a_); Rt[ks] = pack8(r_); Bt[ks] = pack8(b_); Kt[ks] = pack8(k_); Bh[ks] = pack8(bh_); Kh[ks] = pack8(kh_); } \
                    const bf16x8 V0 = Vf[0], V1 = Vf[1]; \
                    if (c + NPR < NCH) S2F_LOADIN(c + NPR);                                       \
                    __builtin_amdgcn_sched_barrier(0); \
                    f32x4 Aab_cl = F4Z, Aab_op = F4Z, Aak_op = F4Z, Arb_op = F4Z, Ark_op = F4Z; \
                    _Pragma("unroll") for (int ks = 0; ks < 2; ++ks) { Aab_cl = MFMA16(At[ks], Bt[ks], Aab_cl); Aab_op = MFMA16(Bt[ks], At[ks], Aab_op); Aak_op = MFMA16(Kt[ks], At[ks], Aak_op); \
                        Arb_op = MFMA16(Bt[ks], Rt[ks], Arb_op); Ark_op = MFMA16(Kt[ks], Rt[ks], Ark_op); } \
                    f32x4 Top;                                                                    \
                    _Pragma("unroll") for (int r = 0; r < 4; ++r) { const int e = 4 * q + r; \
                        if (!(n < e)) Aab_cl[r] = 0.f; \
                        if (!(e < n)) { Aab_op[r] = 0.f; Aak_op[r] = 0.f; } \
                        if (!(e <= n)) { Arb_op[r] = 0.f; Ark_op[r] = 0.f; } \
                        Top[r] = Aab_op[r] + (e == n ? 1.0f : 0.0f); } \
                    f32x4 Zw[4], Zu[4], Vc[4], Bc[4], Kc[4]; \
                    _Pragma("unroll") for (int cc = 0; cc < 4; ++cc) { const bf16x8 s0 = SEL[cc][0], s1 = SEL[cc][1]; \
                        Zw[cc] = MFMA16(At[1], s1, MFMA16(At[0], s0, F4Z)); Vc[cc] = MFMA16(V1, s1, MFMA16(V0, s0, F4Z)); \
                        Bc[cc] = MFMA16(Bh[1], s1, MFMA16(Bh[0], s0, F4Z)); Kc[cc] = MFMA16(Kh[1], s1, MFMA16(Kh[0], s0, F4Z)); } \
                    { const bf16x8 ak = cl_frag(Aak_op); \
                      _Pragma("unroll") for (int vt = 0; vt < 4; ++vt) Zu[vt] = MFMA16(ak, cl_frag(Vc[vt]), F4Z); } \
                      \
                    { const bf16x8 ac = cl_frag(Aab_cl), ao = cl_frag(Aab_op); \
                      const f32x4 P2o = MFMA16(ac, ao, F4Z), P2c = MFMA16(ao, ac, F4Z); const bf16x8 p2c = cl_frag(P2c), p2o = cl_frag(P2o); \
                      const f32x4 P4o = MFMA16(p2c, p2o, F4Z), P4c = MFMA16(p2o, p2c, F4Z); const bf16x8 p4c = cl_frag(P4c); \
                      const f32x4 P8c = MFMA16(cl_frag(P4o), p4c, F4Z); \
                      Top = MFMA16(p2c, cl_frag(Top), Top); Top = MFMA16(p4c, cl_frag(Top), Top); Top = MFMA16(cl_frag(P8c), cl_frag(Top), Top); \
                      const bf16x8 tf = cl_frag(Top); \
                      _Pragma("unroll") for (int cc = 0; cc < 4; ++cc) { Zw[cc] = MFMA16(tf, cl_frag(Zw[cc]), F4Z); Zu[cc] = MFMA16(tf, cl_frag(Zu[cc]), F4Z); } } \
                      \
                    if (c >= NS) { const unsigned need = (unsigned)(c - NS + 1); while (consc[0] < need || consc[1] < need) __builtin_amdgcn_s_sleep(1); } \
                    asm volatile("" ::: "memory"); \
                    _Pragma("unroll") for (int tp = 0; tp < 4; ++tp) { const bf16x8 bf_ = cl_frag(Bc[tp]); \
                        const f32x4 m0_ = MFMA16(cl_frag(Zw[0]), bf_, F4Z), m1_ = MFMA16(cl_frag(Zw[1]), bf_, F4Z), m2_ = MFMA16(cl_frag(Zw[2]), bf_, F4Z), m3_ = MFMA16(cl_frag(Zw[3]), bf_, F4Z); \
                        *(LAS bf16x8*)(sl + (tp * 2 + 0) * 1024 + ln * 16) = cl2_frag(m0_, m1_); *(LAS bf16x8*)(sl + (tp * 2 + 1) * 1024 + ln * 16) = cl2_frag(m2_, m3_); \
                        *(LAS bf16x8*)(sl + 8192 + tp * 1024 + ln * 16) = cl2_frag(Bc[tp], Kc[tp]); \
                        *(LAS bf16x8*)(sl + 12288 + tp * 1024 + ln * 16) = cl2_frag(Zu[tp], Vc[tp]); } \
                    { const bf16x8 rb = cl_frag(Arb_op); f32x4 qT[4]; \
                      _Pragma("unroll") for (int cc = 0; cc < 4; ++cc) qT[cc] = MFMA16(cl_frag(Zw[cc]), rb, MFMA16(SEL[cc][1], Rt[1], MFMA16(SEL[cc][0], Rt[0], F4Z))); \
                      *(LAS bf16x8*)(sl + 16384 + ln * 16) = cl2_frag(qT[0], qT[1]); *(LAS bf16x8*)(sl + 16384 + 1024 + ln * 16) = cl2_frag(qT[2], qT[3]); } \
                    { const bf16x8 rbk = cl2_frag(Arb_op, Ark_op); f32x4 y0[4]; \
                      _Pragma("unroll") for (int vt = 0; vt < 4; ++vt) y0[vt] = MFMA16(rbk, cl2_frag(Zu[vt], Vc[vt]), F4Z); \
                      *(LAS bf16x8*)(sl + 18432 + ln * 16) = cl2_frag(y0[0], y0[1]); *(LAS bf16x8*)(sl + 18432 + 1024 + ln * 16) = cl2_frag(y0[2], y0[3]); } \
                    if (n == 0) { _Pragma("unroll") for (int ks = 0; ks < 2; ++ks) { *(LAS f32x4*)(sl + 20480 + (32 * ks + 8 * q) * 4) = (f32x4){gmv[ks][0], gmv[ks][1], gmv[ks][2], gmv[ks][3]}; \
                        *(LAS f32x4*)(sl + 20480 + (32 * ks + 8 * q + 4) * 4) = (f32x4){gmv[ks][4], gmv[ks][5], gmv[ks][6], gmv[ks][7]}; } } \
                    asm volatile("s_waitcnt lgkmcnt(0)" ::: "memory"); \
                    if (ln == 0) prodc[c % NS] = (unsigned)(c + 1); \
                } \
            } else { const int cw = wave;                                                         \
                f32x4 SA0 = F4Z, SA1 = F4Z, SA2 = F4Z, SA3 = F4Z, SB0 = F4Z, SB1 = F4Z, SB2 = F4Z, SB3 = F4Z; \
                float* yg = Wd + (size_t)mb * MIX + 64 * hd + 32 * cw + n;                       \
                for (int c = 0; c < NCH; ++c) { \
                    const LAS unsigned char* sl = lds + (c % NS) * SLOT; \
                    while (prodc[c % NS] != (unsigned)(c + 1)) __builtin_amdgcn_s_sleep(1); \
                    asm volatile("" ::: "memory"); \
                    const LAS float* gm = (const LAS float*)(sl + 20480); const LAS unsigned char* rdy = sl; \
                    S2F_SLICE(SA0, SA1, SA2, SA3, 2 * cw, 0); \
                    S2F_SLICE(SB0, SB1, SB2, SB3, 2 * cw + 1, 16); \
                    asm volatile("s_waitcnt lgkmcnt(0)" ::: "memory"); \
                    if (ln == 0) consc[cw] = (unsigned)(c + 1); \
                } \
                float* so = out + O_WKP + ((((size_t)l * NSEQ_P + seq) * NH + hd) * HS + 32 * cw + n) * HS + 4 * q; \
                *(f32x4*)so = SA0; *(f32x4*)(so + 16) = SA1; *(f32x4*)(so + 32) = SA2; *(f32x4*)(so + 48) = SA3; \
                so += 16 * HS; *(f32x4*)so = SB0; *(f32x4*)(so + 16) = SB1; *(f32x4*)(so + 32) = SB2; *(f32x4*)(so + 48) = SB3; \
            } \
            __syncthreads(); } while (0)
#define S2F_SLICE(T0, T1, T2, T3, vq, yoff) do { \
            const bf16x8 sf0 = cl2_frag(T0, T1), sf1 = cl2_frag(T2, T3); \
            const bf16x8 uvf = *(const LAS bf16x8*)(sl + 12288 + (vq) * 1024 + ln * 16); \
            const f32x4 n0_ = MFMA16(*(const LAS bf16x8*)(sl + 8192 + 0 * 1024 + ln * 16), uvf, F4Z), n1_ = MFMA16(*(const LAS bf16x8*)(sl + 8192 + 1 * 1024 + ln * 16), uvf, F4Z), \
                        n2_ = MFMA16(*(const LAS bf16x8*)(sl + 8192 + 2 * 1024 + ln * 16), uvf, F4Z), n3_ = MFMA16(*(const LAS bf16x8*)(sl + 8192 + 3 * 1024 + ln * 16), uvf, F4Z); \
            { const v2u yu = *(const LAS v2u*)(sl + 18432 + ((vq) >> 1) * 1024 + ln * 16 + 8 * ((vq) & 1)); f32x4 ya = (f32x4){bf_lo(yu.x), bf_hi(yu.x), bf_lo(yu.y), bf_hi(yu.y)}; \
              ya = MFMA16(*(const LAS bf16x8*)(sl + 16384 + ln * 16), sf0, ya); ya = MFMA16(*(const LAS bf16x8*)(sl + 16384 + 1024 + ln * 16), sf1, ya); \
              _Pragma("unroll") for (int r = 0; r < 4; ++r) yg[(size_t)(c * 16 + 4 * q + r) * MIX + (yoff)] = ya[r]; } \
            S2_UPD(T0, 0, n0_); S2_UPD(T1, 1, n1_); S2_UPD(T2, 2, n2_); S2_UPD(T3, 3, n3_); } while (0)
#define S2F_LOADIN(cc) do { const size_t o0_ = (size_t)(mb + (cc) * 16 + n) * MIX + 64 * hd + 8 * q; \
            _Pragma("unroll") for (int ks = 0; ks < 2; ++ks) { const size_t o_ = o0_ + 32 * ks; wv_[ks][0] = *(const f32x4*)(Wd + o_); wv_[ks][1] = *(const f32x4*)(Wd + o_ + 4); \
                kk_[ks] = *(const v4u*)(KKb + o_); bb_[ks] = *(const v4u*)(Bb + o_); kx_[ks] = *(const v4u*)(K2b + o_); rr_[ks] = *(const v4u*)(Rb + o_); Vf[ks] = *(const bf16x8*)(Vb + o_); } } while (0)
#define S2_UPD(SV, tile, NT) do { const f32x4 g4_ = *(const LAS f32x4*)(gm + 16 * (tile) + 4 * q); f32x4 c0_ = g4_ * SV + NT; \
            c0_ = MFMA16(*(const LAS bf16x8*)(rdy + ((tile) * 2 + 0) * 1024 + ln * 16), sf0, c0_); c0_ = MFMA16(*(const LAS bf16x8*)(rdy + ((tile) * 2 + 1) * 1024 + ln * 16), sf1, c0_); SV = c0_; } while (0)
        if (IN(ph)) for (int rep_ = 0; rep_ < DUPN(3); ++rep_) { PH_PTRS(); PH_IDS();
            if ((int)blockIdx.x < NSEQ_P * NH) { S2F_PROMPT_HEAD(); if (args.dup == 15) S2F_PROMPT_HEAD(); }
            else for (int rep2_ = 0; rep2_ < (args.dup == 16 ? 2 : 1); ++rep2_) {
            constexpr int SB_F = 5 * 512 + 128 + 2048;
            constexpr int O_KK = 512, O_NB = 1024, O_K = 1536, O_R = 2048, O_V = 2560, O_Y = 2688;
            LAS float* lbase = (LAS float*)lds;
            const int first = (int)blockIdx.x - NSEQ_P * NH, stride = G - NSEQ_P * NH, NIT = NSEQ_S * NH * 4;
            const int nit = first < NIT ? (NIT - first + stride - 1) / stride : 0;
            const bool is_ld = wave >= 4;
            const int rl = lane >> 4, kq = lane & 15, lrow = (wave & 3) * 4 + rl;
            const int j = tid - 256, js = j >> 4, jk = (j & 15) * 4, jr = j & 15;
            const bool sact = is_ld && js < T_S;
            f32x4 pw = F4Z; v2u pkk = (v2u){0u, 0u}, pb = pkk, pk = pkk, pr = pkk; unsigned short pv = 0;
#define IT_B(k) ((first + (k) * stride) >> 5)
#define IT_H(k) (((first + (k) * stride) >> 2) & 7)
#define IT_Q(k) ((first + (k) * stride) & 3)
#define SM_LOAD(k) do { if (sact) { const size_t mm = (size_t)(MP + IT_B(k) * T_S + js) * MIX + 64 * IT_H(k); pw = *(const f32x4*)(Wd + mm + jk); pkk = *(const v2u*)(KKb + mm + jk); pb = *(const v2u*)(Bb + mm + jk); \
                pk = *(const v2u*)(K2b + mm + jk); pr = *(const v2u*)(Rb + mm + jk); pv = Vb[mm + 16 * IT_Q(k) + jr]; } } while (0)
#define SM_STORE(bf) do { if (sact) { LAS float* b_ = lbase + (bf) * SB_F; *(LAS f32x4*)(b_ + js * 64 + jk) = pw; *(LAS f32x4*)(b_ + O_KK + js * 64 + jk) = (f32x4){bf_lo(pkk.x), bf_hi(pkk.x), bf_lo(pkk.y), bf_hi(pkk.y)}; \
                *(LAS f32x4*)(b_ + O_NB + js * 64 + jk) = (f32x4){-bf_lo(pb.x), -bf_hi(pb.x), -bf_lo(pb.y), -bf_hi(pb.y)}; *(LAS f32x4*)(b_ + O_K + js * 64 + jk) = (f32x4){bf_lo(pk.x), bf_hi(pk.x), bf_lo(pk.y), bf_hi(pk.y)}; \
                *(LAS f32x4*)(b_ + O_R + js * 64 + jk) = (f32x4){bf_lo(pr.x), bf_hi(pr.x), bf_lo(pr.y), bf_hi(pr.y)}; b_[O_V + js * 16 + jr] = bf_lo((unsigned)pv); } } while (0)
#define SM_YOUT(bf, k) do { if (sact) { const LAS float* y_ = lbase + (bf) * SB_F + O_Y + js * 256 + jr * 16; const f32x4 a_ = *(const LAS f32x4*)y_, b2_ = *(const LAS f32x4*)(y_ + 4), c_ = *(const LAS f32x4*)(y_ + 8), d_ = *(const LAS f32x4*)(y_ + 12); \
                const f32x4 t_ = (a_ + b2_) + (c_ + d_); Y[(size_t)(MP + IT_B(k) * T_S + js) * MIX + 64 * IT_H(k) + 16 * IT_Q(k) + jr] = (t_[0] + t_[1]) + (t_[2] + t_[3]); } } while (0)
#define SM_STATE(k) (ARG(I_SWKV) + ((((size_t)l * NSEQ_S + IT_B(k)) * NH + IT_H(k)) * HS + 16 * IT_Q(k) + lrow) * HS + 4 * kq)
            f32x4 Snext = F4Z;
            if (nit > 0) { SM_LOAD(0); SM_STORE(0); if (nit > 1) SM_LOAD(1); if (!is_ld) Snext = *(const f32x4*)SM_STATE(0); }
            __syncthreads();
            for (int k = 0; k < nit; ++k) {
                const int bf = k & 1;
                if (is_ld) {
                    if (k + 1 < nit) SM_STORE(bf ^ 1);
                    if (k + 2 < nit) SM_LOAD(k + 2);
                    if (k > 0) SM_YOUT(bf ^ 1, k - 1);
                } else {
                    f32x4 S = Snext;
                    if (k + 1 < nit) Snext = *(const f32x4*)SM_STATE(k + 1);
                    const LAS float* b_ = lbase + bf * SB_F;
                    LAS float* yp_ = lbase + bf * SB_F + O_Y + lrow * 16 + kq;
                    f32x2 Slo = __builtin_shufflevector(S, S, 0, 1), Shi = __builtin_shufflevector(S, S, 2, 3);
#define SCAN_CP(X, s2) { const f32x2 vv2 = (f32x2){vv##X, vv##X}; \
                                f32x2 dp = Slo * __builtin_shufflevector(kk4##X, kk4##X, 0, 1); dp = Shi * __builtin_shufflevector(kk4##X, kk4##X, 2, 3) + dp; \
                                const float sa = row16_sum(dp[0] + dp[1]); \
                                const f32x2 sa2 = (f32x2){sa, sa}; \
                                f32x2 tlo = Slo * __builtin_shufflevector(w4##X, w4##X, 0, 1), thi = Shi * __builtin_shufflevector(w4##X, w4##X, 2, 3); \
                                tlo = vv2 * __builtin_shufflevector(k4##X, k4##X, 0, 1) + tlo; thi = vv2 * __builtin_shufflevector(k4##X, k4##X, 2, 3) + thi; \
                                Slo = sa2 * __builtin_shufflevector(nb4##X, nb4##X, 0, 1) + tlo; Shi = sa2 * __builtin_shufflevector(nb4##X, nb4##X, 2, 3) + thi; \
                                f32x2 yp = Slo * __builtin_shufflevector(r4##X, r4##X, 0, 1); yp = Shi * __builtin_shufflevector(r4##X, r4##X, 2, 3) + yp; \
                                yv[s2] = yp[0] + yp[1]; }
#define SCAN_ALD(X, s) asm volatile("ds_read_b128 %0, %6 offset:%8\n\tds_read_b128 %1, %6 offset:%9\n\tds_read_b128 %2, %6 offset:%10\n\tds_read_b128 %3, %6 offset:%11\n\tds_read_b128 %4, %6 offset:%12\n\tds_read_b32 %5, %7 offset:%13" \
                                : "=&v"(w4##X), "=&v"(kk4##X), "=&v"(nb4##X), "=&v"(k4##X), "=&v"(r4##X), "=&v"(vv##X) : "v"(a4_), "v"(av_), "n"((s) * 256), "n"(O_KK * 4 + (s) * 256), "n"(O_NB * 4 + (s) * 256), "n"(O_K * 4 + (s) * 256), "n"(O_R * 4 + (s) * 256), "n"(O_V * 4 + (s) * 64)); \
                                __builtin_amdgcn_sched_barrier(0);
#define SCAN_AW(X) __builtin_amdgcn_sched_barrier(0); asm volatile("s_waitcnt lgkmcnt(0)" : "+v"(w4##X), "+v"(kk4##X), "+v"(nb4##X), "+v"(k4##X), "+v"(r4##X), "+v"(vv##X)); __builtin_amdgcn_sched_barrier(0);
#define SCAN_PAIR(s) SCAN_ALD(B, (s) + 1) SCAN_CP(A, s) SCAN_AW(B) SCAN_ALD(A, (s) + 2) SCAN_CP(B, (s) + 1) SCAN_AW(A)
                    float yv[8];
                    { const unsigned a4_ = (unsigned)(unsigned long long)(b_ + 4 * kq), av_ = (unsigned)(unsigned long long)(b_ + lrow);
                      f32x4 w4A, kk4A, nb4A, k4A, r4A, w4B, kk4B, nb4B, k4B, r4B; float vvA, vvB;
                      SCAN_ALD(A, 0) SCAN_AW(A)
                      SCAN_PAIR(0) SCAN_PAIR(2) SCAN_PAIR(4)
                      SCAN_ALD(B, 7) SCAN_CP(A, 6) SCAN_AW(B) SCAN_CP(B, 7) }
#pragma unroll
                    for (int s2 = 0; s2 < 8; ++s2) yp_[s2 * 256] = yv[s2];
#undef SCAN_ALD
#undef SCAN_AW
#undef SCAN_CP
#undef SCAN_PAIR
                    S = (f32x4){Slo[0], Slo[1], Shi[0], Shi[1]};
                    *(f32x4*)(out + O_WKS + ((((size_t)l * NSEQ_S + IT_B(k)) * NH + IT_H(k)) * HS + 16 * IT_Q(k) + lrow) * HS + 4 * kq) = S;
                }
                __syncthreads();
            }
            if (is_ld && nit > 0) SM_YOUT((nit - 1) & 1, nit - 1);
            __syncthreads();
            if (l + 1 < DEPTH) CONVERT_WEIGHTS(l + 1, (int)blockIdx.x - NSEQ_P * NH, G - NSEQ_P * NH);
#undef SM_LOAD
#undef SM_STORE
#undef SM_YOUT
#undef SM_STATE
#undef IT_B
#undef IT_H
#undef IT_Q
            }
        }
        SEAM(ph); ++ph;
        if (IN(ph)) for (int rep_ = 0; rep_ < DUPN(4); ++rep_) { PH_PTRS(); PH_IDS();
            const float* lnw = ARG(I_LNW) + (size_t)l * MIX; const float* lnb = ARG(I_LNB) + (size_t)l * MIX; const float* rk = ARG(I_RK) + (size_t)l * MIX;
            const int c = 8 * lane;
            for (int m = gw; m < M; m += NGW) {
                const float* ysrc = m < MP ? Wd : Y;
                const f32x4 y0 = *(const f32x4*)(ysrc + (size_t)m * MIX + c), y1 = *(const f32x4*)(ysrc + (size_t)m * MIX + c + 4);
                float y[8] = {y0[0], y0[1], y0[2], y0[3], y1[0], y1[1], y1[2], y1[3]};
                float s = 0.f;
#pragma unroll
                for (int i = 0; i < 8; ++i) s += y[i];
                s = row8_sum(s);
                const float mean = s * (1.0f / 64.0f); float q2 = 0.f;
#pragma unroll
                for (int i = 0; i < 8; ++i) { y[i] -= mean; q2 += y[i] * y[i]; }
                q2 = row8_sum(q2);
                const float rstd = 1.0f / sqrtf(q2 * (1.0f / 64.0f) + 64e-5f);
                const v4u ru = *(const v4u*)(Rb + (size_t)m * MIX + c), ku = *(const v4u*)(K2b + (size_t)m * MIX + c), vu = *(const v4u*)(Vb + (size_t)m * MIX + c), gu = *(const v4u*)(Gb + (size_t)m * MIX + c);
                const float rr[8] = {bf_lo(ru.x), bf_hi(ru.x), bf_lo(ru.y), bf_hi(ru.y), bf_lo(ru.z), bf_hi(ru.z), bf_lo(ru.w), bf_hi(ru.w)};
                const float kk[8] = {bf_lo(ku.x), bf_hi(ku.x), bf_lo(ku.y), bf_hi(ku.y), bf_lo(ku.z), bf_hi(ku.z), bf_lo(ku.w), bf_hi(ku.w)};
                const float vv[8] = {bf_lo(vu.x), bf_hi(vu.x), bf_lo(vu.y), bf_hi(vu.y), bf_lo(vu.z), bf_hi(vu.z), bf_lo(vu.w), bf_hi(vu.w)};
                const float gg[8] = {bf_lo(gu.x), bf_hi(gu.x), bf_lo(gu.y), bf_hi(gu.y), bf_lo(gu.z), bf_hi(gu.z), bf_lo(gu.w), bf_hi(gu.w)};
                const f32x4 rk0 = *(const f32x4*)(rk + c), rk1 = *(const f32x4*)(rk + c + 4), w0 = *(const f32x4*)(lnw + c), w1 = *(const f32x4*)(lnw + c + 4), b0 = *(const f32x4*)(lnb + c), b1 = *(const f32x4*)(lnb + c + 4);
                float bs = 0.f;
#pragma unroll
                for (int i = 0; i < 4; ++i) bs += rr[i] * kk[i] * rk0[i] + rr[4 + i] * kk[4 + i] * rk1[i];
                bs = row8_sum(bs);
                float o[8];
#pragma unroll
                for (int i = 0; i < 4; ++i) { o[i] = (y[i] * rstd * w0[i] + b0[i] + bs * vv[i]) * gg[i]; o[4 + i] = (y[4 + i] * rstd * w1[i] + b1[i] + bs * vv[4 + i]) * gg[4 + i]; }
                *(bf16x8*)(ORP + (size_t)m * D + c) = pack8(o);
            }
        }
        SEAM(ph); ++ph;
        if (IN(ph)) for (int rep_ = 0; rep_ < DUPN(5); ++rep_) { PH_PTRS();
            pg8::Gemm g{ORP, WBR_T, MP, D, D}; pg8::StaticOrder S; S.init(MP, D, G, (int)blockIdx.x);
            EpiMerge E{8, P, H};
            pg8::gemm_phase<EpiMerge, pg8::StaticOrder, true, true>(lds, g, S, E, wave_u);
            SAMPLE_TILES(ORP, WBR_T, D, D, E, (MP / 256) * (D / 256));
        }
        SEAM(ph); ++ph;
        if (IN(ph)) for (int rep_ = 0; rep_ < DUPN(6); ++rep_) { PH_PTRS();
            pg8::Gemm g{H, WOUT_T, MP, D, D}; pg8::StaticOrder S; S.init(MP, D, G, (int)blockIdx.x);
            EpiRes E{0, X, modmix + 2048};
            pg8::gemm_phase<EpiRes, pg8::StaticOrder, true, true>(lds, g, S, E, wave_u);
            SAMPLE_TILES(H, WOUT_T, D, D, E, (MP / 256) * (D / 256));
        }
        SEAM(ph); ++ph;
        if (IN(ph)) for (int rep_ = 0; rep_ < DUPN(7); ++rep_) { PH_PTRS(); PH_IDS();
            const float* nw = ARG(I_NORMMLP) + (size_t)l * D;
            for (int m = gw; m < M; m += NGW) {
                const float* xr = X + (size_t)m * D; const float* mo = modmlp + (size_t)row_seq(m) * MODW;
                f32x4 v[4]; float s = 0.f;
#pragma unroll
                for (int j = 0; j < 4; ++j) { v[j] = *(const f32x4*)(xr + 4 * lane + 256 * j); s += (v[j][0] * v[j][0] + v[j][1] * v[j][1]) + (v[j][2] * v[j][2] + v[j][3] * v[j][3]); }
                const float rstd = 1.0f / sqrtf(wave_sum(s) * (1.0f / D) + 1e-6f);
#pragma unroll
                for (int j = 0; j < 4; ++j) { const int c = 4 * lane + 256 * j; const f32x4 g = *(const f32x4*)(nw + c), sh = *(const f32x4*)(mo + c), sc = *(const f32x4*)(mo + 1024 + c);
                    f32x4 o;
#pragma unroll
                    for (int i = 0; i < 4; ++i) o[i] = v[j][i] * rstd * g[i] * (1.0f + sc[i]) + sh[i];
                    *(v2u*)(H + (size_t)m * D + c) = pack4(o[0], o[1], o[2], o[3]); }
            }
        }
        SEAM(ph); ++ph;
        if (IN(ph)) for (int rep_ = 0; rep_ < DUPN(8); ++rep_) { PH_PTRS();
            pg8::Gemm g{H, WFF1_T, MP, DFF, D}; pg8::StaticOrder S; S.init(MP, DFF, G, (int)blockIdx.x);
            EpiStoreBf16 E{0, P, DFF, 1};
            pg8::gemm_phase<EpiStoreBf16, pg8::StaticOrder, true, true>(lds, g, S, E, wave_u);
            SAMPLE_TILES(H, WFF1_T, DFF, D, E, (MP / 256) * (DFF / 256));
        }
        SEAM(ph); ++ph;
        if (IN(ph)) for (int rep_ = 0; rep_ < DUPN(9); ++rep_) { PH_PTRS();
            pg8::Gemm g{P, WFF2_T, MP, D, DFF}; pg8::StaticOrder S; S.init(MP, D, G, (int)blockIdx.x);
            EpiRes E{0, X, modmlp + 2048};
            pg8::gemm_phase<EpiRes, pg8::StaticOrder, true, true>(lds, g, S, E, wave_u);
            SAMPLE_TILES(P, WFF2_T, D, DFF, E, (MP / 256) * (D / 256));
        }
        SEAM(ph); ++ph;
    }
    if (IN(ph)) for (int rep_ = 0; rep_ < DUPN(12); ++rep_) { PH_PTRS(); PH_IDS();
        const float* nw = ARG(I_NORMF);
        for (int m = gw; m < M; m += NGW) {
            float* xr = X + (size_t)m * D;
            f32x4 v[4]; float s = 0.f;
#pragma unroll
            for (int j = 0; j < 4; ++j) { v[j] = *(const f32x4*)(xr + 4 * lane + 256 * j); s += (v[j][0] * v[j][0] + v[j][1] * v[j][1]) + (v[j][2] * v[j][2] + v[j][3] * v[j][3]); }
            const float rstd = 1.0f / sqrtf(wave_sum(s) * (1.0f / D) + 1e-6f);
#pragma unroll
            for (int j = 0; j < 4; ++j) { const int c = 4 * lane + 256 * j; const f32x4 g = *(const f32x4*)(nw + c); *(f32x4*)(xr + c) = v[j] * rstd * g; }
        }
    }
#undef IN
#undef SEAM
}

constexpr int N_PHASES = 2 + DEPTH * 11 + 1;

extern "C" void kernel_launch(void* const* d_in, const int* in_sizes, int n_in, void* d_out, int out_size, void* d_ws, size_t ws_size, hipStream_t stream) {
    static int grid = 0;
    if (grid == 0) {
        if (n_in != N_IN || (size_t)out_size != O_END || ws_size < WS_END) { fprintf(stderr, "kernel_launch: shape mismatch n_in %d out %d ws %zu\n", n_in, out_size, ws_size); grid = -1; return; }
        int dev = 0, cus = 0, per_cu = 0;
        if (hipGetDevice(&dev) != hipSuccess || hipDeviceGetAttribute(&cus, hipDeviceAttributeMultiprocessorCount, dev) != hipSuccess) { grid = -1; return; }
        if (hipFuncSetAttribute((const void*)mk_fwd, hipFuncAttributeMaxDynamicSharedMemorySize, LDS_BYTES) != hipSuccess) { fprintf(stderr, "kernel_launch: hipFuncSetAttribute failed\n"); grid = -1; return; }
        if (hipOccupancyMaxActiveBlocksPerMultiprocessor(&per_cu, (const void*)mk_fwd, NTHR, LDS_BYTES) != hipSuccess || per_cu < 1) { fprintf(stderr, "kernel_launch: occupancy query says %d\n", per_cu); per_cu = 1; }
        (void)hipGetLastError();
        grid = cus * (per_cu < 1 ? per_cu : 1);
    }
    if (grid < 0) return;
    (void)hipMemsetAsync((char*)d_ws + WS_CTL, 0, CTL_ZERO_BYTES, stream);
    Args a{};
    for (int i = 0; i < N_IN; ++i) a.in[i] = (const float*)d_in[i];
    a.out = (float*)d_out; a.ws = (unsigned char*)d_ws; a.dup = PROBE_DUP;
#if MK_ONE_LAUNCH
    a.ph_lo = 0; a.ph_hi = N_PHASES;
    void* kargs[] = {(void*)&a};
    hipError_t e = hipLaunchCooperativeKernel((const void*)mk_fwd, dim3(grid), dim3(NTHR), kargs, LDS_BYTES, stream);
    if (e != hipSuccess) fprintf(stderr, "kernel_launch: cooperative launch failed: %s (grid %d)\n", hipGetErrorString(e), grid);
#else
    for (int p = 0; p < N_PHASES; ++p) { a.ph_lo = p; a.ph_hi = p + 1; hipLaunchKernelGGL(mk_fwd, dim3(grid), dim3(NTHR), LDS_BYTES, stream, a); }
#endif
}
```
